# Optimizing an MI355X kernel written in HIP

```python
import jax, jax.numpy as jnp
from jax import lax
import numpy as np

D_MODEL = 2048
BATCH = 8
SEQ = 2048
DEPTH = 1

CTX_LEN = 256
GRID_W = 64
RET_HEADS = 8
RET_DK = 256
RET_DV = 256
RET_QK = RET_HEADS * RET_DK
RET_VW = RET_HEADS * RET_DV
RET_CHUNK = 128
ROPE_FREQS = RET_DK // 4
ROPE_BASE = 10000.0
SG_GROUPS = 8
SG_CHUNK = 128
SG_WIDTH = 2048
SG_GD = SG_WIDTH // SG_GROUPS
FFN_HIDDEN = -(-8 * D_MODEL // (3 * 256)) * 256
EPS = 1e-6
Q_OFF = 0
K_OFF = Q_OFF + RET_QK
V_OFF = K_OFF + RET_QK
G_OFF = V_OFF + RET_VW
U_OFF = G_OFF + RET_VW
VS_OFF = U_OFF + SG_WIDTH
GR_OFF = VS_OFF + SG_WIDTH
GS_OFF = GR_OFF + D_MODEL
D_IN = GS_OFF + D_MODEL

kernel_name = "hybrid_retention_gmlp_prefix_dit"

F32 = jnp.float32


def rmsnorm(x, g):
    xf = x.astype(F32)
    y = xf * lax.rsqrt(jnp.mean(xf * xf, axis=-1, keepdims=True) + EPS)
    return (y * g.astype(F32)).astype(x.dtype)


def layernorm(x, g, b):
    xf = x.astype(F32)
    mu = jnp.mean(xf, axis=-1, keepdims=True)
    var = jnp.mean(jnp.square(xf - mu), axis=-1, keepdims=True)
    y = (xf - mu) * lax.rsqrt(var + EPS)
    return (y * g.astype(F32) + b.astype(F32)).astype(x.dtype)


def adaln(cond, w_mod, b_mod):
    return jnp.split(jax.nn.silu(cond) @ w_mod + b_mod, 6, axis=-1)


def modulate(h, shift, scale):
    return h * (1.0 + scale) + shift


def rope_tables(L):
    rows = L // GRID_W
    row = jnp.repeat(jnp.arange(rows), GRID_W)
    col = jnp.tile(jnp.arange(GRID_W), rows)
    freq = ROPE_BASE ** (-jnp.arange(ROPE_FREQS, dtype=F32) / ROPE_FREQS)
    ang = jnp.stack([row, col], axis=-1).astype(F32)[:, :, None] * freq
    return jnp.cos(ang), jnp.sin(ang)


def apply_rope(x, cos, sin):
    B, L, H, Dk = x.shape
    xb = x.reshape(B, L, H, 2, 2, ROPE_FREQS)
    x1, x2 = xb[..., 0, :], xb[..., 1, :]
    c = cos[None, :, None]
    s = sin[None, :, None]
    return jnp.stack([x1 * c - x2 * s, x2 * c + x1 * s], axis=-2).reshape(B, L, H, Dk).astype(x.dtype)


def log_decay(logit):
    return -jax.nn.softplus(-logit.astype(F32))


def retention_scan(q, k, v, lg, s0, include_diag):
    B, H, L, _ = q.shape
    Dv = v.shape[-1]
    C = RET_CHUNK
    n = L // C

    def chunks(t):
        return jnp.moveaxis(t.reshape(B, H, n, C, t.shape[-1]), 2, 0)

    idx = jnp.arange(C, dtype=F32)
    diff = idx[:, None] - idx[None, :]
    mask = (diff >= 0) if include_diag else (diff > 0)
    decay_in = jnp.where(mask, jnp.exp(lg[:, None, None] * jnp.maximum(diff, 0.0)), 0.0)
    q_dec = jnp.exp(lg[:, None] * (idx + 1.0))[None, :, :, None]
    k_dec = jnp.exp(lg[:, None] * (C - 1.0 - idx))[None, :, :, None]
    c_dec = jnp.exp(lg * C)[None, :, None, None]

    def step(S, qkv):
        qc, kc, vc = qkv
        scores = jnp.einsum('bhid,bhjd->bhij', qc, kc) * decay_in
        out = (jnp.einsum('bhij,bhje->bhie', scores, vc)
               + jnp.einsum('bhid,bhde->bhie', qc, S) * q_dec)
        S = S * c_dec + jnp.einsum('bhjd,bhje->bhde', kc * k_dec, vc)
        return S, out

    _, out = lax.scan(step, s0, (chunks(q), chunks(k), chunks(v)))
    return jnp.moveaxis(out, 0, 2).reshape(B, H, L, Dv)


def bidirectional_retention(q, k, v, lg_f, lg_b, s_f, s_b):
    q, k, v = (jnp.swapaxes(t.astype(F32), 1, 2) for t in (q, k, v))
    flip = lambda t: jnp.flip(t, axis=2)
    fwd = retention_scan(q, k, v, lg_f, s_f, True)
    bwd = flip(retention_scan(flip(q), flip(k), flip(v), lg_b, s_b, False))
    return jnp.swapaxes(fwd + bwd, 1, 2)


def context_states(k, v, lg_f, lg_b):
    Lc = k.shape[2]
    j = jnp.arange(Lc, dtype=F32)
    w_f = jnp.exp(lg_f[:, None] * (Lc - 1.0 - j))[None, :, :, None]
    w_b = jnp.exp(lg_b[:, None] * j)[None, :, :, None]
    s_f = jnp.einsum('bhld,bhle->bhde', k * w_f, v)
    s_b = jnp.einsum('bhld,bhle->bhde', k * w_b, v)
    return s_f, s_b


def spatial_gating(u, vs, ln_g, ln_b, w_s, b_s):
    B, L, _ = u.shape
    n = L // SG_CHUNK
    vn = layernorm(vs, ln_g, ln_b).reshape(B, n, SG_CHUNK, SG_GROUPS, SG_GD)
    mixed = jnp.einsum('gij,bnjgd->bnigd', w_s, vn) + b_s.T[None, None, :, :, None]
    return u * mixed.reshape(B, L, SG_WIDTH)


def token_mixer(h, s_f, s_b, rope, w_in, lg_f, lg_b, sg_ln_g, sg_ln_b, sg_w, sg_b,
                w_ret_o, w_sg_o, w_out):
    B, L, _ = h.shape
    p = h @ w_in
    q = p[..., Q_OFF:K_OFF].reshape(B, L, RET_HEADS, RET_DK)
    k = p[..., K_OFF:V_OFF].reshape(B, L, RET_HEADS, RET_DK) * (RET_DK ** -0.5)
    v = p[..., V_OFF:G_OFF].reshape(B, L, RET_HEADS, RET_DV)
    g_ret = p[..., G_OFF:U_OFF]
    u = jax.nn.gelu(p[..., U_OFF:VS_OFF])
    vs = jax.nn.gelu(p[..., VS_OFF:GR_OFF])
    gate_r = jax.nn.sigmoid(p[..., GR_OFF:GS_OFF].astype(F32))
    gate_s = jax.nn.sigmoid(p[..., GS_OFF:D_IN].astype(F32))
    if rope is not None:
        q = apply_rope(q, *rope)
        k = apply_rope(k, *rope)
    ret = bidirectional_retention(q, k, v, lg_f, lg_b, s_f, s_b)
    ret = ret * lax.rsqrt(jnp.mean(ret * ret, axis=-1, keepdims=True) + EPS)
    ret = ret.reshape(B, L, RET_VW) * jax.nn.silu(g_ret)
    y_ret = ret @ w_ret_o
    y_sg = spatial_gating(u, vs, sg_ln_g, sg_ln_b, sg_w, sg_b) @ w_sg_o
    return (gate_r * y_ret + gate_s * y_sg) @ w_out


def swiglu(h, w_ffn_in, w_ffn_out):
    a, b = jnp.split(h @ w_ffn_in, 2, axis=-1)
    return (jax.nn.silu(a) * b) @ w_ffn_out


def setup_inputs(seed: int = 0) -> dict:
    key = jax.random.key(seed)
    ks = jax.random.split(key, 24)
    nrm = lambda k, shape, s: jax.random.normal(k, shape, F32) * s
    base_logit = jnp.log(2.0 ** (5.0 + jnp.arange(RET_HEADS, dtype=F32)) - 1.0)
    return {
        "x": nrm(ks[0], (BATCH, SEQ, D_MODEL), 1.0),
        "c": nrm(ks[1], (BATCH, D_MODEL), 1.0),
        "ctx": nrm(ks[2], (BATCH, CTX_LEN, D_MODEL), 1.0),
        "c_ctx": nrm(ks[3], (D_MODEL,), 1.0),
        "w_mod": nrm(ks[4], (DEPTH, D_MODEL, 6 * D_MODEL), 0.5 * D_MODEL ** -0.5),
        "b_mod": nrm(ks[5], (DEPTH, 6 * D_MODEL), 0.01),
        "norm1_g": 1.0 + nrm(ks[6], (DEPTH, D_MODEL), 0.02),
        "w_in": nrm(ks[7], (DEPTH, D_MODEL, D_IN), D_MODEL ** -0.5),
        "ret_decay_fwd": base_logit[None] + nrm(ks[8], (DEPTH, RET_HEADS), 0.1),
        "ret_decay_bwd": base_logit[None] + nrm(ks[9], (DEPTH, RET_HEADS), 0.1),
        "sg_ln_g": 1.0 + nrm(ks[10], (DEPTH, SG_WIDTH), 0.02),
        "sg_ln_b": nrm(ks[11], (DEPTH, SG_WIDTH), 0.02),
        "sg_w": nrm(ks[12], (DEPTH, SG_GROUPS, SG_CHUNK, SG_CHUNK), 0.5 * SG_CHUNK ** -0.5),
        "sg_b": 1.0 + nrm(ks[13], (DEPTH, SG_GROUPS, SG_CHUNK), 0.02),
        "w_ret_o": nrm(ks[14], (DEPTH, RET_VW, D_MODEL), RET_VW ** -0.5),
        "w_sg_o": nrm(ks[15], (DEPTH, SG_WIDTH, D_MODEL), SG_WIDTH ** -0.5),
        "w_out": nrm(ks[16], (DEPTH, D_MODEL, D_MODEL), D_MODEL ** -0.5),
        "norm2_g": 1.0 + nrm(ks[17], (DEPTH, D_MODEL), 0.02),
        "w_ffn_in": nrm(ks[18], (DEPTH, D_MODEL, 2 * FFN_HIDDEN), D_MODEL ** -0.5),
        "w_ffn_out": nrm(ks[19], (DEPTH, FFN_HIDDEN, D_MODEL), FFN_HIDDEN ** -0.5),
        "final_norm_g": 1.0 + nrm(ks[20], (D_MODEL,), 0.02),
    }


def reference(x, c, ctx, c_ctx, w_mod, b_mod, norm1_g, w_in, ret_decay_fwd, ret_decay_bwd,
              sg_ln_g, sg_ln_b, sg_w, sg_b, w_ret_o, w_sg_o, w_out, norm2_g,
              w_ffn_in, w_ffn_out, final_norm_g):
    B, L, _ = x.shape
    rope = rope_tables(L)
    ctx_s = ctx
    for l in range(DEPTH):
        sh1, sc1, gt1, sh2, sc2, gt2 = (t[:, None, :] for t in adaln(c, w_mod[l], b_mod[l]))
        csh1, csc1, cgt1, csh2, csc2, cgt2 = adaln(c_ctx, w_mod[l], b_mod[l])
        lg_f = log_decay(ret_decay_fwd[l])
        lg_b = log_decay(ret_decay_bwd[l])
        mixer_params = (w_in[l], lg_f, lg_b, sg_ln_g[l], sg_ln_b[l], sg_w[l], sg_b[l],
                        w_ret_o[l], w_sg_o[l], w_out[l])

        hc = modulate(rmsnorm(ctx_s, norm1_g[l]), csh1, csc1)
        Lc = hc.shape[1]
        kc = (hc @ w_in[l][:, K_OFF:V_OFF]).reshape(B, Lc, RET_HEADS, RET_DK) * (RET_DK ** -0.5)
        vc = (hc @ w_in[l][:, V_OFF:G_OFF]).reshape(B, Lc, RET_HEADS, RET_DV)
        s_f, s_b = context_states(jnp.swapaxes(kc.astype(F32), 1, 2),
                                  jnp.swapaxes(vc.astype(F32), 1, 2), lg_f, lg_b)

        h = modulate(rmsnorm(x, norm1_g[l]), sh1, sc1)
        x = x + gt1 * token_mixer(h, s_f, s_b, rope, *mixer_params)
        h2 = modulate(rmsnorm(x, norm2_g[l]), sh2, sc2)
        x = x + gt2 * swiglu(h2, w_ffn_in[l], w_ffn_out[l])

        if l < DEPTH - 1:
            zero = jnp.zeros((B, RET_HEADS, RET_DK, RET_DV), F32)
            ctx_s = ctx_s + cgt1 * token_mixer(hc, zero, zero, None, *mixer_params)
            hc2 = modulate(rmsnorm(ctx_s, norm2_g[l]), csh2, csc2)
            ctx_s = ctx_s + cgt2 * swiglu(hc2, w_ffn_in[l], w_ffn_out[l])
    return rmsnorm(x, final_norm_g)
```

```cpp
#include <hip/hip_runtime.h>
#include <hip/hip_cooperative_groups.h>
#include <cstdio>
#include <cstdint>
namespace cg = cooperative_groups;

#define LAS __attribute__((address_space(3)))
typedef unsigned short bf16_t;
typedef short bf16x8 __attribute__((ext_vector_type(8)));
typedef short s16x4 __attribute__((ext_vector_type(4)));
typedef short v4i16_t __attribute__((ext_vector_type(4)));
typedef float f32x2 __attribute__((ext_vector_type(2)));
typedef float f32x4 __attribute__((ext_vector_type(4)));
typedef float f32x16 __attribute__((ext_vector_type(16)));
typedef unsigned u32x2 __attribute__((ext_vector_type(2)));
typedef unsigned u32x4 __attribute__((ext_vector_type(4)));
typedef __bf16 bf16x2_t __attribute__((ext_vector_type(2)));

constexpr int DM = 2048, NB = 8, SEQ = 2048, MTOK = NB * SEQ, LCTX = 256, MCTX = NB * LCTX, NH = 8, DIN = 16384, FF = 5632, NMOD = 12288;
constexpr float EPS = 1e-6f;
constexpr size_t MiB = 1u << 20;
constexpr size_t WS_MOD = 0, WS_ROPE = 512 * 1024, WS_SGW = 576 * 1024;
constexpr size_t WS_WF1 = 1 * MiB, WS_WF2 = 45 * MiB, WS_W3 = 67 * MiB, WS_Q = 91 * MiB, WS_WIN = 155 * MiB, WS_H = 219 * MiB, WS_K = 291 * MiB, WS_V = 355 * MiB,
                 WS_KC = 419 * MiB, WS_VC = 427 * MiB, WS_G = 435 * MiB, WS_END = 499 * MiB;
constexpr size_t WS_T = WS_WIN, WS_HID = WS_WIN;
constexpr int LDS_BYTES = 153600;
constexpr int LDS_XCH = 131072, LDS_XS = 147456, LDS_STATS = 148480, LDS_BARST = 149504;
constexpr size_t WS_BAR = 896 * 1024;

__device__ __forceinline__ unsigned cvtpk(float lo, float hi) { f32x2 v = {lo, hi}; bf16x2_t b = __builtin_convertvector(v, bf16x2_t); return __builtin_bit_cast(unsigned, b); }
__device__ __forceinline__ float bflo(unsigned w) { return __uint_as_float(w << 16); }
__device__ __forceinline__ float bfhi(unsigned w) { return __uint_as_float(w & 0xffff0000u); }
__device__ __forceinline__ float bf2f(bf16_t b) { return __uint_as_float(((unsigned)b) << 16); }
__device__ __forceinline__ float fast_sigmoid(float x) { return __builtin_amdgcn_rcpf(1.0f + __builtin_amdgcn_exp2f(-1.4426950408889634f * x)); }
__device__ __forceinline__ float fast_silu(float x) { return x * fast_sigmoid(x); }
__device__ __forceinline__ float fast_gelu(float x) { const float z = 0.7978845608028654f * (x + 0.044715f * x * x * x); return x * fast_sigmoid(2.0f * z); }
__device__ __forceinline__ float wave_sum(float v) {
#pragma unroll
    for (int o = 1; o < 64; o <<= 1) v += __shfl_xor(v, o);
    return v;
}

namespace pg8 {
constexpr int BM = 256, BK = 64, HALF = 128, HTB = HALF * BK * 2, STAGE_BYTES = 8 * HTB, NXCD = 8, WGM = 8;
__host__ __device__ __forceinline__ int lds_byte(int r, int c) { const int st = (r >> 4) * 2 + (c >> 5), rr = r & 15, cc = c & 31, ob = rr * 64 + cc * 2; return st * 1024 + (ob ^ (((ob >> 9) & 1) << 5)); }
__host__ __device__ __forceinline__ void stage_rc(int b, int& R, int& C) { const int st = b / 1024, sb = b % 1024, swz = sb ^ (((sb >> 9) & 1) << 5); R = (st >> 1) * 16 + swz / 64; C = (st & 1) * 32 + (swz % 64) / 2; }
__host__ __device__ __forceinline__ int perm32(int rho) { const int n = rho >> 4, i = rho & 15; return 8 * (i >> 2) + 4 * n + (i & 3); }

struct Unit { int pm, pn, which; };
struct Gemm { const bf16_t* A; const bf16_t* Bt; const bf16_t* A2; const bf16_t* Bt2; int K; };

struct Order {
    int nM, nN, pn0, nwg, G, c, nextra, dual;
    __device__ void init(int nM_, int nN_, int pn0_, int nextra_, int G_, int c_, int dual_ = 0) { nM = nM_; nN = nN_; pn0 = pn0_; nwg = nM * nN; nextra = nextra_; G = G_; c = c_; dual = dual_; }
    __device__ bool next(int i, Unit& u) const {
        u.which = dual ? (i & 1) : 0; if (dual) i >>= 1;
        long L = (long)i * G + c;
        if (L < nwg) {
            int wgid = (int)L; { const int q = nwg / NXCD, r = nwg % NXCD, xcd = wgid % NXCD, off = wgid / NXCD; wgid = (xcd < r ? xcd * (q + 1) : r * (q + 1) + (xcd - r) * q) + off; }
            const int nig = WGM * nN, gid = wgid / nig, fm = gid * WGM, gsz = (nM - fm) < WGM ? (nM - fm) : WGM;
            u.pm = fm + ((wgid % nig) % gsz); u.pn = pn0 + (wgid % nig) / gsz; return true;
        }
        L -= nwg;
        if (L < nextra) { u.pm = 64 + (int)(L & 7); u.pn = 8 + (int)(L >> 3); return true; }
        return false;
    }
};

template <class Epi>
__device__ __forceinline__ void gemm_phase(LAS unsigned char* lds, const Gemm g, const Order& S, const Epi& E) {
    int tid_ = threadIdx.x; asm volatile("" : "+v"(tid_));
    const int tid = tid_, wid = __builtin_amdgcn_readfirstlane(tid >> 6), lane = tid & 63, wr = wid >> 2, wc = wid & 3, fr = lane & 15, fq = lane >> 4;
    const int K = g.K, nt = K / BK;
    unsigned voffA[2], voffB[2];
#pragma unroll
    for (int i = 0; i < 2; ++i) { int R, C; stage_rc(tid * 16 + i * 8192, R, C); const int Rb = (R & ~31) + perm32(R & 31);
        voffA[i] = (unsigned)(R * K + C) * 2u; voffB[i] = (unsigned)(Rb * K + C) * 2u; }
    const size_t kstep = (size_t)(BK * 2);
    const size_t hstep = (size_t)HALF * K * 2;
    const size_t tstep = 2 * hstep;
    const unsigned ldsw = (unsigned)wid * 1024u;
    const int aoff = lds_byte(wr * 64 + fr, fq * 8), boff = lds_byte(wc * 32 + fr, fq * 8);
#define PG8_SA(b, h) (((b) * 2 + (h)) * HTB)
#define PG8_SB(b, h) ((4 + (b) * 2 + (h)) * HTB)
#define PG8_STAGE(bufoff, gbase, voff) do { _Pragma("unroll") for (int _i = 0; _i < 2; ++_i) \
        __builtin_amdgcn_global_load_lds((const unsigned*)((const char*)(gbase) + (voff)[_i]), (LAS unsigned*)(lds + (bufoff) + ldsw + _i * 8192), 16, 0, 0); } while (0)
#define PG8_LDA(dst, b, h) do { _Pragma("unroll") for (int m = 0; m < 4; ++m) _Pragma("unroll") for (int k = 0; k < 2; ++k) dst[m][k] = *(const LAS bf16x8*)(lds + PG8_SA(b, h) + aoff + m * 2048 + k * 1024); } while (0)
#define PG8_LDB(dst, b, h) do { _Pragma("unroll") for (int n = 0; n < 2; ++n) _Pragma("unroll") for (int k = 0; k < 2; ++k) dst[n][k] = *(const LAS bf16x8*)(lds + PG8_SB(b, h) + boff + n * 2048 + k * 1024); } while (0)
#define PG8_MMA(ai, bj, At, Bt) do { __builtin_amdgcn_s_setprio(1); _Pragma("unroll") for (int m = 0; m < 4; ++m) _Pragma("unroll") for (int n = 0; n < 2; ++n) _Pragma("unroll") for (int k = 0; k < 2; ++k) \
        acc[ai][bj][m][n] = __builtin_amdgcn_mfma_f32_16x16x32_bf16(Bt[n][k], At[m][k], acc[ai][bj][m][n], 0, 0, 0); __builtin_amdgcn_s_setprio(0); } while (0)
#define PG8_WAIT_V(n) asm volatile("s_waitcnt vmcnt(" #n ")" ::: "memory")
#define PG8_WAIT_L(n) asm volatile("s_waitcnt lgkmcnt(" #n ")" ::: "memory")
#define PG8_BAR __builtin_amdgcn_s_barrier()
#define PG8_SCHED __builtin_amdgcn_sched_barrier(0)
    Unit cur, nxt; int ui = 0;
    if (!S.next(0, cur)) return;
    f32x4 acc[2][2][4][2];
#pragma unroll
    for (int a = 0; a < 2; ++a)
#pragma unroll
        for (int b = 0; b < 2; ++b)
#pragma unroll
            for (int m = 0; m < 4; ++m)
#pragma unroll
                for (int n = 0; n < 2; ++n) acc[a][b][m][n] = (f32x4){0.f, 0.f, 0.f, 0.f};
    bf16x8 At[4][2], B0[2][2], B1[2][2];
    const char* cA = (const char*)(cur.which ? g.A2 : g.A) + (size_t)cur.pm * tstep; const char* cB = (const char*)(cur.which ? g.Bt2 : g.Bt) + (size_t)cur.pn * tstep;
    PG8_STAGE(PG8_SB(0, 0), cB, voffB); PG8_STAGE(PG8_SB(0, 1), cB + hstep, voffB); PG8_STAGE(PG8_SA(0, 0), cA, voffA); PG8_STAGE(PG8_SA(0, 1), cA + hstep, voffA);
    if (wr == 1) PG8_BAR;
    PG8_WAIT_V(2); PG8_BAR;
    PG8_STAGE(PG8_SB(1, 0), cB + kstep, voffB); PG8_STAGE(PG8_SA(1, 0), cA + kstep, voffA); PG8_STAGE(PG8_SB(1, 1), cB + hstep + kstep, voffB);
    PG8_WAIT_V(6); PG8_BAR;
    for (;;) {
        const bool has_next = S.next(ui + 1, nxt);
        const char* nA = has_next ? (const char*)(nxt.which ? g.A2 : g.A) + (size_t)nxt.pm * tstep : cA; const char* nB = has_next ? (const char*)(nxt.which ? g.Bt2 : g.Bt) + (size_t)nxt.pn * tstep : cB;
        for (int t = 0; t < nt; t += 2) {
            const bool last = (t == nt - 2);
            const char* a1 = cA + (size_t)(t + 1) * kstep;
            const char* a2 = last ? nA : cA + (size_t)(t + 2) * kstep; const char* b2 = last ? nB : cB + (size_t)(t + 2) * kstep;
            const char* a3 = a2 + kstep; const char* b3 = b2 + kstep;
            PG8_LDB(B0, 0, 0); PG8_LDB(B1, 0, 1); PG8_SCHED; PG8_LDA(At, 0, 0); PG8_STAGE(PG8_SA(1, 1), a1 + hstep, voffA);
            PG8_WAIT_V(8); PG8_WAIT_L(0); PG8_BAR; PG8_MMA(0, 0, At, B0); PG8_MMA(0, 1, At, B1); PG8_BAR; PG8_SCHED;
            PG8_LDA(At, 0, 1); PG8_STAGE(PG8_SB(0, 0), b2, voffB); PG8_STAGE(PG8_SB(0, 1), b2 + hstep, voffB); PG8_STAGE(PG8_SA(0, 0), a2, voffA);
            PG8_WAIT_V(8); PG8_WAIT_L(0); PG8_BAR; PG8_MMA(1, 0, At, B0); PG8_MMA(1, 1, At, B1); PG8_BAR; PG8_SCHED;
            PG8_LDB(B0, 1, 0); PG8_LDB(B1, 1, 1); PG8_SCHED; PG8_LDA(At, 1, 0); PG8_STAGE(PG8_SA(0, 1), a2 + hstep, voffA);
            PG8_WAIT_V(8); PG8_WAIT_L(0); PG8_BAR; PG8_MMA(0, 0, At, B0); PG8_MMA(0, 1, At, B1); PG8_BAR; PG8_SCHED;
            PG8_LDA(At, 1, 1); PG8_STAGE(PG8_SB(1, 0), b3, voffB); PG8_STAGE(PG8_SB(1, 1), b3 + hstep, voffB); PG8_STAGE(PG8_SA(1, 0), a3, voffA);
            PG8_WAIT_V(8); PG8_WAIT_L(0); PG8_BAR; PG8_MMA(1, 0, At, B0); PG8_MMA(1, 1, At, B1); PG8_BAR; PG8_SCHED;
        }
        if (wr == 0) PG8_BAR;
        const bool keep = E(acc, cur, wr, wc, fr, fq);
        if (!has_next) break;
        if (!keep)
#pragma unroll
        for (int a = 0; a < 2; ++a)
#pragma unroll
            for (int b = 0; b < 2; ++b)
#pragma unroll
                for (int m = 0; m < 4; ++m)
#pragma unroll
                    for (int n = 0; n < 2; ++n) acc[a][b][m][n] = (f32x4){0.f, 0.f, 0.f, 0.f};
        cur = nxt; cA = nA; cB = nB; ++ui;
        if (wr == 1) PG8_BAR;
    }
    PG8_WAIT_V(0);
    PG8_BAR;
#undef PG8_SA
#undef PG8_SB
#undef PG8_STAGE
#undef PG8_LDA
#undef PG8_LDB
#undef PG8_MMA
#undef PG8_WAIT_V
#undef PG8_WAIT_L
#undef PG8_BAR
#undef PG8_SCHED
}
}
using pg8::Unit;

#define EPI_ARGS f32x4 (&acc)[2][2][4][2], const Unit& u, int wr, int wc, int fr, int fq
#define EPI_FOR_ROWS _Pragma("unroll") for (int ai = 0; ai < 2; ++ai) _Pragma("unroll") for (int m = 0; m < 4; ++m)
#define EPI_FOR_BJ _Pragma("unroll") for (int bj = 0; bj < 2; ++bj)

struct EpiIn {
    bf16_t *Q, *K, *V, *G, *U, *VS, *KC, *VC; const f32x4* rope;
    __device__ __forceinline__ bool operator()(EPI_ARGS) const {
        const int region = u.pn >> 3, hcol = (u.pn & 7) * 256;
        const bool isctx = u.pm >= 64;
        bf16_t* base; int mode; float sc = 1.0f;
        switch (region) {
            case 0: base = Q; mode = 0; break;
            case 1: base = isctx ? KC : K; mode = isctx ? 1 : 0; sc = 0.0625f; break;
            case 2: base = isctx ? VC : V; mode = 1; break;
            case 3: base = G; mode = 2; break;
            case 4: base = U; mode = 3; break;
            case 5: base = VS; mode = 3; break;
            case 6: base = K; mode = 4; break;
            default: base = V; mode = 4; break;
        }
        const int prow = isctx ? (u.pm - 64) * 256 : u.pm * 256;
        const int col0 = hcol + wc * 32 + fq * 8;
        if (mode == 0) {
            const int lbase = (u.pm & 7) * 256, tcol = wc * 8 + fq * 2;
            f32x4 tr[2][2], tc[4][2];
#pragma unroll
            for (int ai = 0; ai < 2; ++ai) { const int pos = (lbase + ai * 128 + wr * 64) >> 6; tr[ai][0] = rope[pos * 32 + tcol]; tr[ai][1] = rope[pos * 32 + tcol + 1]; }
#pragma unroll
            for (int m = 0; m < 4; ++m) { const int pos = m * 16 + fr; tc[m][0] = rope[pos * 32 + tcol]; tc[m][1] = rope[pos * 32 + tcol + 1]; }
            EPI_FOR_ROWS {
                const int rl = ai * 128 + wr * 64 + m * 16 + fr;
                bf16_t* rowp = base + (size_t)(prow + rl) * DM + col0;
                EPI_FOR_BJ {
                    const f32x4 t0 = bj == 0 ? tr[ai][0] : tc[m][0], t1 = bj == 0 ? tr[ai][1] : tc[m][1];
                    const f32x4 v0 = acc[ai][bj][m][0] * sc, v1 = acc[ai][bj][m][1] * sc;
                    u32x4 w;
                    w.x = cvtpk(v0[0] * t0[0] - v0[1] * t0[1], v0[1] * t0[0] + v0[0] * t0[1]);
                    w.y = cvtpk(v0[2] * t0[2] - v0[3] * t0[3], v0[3] * t0[2] + v0[2] * t0[3]);
                    w.z = cvtpk(v1[0] * t1[0] - v1[1] * t1[1], v1[1] * t1[0] + v1[0] * t1[1]);
                    w.w = cvtpk(v1[2] * t1[2] - v1[3] * t1[3], v1[3] * t1[2] + v1[2] * t1[3]);
                    *(u32x4*)(rowp + bj * 128) = w;
                }
            }
        } else {
            EPI_FOR_ROWS {
                const int rl = ai * 128 + wr * 64 + m * 16 + fr;
                bf16_t* rowp = base + (size_t)(prow + rl) * DM + col0;
                EPI_FOR_BJ {
                    f32x4 v0 = acc[ai][bj][m][0], v1 = acc[ai][bj][m][1];
                    if (mode == 1) { v0 = v0 * sc; v1 = v1 * sc; }
                    else if (mode == 2) {
#pragma unroll
                        for (int e = 0; e < 4; ++e) { v0[e] = fast_silu(v0[e]); v1[e] = fast_silu(v1[e]); } }
                    else if (mode == 3) {
#pragma unroll
                        for (int e = 0; e < 4; ++e) { v0[e] = fast_gelu(v0[e]); v1[e] = fast_gelu(v1[e]); } }
                    else {
#pragma unroll
                        for (int e = 0; e < 4; ++e) { v0[e] = fast_sigmoid(v0[e]); v1[e] = fast_sigmoid(v1[e]); } }
                    u32x4 w; w.x = cvtpk(v0[0], v0[1]); w.y = cvtpk(v0[2], v0[3]); w.z = cvtpk(v1[0], v1[1]); w.w = cvtpk(v1[2], v1[3]);
                    *(u32x4*)(rowp + bj * 128) = w;
                }
            }
        }
        return false;
    }
};
struct EpiDual {
    const bf16_t* GR; const bf16_t* GS; bf16_t* MG;
    __device__ __forceinline__ bool operator()(EPI_ARGS) const {
        const int col0 = u.pn * 256 + wc * 32 + fq * 8;
        const size_t off0 = (size_t)(u.pm * 256 + wr * 64 + fr) * DM + col0;
        if (u.which == 0) {
#pragma unroll
            for (int ai = 0; ai < 2; ++ai) {
                u32x4 rw[4][2], sw[4][2];
#pragma unroll
                for (int m = 0; m < 4; ++m)
#pragma unroll
                    for (int bj = 0; bj < 2; ++bj) { const size_t off = off0 + (size_t)(ai * 128 + m * 16) * DM + bj * 128; rw[m][bj] = *(const u32x4*)(GR + off); sw[m][bj] = *(const u32x4*)(GS + off); }
                asm volatile("" ::: "memory");
#pragma unroll
                for (int m = 0; m < 4; ++m)
#pragma unroll
                    for (int bj = 0; bj < 2; ++bj)
#pragma unroll
                        for (int e = 0; e < 4; ++e) {
                            const float r0 = bflo(rw[m][bj][e]) * __builtin_amdgcn_rcpf(fmaxf(bflo(sw[m][bj][e]), 1e-30f)), r1 = bfhi(rw[m][bj][e]) * __builtin_amdgcn_rcpf(fmaxf(bfhi(sw[m][bj][e]), 1e-30f));
                            acc[ai][bj][m][e >> 1][(e & 1) * 2] *= r0; acc[ai][bj][m][e >> 1][(e & 1) * 2 + 1] *= r1; }
            }
            return true;
        }
#pragma unroll
        for (int ai = 0; ai < 2; ++ai) {
            u32x4 gw[4][2];
#pragma unroll
            for (int m = 0; m < 4; ++m)
#pragma unroll
                for (int bj = 0; bj < 2; ++bj) gw[m][bj] = *(const u32x4*)(GS + off0 + (size_t)(ai * 128 + m * 16) * DM + bj * 128);
            asm volatile("" ::: "memory");
#pragma unroll
            for (int m = 0; m < 4; ++m)
#pragma unroll
                for (int bj = 0; bj < 2; ++bj) {
                    const f32x4 v0 = acc[ai][bj][m][0], v1 = acc[ai][bj][m][1]; const u32x4 g = gw[m][bj];
                    u32x4 w; w.x = cvtpk(v0[0] * bflo(g.x), v0[1] * bfhi(g.x)); w.y = cvtpk(v0[2] * bflo(g.y), v0[3] * bfhi(g.y));
                    w.z = cvtpk(v1[0] * bflo(g.z), v1[1] * bfhi(g.z)); w.w = cvtpk(v1[2] * bflo(g.w), v1[3] * bfhi(g.w));
                    *(u32x4*)(MG + off0 + (size_t)(ai * 128 + m * 16) * DM + bj * 128) = w;
                }
            asm volatile("" ::: "memory");
        }
        return false;
    }
};
struct EpiRes {
    const float* res; const float* gate; float* out;
    __device__ __forceinline__ bool operator()(EPI_ARGS) const {
        const int col0 = u.pn * 256 + wc * 32 + fq * 8;
        const float* gp = gate + (size_t)(u.pm >> 3) * NMOD + col0;
        const size_t off0 = (size_t)(u.pm * 256 + wr * 64 + fr) * DM + col0;
        f32x4 g0[2], g1[2];
        EPI_FOR_BJ { g0[bj] = *(const f32x4*)(gp + bj * 128); g1[bj] = *(const f32x4*)(gp + bj * 128 + 4); }
#pragma unroll
        for (int ai = 0; ai < 2; ++ai) {
            f32x4 r0[4][2], r1[4][2];
#pragma unroll
            for (int m = 0; m < 4; ++m)
#pragma unroll
                for (int bj = 0; bj < 2; ++bj) { const float* p = res + off0 + (size_t)(ai * 128 + m * 16) * DM + bj * 128; r0[m][bj] = *(const f32x4*)p; r1[m][bj] = *(const f32x4*)(p + 4); }
            asm volatile("" ::: "memory");
#pragma unroll
            for (int m = 0; m < 4; ++m)
#pragma unroll
                for (int bj = 0; bj < 2; ++bj) { float* p = out + off0 + (size_t)(ai * 128 + m * 16) * DM + bj * 128;
                    *(f32x4*)p = r0[m][bj] + g0[bj] * acc[ai][bj][m][0]; *(f32x4*)(p + 4) = r1[m][bj] + g1[bj] * acc[ai][bj][m][1]; }
            asm volatile("" ::: "memory");
        }
        return false;
    }
};
struct EpiSwiglu {
    bf16_t* HID;
    __device__ __forceinline__ bool operator()(EPI_ARGS) const {
        const int col0 = u.pn * 128 + wc * 16 + fq * 4;
        EPI_FOR_ROWS {
            bf16_t* rowp = HID + (size_t)(u.pm * 256 + ai * 128 + wr * 64 + m * 16 + fr) * FF + col0;
            EPI_FOR_BJ {
                const f32x4 a = acc[ai][bj][m][0], b = acc[ai][bj][m][1];
                u32x2 w; w.x = cvtpk(fast_silu(a[0]) * b[0], fast_silu(a[1]) * b[1]); w.y = cvtpk(fast_silu(a[2]) * b[2], fast_silu(a[3]) * b[3]);
                *(u32x2*)(rowp + bj * 64) = w;
            }
        }
        return false;
    }
};

struct Args {
    const float *x, *c, *ctx, *c_ctx, *w_mod, *b_mod, *norm1_g, *w_in, *dec_f, *dec_b, *sg_ln_g, *sg_ln_b, *sg_w, *sg_b, *w_ret_o, *w_sg_o, *w_out, *norm2_g, *w_ffn_in, *w_ffn_out, *final_g;
    float* out; unsigned char* ws;
};

__device__ __forceinline__ int src_col(int kind, int n) {
    if (kind == 1) { if (n >= 4096) return n; const int cp = n & 255, half = cp >> 7, within = cp & 127; return (n & ~255) + half * 128 + (within & 1) * 64 + (within >> 1); }
    if (kind == 2) { const int grp = n >> 3, w = n & 7; return w < 4 ? grp * 4 + w : FF + grp * 4 + (w - 4); }
    return n;
}
__device__ __forceinline__ void transpose_item(const float* W, int K, int N, bf16_t* WT, int kind, LAS float* scr, int item, int lane) {
    const int nblk = N >> 6, kb = item / nblk, nb = item - kb * nblk, k0 = kb * 64, n0 = nb * 64;
    const float* src = W + (size_t)k0 * N + src_col(kind, n0 + lane);
#pragma unroll 8
    for (int i = 0; i < 64; ++i) scr[i * 65 + lane] = src[(size_t)i * N];
    asm volatile("s_waitcnt lgkmcnt(0)" ::: "memory");
    const int c = lane & 7;
#pragma unroll
    for (int j = 0; j < 8; ++j) { const int n = (lane >> 3) + 8 * j; const LAS float* s = scr + (8 * c) * 65 + n;
        u32x4 o; o.x = cvtpk(s[0 * 65], s[1 * 65]); o.y = cvtpk(s[2 * 65], s[3 * 65]); o.z = cvtpk(s[4 * 65], s[5 * 65]); o.w = cvtpk(s[6 * 65], s[7 * 65]);
        *(u32x4*)(WT + (size_t)(n0 + n) * K + k0 + 8 * c) = o; }
    asm volatile("s_waitcnt lgkmcnt(0)" ::: "memory");
}

__device__ __forceinline__ void p0_prologue(const Args& a, LAS unsigned char* lds, int tid, int wid, int lane, int G) {
    unsigned char* ws = a.ws;
    if ((int)blockIdx.x < 192) {
        LAS float* sl = (LAS float*)lds;
        LAS float* part = (LAS float*)(lds + 73728);
        for (int i = tid; i < 9 * DM; i += 512) { const float v = i < 8 * DM ? a.c[i] : a.c_ctx[i - 8 * DM]; sl[i] = fast_silu(v); }
        __syncthreads();
        const int n = blockIdx.x * 64 + lane;
        float accv[9];
#pragma unroll
        for (int r = 0; r < 9; ++r) accv[r] = 0.f;
        const float* wp = a.w_mod + (size_t)(wid * 256) * NMOD + n;
#pragma unroll 16
        for (int k = 0; k < 256; ++k) { const float wv = wp[(size_t)k * NMOD];
#pragma unroll
            for (int r = 0; r < 9; ++r) accv[r] += sl[r * DM + wid * 256 + k] * wv; }
#pragma unroll
        for (int r = 0; r < 9; ++r) part[(wid * 9 + r) * 64 + lane] = accv[r];
        __syncthreads();
        for (int i = tid; i < 9 * 64; i += 512) { const int r = i >> 6, cc = i & 63; float s = 0.f;
#pragma unroll
            for (int w = 0; w < 8; ++w) s += part[(w * 9 + r) * 64 + cc];
            ((float*)(ws + WS_MOD))[(size_t)r * NMOD + blockIdx.x * 64 + cc] = s + a.b_mod[blockIdx.x * 64 + cc]; }
        __syncthreads();
    } else if ((int)blockIdx.x == G - 1) {
        f32x2* tab = (f32x2*)(ws + WS_ROPE);
        for (int i = tid; i < 64 * 64; i += 512) { const int pos = i >> 6, f = i & 63; const float freq = exp2f(-(float)f * (13.287712379549449f / 64.0f)); const float ang = (float)pos * freq;
            tab[i] = (f32x2){cosf(ang), sinf(ang)}; }
    } else if ((int)blockIdx.x == G - 2) {
        bf16_t* sw = (bf16_t*)(ws + WS_SGW);
        for (int i = tid; i < 8 * 128 * 128 / 2; i += 512) ((unsigned*)sw)[i] = cvtpk(a.sg_w[2 * i], a.sg_w[2 * i + 1]);
    }
    LAS float* scr = (LAS float*)(lds + wid * 16640);
    const int gw = blockIdx.x * 8 + wid, NGW = G * 8;
    constexpr int I_IN = 32 * 256, I_SQ = 32 * 32, NITEMS = I_IN + 3 * I_SQ;
    const int nfree = G > 192 ? G - 192 : 0, E = nfree * 8 * 4 < NITEMS ? nfree * 8 * 4 : NITEMS;
    const bool isfree = (int)blockIdx.x >= 192;
    for (int it = isfree ? ((int)blockIdx.x - 192) * 8 + wid : E + gw; it < NITEMS; ) {
        int r = it;
        it = (it < E) ? ((it + nfree * 8 < E) ? it + nfree * 8 : E + gw) : it + NGW;
        if (r < I_IN) { transpose_item(a.w_in, DM, DIN, (bf16_t*)(ws + WS_WIN), 1, scr, r, lane); continue; } r -= I_IN;
        if (r < I_SQ) { transpose_item(a.w_ret_o, DM, DM, (bf16_t*)(ws + WS_W3), 0, scr, r, lane); continue; } r -= I_SQ;
        if (r < I_SQ) { transpose_item(a.w_sg_o, DM, DM, (bf16_t*)(ws + WS_W3 + 8 * MiB), 0, scr, r, lane); continue; } r -= I_SQ;
        transpose_item(a.w_out, DM, DM, (bf16_t*)(ws + WS_W3 + 16 * MiB), 0, scr, r, lane);
    }
}
__device__ __forceinline__ void convert_ffn(const Args& a, LAS unsigned char* lds, int cw, int ncw, int wid, int lane) {
    LAS float* scr = (LAS float*)(lds + wid * 16640);
    constexpr int I_F1 = 32 * 176, I_F2 = 88 * 32;
    for (int it = cw; it < I_F1 + I_F2; it += ncw) {
        if (it < I_F1) transpose_item(a.w_ffn_in, DM, 2 * FF, (bf16_t*)(a.ws + WS_WF1), 2, scr, it, lane);
        else transpose_item(a.w_ffn_out, FF, DM, (bf16_t*)(a.ws + WS_WF2), 0, scr, it - I_F1, lane);
    }
}

template <bool FINAL>
__device__ __forceinline__ void rows_phase(const float* srcL, const float* srcC, int nL, int nTot, const float* g, const float* mod, int sh_off, int sc_off, void* dst, int gw, int NGW, int lane) {
    asm volatile("" : "+v"(lane));
    const int per = (nTot + NGW - 1) / NGW; const int r0 = gw * per; int r1 = r0 + per; if (r1 > nTot) r1 = nTot;
    if (r0 >= r1) return;
    f32x4 v[8], A[8], B[8]; int cur = -1;
    { const float* p = (r0 < nL ? srcL + (size_t)r0 * DM : srcC + (size_t)(r0 - nL) * DM) + lane * 4;
#pragma unroll
      for (int j = 0; j < 8; ++j) v[j] = *(const f32x4*)(p + j * 256); }
#pragma unroll 1
    for (int row = r0; row < r1; ++row) {
        f32x4 vn[8];
        const bool more = row + 1 < r1;
        if (more) { const int rn = row + 1; const float* p = (rn < nL ? srcL + (size_t)rn * DM : srcC + (size_t)(rn - nL) * DM) + lane * 4;
#pragma unroll
            for (int j = 0; j < 8; ++j) vn[j] = *(const f32x4*)(p + j * 256); }
        const int mr = FINAL ? 0 : (row < nL ? (row >> 11) : 8);
        if (mr != cur) { cur = mr;
#pragma unroll
            for (int j = 0; j < 8; ++j) { const int o = j * 256 + lane * 4; const f32x4 gg = *(const f32x4*)(g + o);
                if (FINAL) { A[j] = gg; B[j] = (f32x4){0.f, 0.f, 0.f, 0.f}; }
                else { const float* mp = mod + (size_t)mr * NMOD + o; A[j] = gg * (*(const f32x4*)(mp + sc_off) + 1.0f); B[j] = *(const f32x4*)(mp + sh_off); } } }
        float ss = 0.f;
#pragma unroll
        for (int j = 0; j < 8; ++j) ss += (v[j][0] * v[j][0] + v[j][1] * v[j][1]) + (v[j][2] * v[j][2] + v[j][3] * v[j][3]);
        const float rstd = 1.0f / sqrtf(wave_sum(ss) * (1.0f / DM) + EPS);
#pragma unroll
        for (int j = 0; j < 8; ++j) { const int o = j * 256 + lane * 4;
            if (FINAL) *(f32x4*)((float*)dst + (size_t)row * DM + o) = v[j] * rstd * A[j];
            else { const f32x4 y = v[j] * rstd * A[j] + B[j]; u32x2 w; w.x = cvtpk(y[0], y[1]); w.y = cvtpk(y[2], y[3]); *(u32x2*)((bf16_t*)dst + (size_t)row * DM + o) = w; } }
        if (more) {
#pragma unroll
            for (int j = 0; j < 8; ++j) v[j] = vn[j]; }
    }
}

__device__ __forceinline__ s16x4 vtr(const LAS unsigned char* p) { return __builtin_bit_cast(s16x4, __builtin_amdgcn_ds_read_tr16_b64_v4i16((LAS v4i16_t*)p)); }
#define MFMA32(a, b, c) __builtin_amdgcn_mfma_f32_32x32x16_bf16((a), (b), (c), 0, 0, 0)

template <bool ISV>
__device__ __forceinline__ void ret_issue(LAS unsigned char* dst, const bf16_t* T, int wid, int lane) {
    const int rsub = lane >> 5, pc = lane & 31;
#pragma unroll
    for (int cc = 0; cc < 4; ++cc) {
        const int c = wid * 4 + cc, row = 2 * c + rsub;
        const int lc = ISV ? (pc ^ ((row & 3) << 2)) : (pc ^ (row & 15));
        __builtin_amdgcn_global_load_lds((const unsigned*)(T + (size_t)row * DM + lc * 8), (LAS unsigned*)(dst + c * 1024), 16, 0, 0);
    }
}
struct RetC { const bf16_t *Kl0, *Vl0, *Kc0, *Vc0; float lf2, lb2, gi, gi8, gb, gb8; int iabs, qr0, r, h, hf, tq, vlane, myx, pbx; };
template <bool PV, bool CTX>
__device__ __forceinline__ void ret_iter(LAS unsigned char* lds, const RetC& c, int kt, f32x16 (&O)[4], const bf16x8 (&qf)[16], int wid, int lane) {
    LAS unsigned char* xch = lds + LDS_XCH;
    asm volatile("s_waitcnt vmcnt(0) lgkmcnt(0)" ::: "memory");
    __builtin_amdgcn_s_barrier();
    asm volatile("" ::: "memory");
    if (kt + 1 < 36) { const int k1 = kt + 1; ret_issue<false>(lds + (k1 & 1) * 65536, k1 < 32 ? c.Kl0 + (size_t)(k1 * 64) * DM : c.Kc0 + (size_t)((k1 - 32) * 64) * DM, wid, lane); }
    if (kt < 36) ret_issue<true>(lds + 32768 + (kt & 1) * 65536, kt < 32 ? c.Vl0 + (size_t)(kt * 64) * DM : c.Vc0 + (size_t)((kt - 32) * 64) * DM, wid, lane);
    const LAS unsigned char* Kl = lds + (kt & 1) * 65536;
    int krow = 32 * c.hf + c.r; asm volatile("" : "+v"(krow));
    const LAS unsigned char* kb = Kl + krow * 512; const int cx = ((krow & 15) ^ c.h) << 4;
    f32x16 st;
#pragma unroll
    for (int i = 0; i < 16; ++i) st[i] = 0.f;
    bf16x8 kf[2][4];
#define RET_PIN asm volatile("" ::: "memory")
#define RET_SB __builtin_amdgcn_sched_barrier(0)
#define RET_KREAD(g) do { _Pragma("unroll") for (int j = 0; j < 4; ++j) kf[(g) & 1][j] = *(const LAS bf16x8*)(kb + ((32 * (4 * (g) + j)) ^ cx)); RET_PIN; } while (0)
#define RET_KMMA(g) do { _Pragma("unroll") for (int j = 0; j < 4; ++j) st = MFMA32(kf[(g) & 1][j], qf[4 * (g) + j], st); } while (0)
    RET_KREAD(0); RET_SB;
    RET_KREAD(1); RET_KMMA(0); RET_SB;
    RET_KREAD(2); RET_KMMA(1); RET_SB;
    RET_KREAD(3); RET_KMMA(2); RET_SB;
    if (PV) {
        const LAS unsigned char* Vl = lds + 32768 + ((kt + 1) & 1) * 65536;
        int vb = c.vlane; asm volatile("" : "+v"(vb));
        const LAS unsigned char* vbase = Vl + vb;
        const LAS unsigned char* pbase = xch + c.pbx;
        const int vo0 = ((0 ^ c.tq) & 3) << 6, vo1 = ((1 ^ c.tq) & 3) << 6, vo2 = ((2 ^ c.tq) & 3) << 6, vo3 = ((3 ^ c.tq) & 3) << 6;
        s16x4 vlo[2][4], vhi[2][4]; bf16x8 pf[2];
#define RET_VREAD(g) do { const LAS unsigned char* _p = vbase + ((g) * 16) * 512; pf[(g) & 1] = *(const LAS bf16x8*)(pbase + (g) * 1024); \
            vlo[(g) & 1][0] = vtr(_p + vo0); vhi[(g) & 1][0] = vtr(_p + vo0 + 4096); vlo[(g) & 1][1] = vtr(_p + vo1); vhi[(g) & 1][1] = vtr(_p + vo1 + 4096); \
            vlo[(g) & 1][2] = vtr(_p + vo2); vhi[(g) & 1][2] = vtr(_p + vo2 + 4096); vlo[(g) & 1][3] = vtr(_p + vo3); vhi[(g) & 1][3] = vtr(_p + vo3 + 4096); RET_PIN; } while (0)
#define RET_VMMA(g) do { _Pragma("unroll") for (int d = 0; d < 4; ++d) O[d] = MFMA32(pf[(g) & 1], __builtin_shufflevector(vlo[(g) & 1][d], vhi[(g) & 1][d], 0, 1, 2, 3, 4, 5, 6, 7), O[d]); } while (0)
        RET_VREAD(0); RET_KMMA(3); RET_SB;
        RET_VREAD(1); RET_VMMA(0); RET_SB;
        RET_VREAD(2); RET_VMMA(1); RET_SB;
        RET_VREAD(3); RET_VMMA(2); RET_SB;
        RET_VMMA(3); RET_SB;
#undef RET_VREAD
#undef RET_VMMA
    } else {
        RET_KMMA(3); RET_SB;
    }
#undef RET_KREAD
#undef RET_KMMA
#undef RET_SB
#undef RET_PIN
    {
        const int k0 = kt * 64 + 32 * c.hf;
        if (!CTX) {
            const int d0 = c.iabs - (k0 + 4 * c.h);
            if (k0 != c.qr0) {
                const bool fwd = c.qr0 > k0;
                const float m = fwd ? c.gi : c.gb, m8 = fwd ? c.gi8 : c.gb8;
                float w[4]; w[0] = __builtin_amdgcn_exp2f((float)d0 * (fwd ? c.lf2 : -c.lb2)); w[1] = w[0] * m; w[2] = w[1] * m; w[3] = w[2] * m;
#pragma unroll
                for (int q4 = 0; q4 < 4; ++q4) {
#pragma unroll
                    for (int e = 0; e < 4; ++e) { st[4 * q4 + e] *= w[e]; w[e] *= m8; } }
            } else {
#pragma unroll
                for (int i = 0; i < 16; ++i) { const int dist = d0 - ((i & 3) + 8 * (i >> 2)); const float fd = (float)dist; st[i] *= __builtin_amdgcn_exp2f(fd * (dist >= 0 ? c.lf2 : -c.lb2)); }
            }
        } else {
            const int l0 = (kt - 32) * 64 + 32 * c.hf + 4 * c.h;
            float wf[4], wb[4];
            wf[0] = __builtin_amdgcn_exp2f(c.lf2 * (float)(c.iabs + LCTX - l0)); wf[1] = wf[0] * c.gi; wf[2] = wf[1] * c.gi; wf[3] = wf[2] * c.gi;
            wb[0] = __builtin_amdgcn_exp2f(c.lb2 * (float)(SEQ + l0 - c.iabs)); wb[1] = wb[0] * c.gb; wb[2] = wb[1] * c.gb; wb[3] = wb[2] * c.gb;
#pragma unroll
            for (int q4 = 0; q4 < 4; ++q4) {
#pragma unroll
                for (int e = 0; e < 4; ++e) { st[4 * q4 + e] *= wf[e] + wb[e]; wf[e] *= c.gi8; wb[e] *= c.gb8; } }
        }
    }
    u32x4 p0, p1;
    p0.x = cvtpk(st[0], st[1]); p0.y = cvtpk(st[2], st[3]); p0.z = cvtpk(st[4], st[5]); p0.w = cvtpk(st[6], st[7]);
    p1.x = cvtpk(st[8], st[9]); p1.y = cvtpk(st[10], st[11]); p1.z = cvtpk(st[12], st[13]); p1.w = cvtpk(st[14], st[15]);
    asm volatile("s_waitcnt lgkmcnt(0)" ::: "memory");
    __builtin_amdgcn_s_barrier();
    asm volatile("" ::: "memory");
    *(LAS u32x4*)(xch + c.myx) = p0; *(LAS u32x4*)(xch + c.myx + 1024) = p1;
}

__device__ __forceinline__ void retention_unit(LAS unsigned char* lds, const Args& a, int b, int hh, int qb, int wid, int lane) {
    unsigned char* ws = a.ws;
    bf16_t* Qp = (bf16_t*)(ws + WS_Q); const bf16_t* Kp = (const bf16_t*)(ws + WS_K); const bf16_t* Vp = (const bf16_t*)(ws + WS_V);
    const bf16_t* KCp = (const bf16_t*)(ws + WS_KC); const bf16_t* VCp = (const bf16_t*)(ws + WS_VC); const bf16_t* Gp = (const bf16_t*)(ws + WS_G);
    asm volatile("" : "+v"(lane));
    const int r = lane & 31, h = lane >> 5, rg = wid >> 1, hf = wid & 1;
    RetC c;
    c.lf2 = -log1pf(expf(-a.dec_f[hh])) * 1.4426950408889634f; c.lb2 = -log1pf(expf(-a.dec_b[hh])) * 1.4426950408889634f;
    c.iabs = qb * 128 + rg * 32 + r; c.qr0 = qb * 128 + rg * 32; c.r = r; c.h = h; c.hf = hf;
    c.gi = exp2f(-c.lf2); { const float t2 = c.gi * c.gi, t4 = t2 * t2; c.gi8 = t4 * t4; } c.gb = exp2f(c.lb2); { const float t2 = c.gb * c.gb, t4 = t2 * t2; c.gb8 = t4 * t4; }
#define RET_UNI(x) x = __uint_as_float(__builtin_amdgcn_readfirstlane(__float_as_uint(x)))
    RET_UNI(c.lf2); RET_UNI(c.lb2); RET_UNI(c.gi); RET_UNI(c.gi8); RET_UNI(c.gb); RET_UNI(c.gb8);
#undef RET_UNI
    bf16x8 qf[16];
    { const bf16_t* qp = Qp + (size_t)(b * SEQ + c.iabs) * DM + hh * 256 + 8 * h;
#pragma unroll
      for (int s = 0; s < 16; ++s) qf[s] = *(const bf16x8*)(qp + 16 * s); }
    f32x16 O[4];
#pragma unroll
    for (int d = 0; d < 4; ++d)
#pragma unroll
        for (int i = 0; i < 16; ++i) O[d][i] = 0.f;
    c.Kl0 = Kp + (size_t)(b * SEQ) * DM + hh * 256; c.Vl0 = Vp + (size_t)(b * SEQ) * DM + hh * 256;
    c.Kc0 = KCp + (size_t)(b * LCTX) * DM + hh * 256; c.Vc0 = VCp + (size_t)(b * LCTX) * DM + hh * 256;
    const int tq = (lane & 15) >> 2, tp = lane & 3, g16 = (lane >> 4) & 1;
    c.tq = tq; c.vlane = (4 * h + tq) * 512 + (2 * g16 + (tp >> 1)) * 16 + (tp & 1) * 8 + hf * 256;
    c.myx = ((wid * 2) * 64 + lane) * 16; c.pbx = (((wid & ~1) * 2) * 64 + lane) * 16;
    ret_issue<false>(lds, c.Kl0, wid, lane);
    ret_iter<false, false>(lds, c, 0, O, qf, wid, lane);
#pragma unroll 1
    for (int kt = 1; kt < 32; ++kt) ret_iter<true, false>(lds, c, kt, O, qf, wid, lane);
#pragma unroll 1
    for (int kt = 32; kt <= 36; ++kt) ret_iter<true, true>(lds, c, kt, O, qf, wid, lane);
    LAS float* xs = (LAS float*)(lds + LDS_XS);
    float rs[16];
#pragma unroll
    for (int i = 0; i < 16; ++i) { float s = 0.f;
#pragma unroll
        for (int d = 0; d < 4; ++d) s += O[d][i] * O[d][i];
        s += __shfl_xor(s, 1); s += __shfl_xor(s, 2); s += __shfl_xor(s, 4); s += __shfl_xor(s, 8); s += __shfl_xor(s, 16);
        rs[i] = s; if (r == 0) xs[wid * 32 + (i & 3) + 8 * (i >> 2) + 4 * h] = s; }
    __syncthreads();
#pragma unroll
    for (int i = 0; i < 16; ++i) { const float s = rs[i] + xs[(wid ^ 1) * 32 + (i & 3) + 8 * (i >> 2) + 4 * h]; rs[i] = 1.0f / sqrtf(s * (1.0f / 256.0f) + EPS); }
    const size_t obase = (size_t)(b * SEQ + qb * 128 + rg * 32 + 4 * h) * DM + hh * 256 + hf * 128 + r;
#pragma unroll
    for (int hh2 = 0; hh2 < 2; ++hh2) {
        bf16_t gv[8][4];
#pragma unroll
        for (int ii = 0; ii < 8; ++ii) { const int i = hh2 * 8 + ii; const size_t off = obase + (size_t)((i & 3) + 8 * (i >> 2)) * DM;
#pragma unroll
            for (int d = 0; d < 4; ++d) gv[ii][d] = Gp[off + 32 * d]; }
        asm volatile("" ::: "memory");
#pragma unroll
        for (int ii = 0; ii < 8; ++ii) { const int i = hh2 * 8 + ii; const size_t off = obase + (size_t)((i & 3) + 8 * (i >> 2)) * DM;
#pragma unroll
            for (int d = 0; d < 4; ++d) Qp[off + 32 * d] = (bf16_t)(cvtpk(O[d][i] * rs[i] * bf2f(gv[ii][d]), 0.f) & 0xffffu); }
        asm volatile("" ::: "memory");
    }
}

__device__ __forceinline__ void spatial_unit(LAS unsigned char* lds, const Args& a, int b, int n, int ghalf, int tid, int wid, int lane) {
    bf16_t* Up = (bf16_t*)a.out; const bf16_t* VSp = (const bf16_t*)a.out + (size_t)MTOK * DM;
    const bf16_t* Wb = (const bf16_t*)(a.ws + WS_SGW);
    asm volatile("" : "+v"(lane)); asm volatile("" : "+v"(tid));
    LAS f32x2* stats = (LAS f32x2*)(lds + LDS_STATS);
    const int tok0 = b * SEQ + n * 128;
#pragma unroll 1
    for (int t0 = wid * 16; t0 < wid * 16 + 16; t0 += 4) {
        u32x4 w[4][4];
#pragma unroll
        for (int tt = 0; tt < 4; ++tt)
#pragma unroll
            for (int j = 0; j < 4; ++j) w[tt][j] = *(const u32x4*)(VSp + (size_t)(tok0 + t0 + tt) * DM + j * 512 + lane * 8);
#pragma unroll
        for (int tt = 0; tt < 4; ++tt) { float s = 0.f, ss = 0.f;
#pragma unroll
            for (int j = 0; j < 4; ++j)
#pragma unroll
                for (int e = 0; e < 4; ++e) { const float x0 = bflo(w[tt][j][e]), x1 = bfhi(w[tt][j][e]); s += x0 + x1; ss += x0 * x0 + x1 * x1; }
            s = wave_sum(s); ss = wave_sum(ss);
            const float mean = s * (1.0f / DM); float var = ss * (1.0f / DM) - mean * mean; var = var > 0.f ? var : 0.f;
            if (lane == 0) stats[t0 + tt] = (f32x2){mean, 1.0f / sqrtf(var + EPS)}; }
    }
    __syncthreads();
    const int r = lane & 31, h = lane >> 5, ib = wid & 3, dbh = wid >> 2;
    const int tq = (lane & 15) >> 2, tp = lane & 3, g16 = (lane >> 4) & 1;
    for (int gi = 0; gi < 4; ++gi) {
        const int g = ghalf * 4 + gi;
        { const int lc = tid & 31, ch = g * 256 + lc * 8, row0 = tid >> 5;
          u32x4 w[8];
#pragma unroll
          for (int it = 0; it < 8; ++it) w[it] = *(const u32x4*)(VSp + (size_t)(tok0 + row0 + it * 16) * DM + ch);
          const f32x4 g0 = *(const f32x4*)(a.sg_ln_g + ch), g1 = *(const f32x4*)(a.sg_ln_g + ch + 4), b0 = *(const f32x4*)(a.sg_ln_b + ch), b1 = *(const f32x4*)(a.sg_ln_b + ch + 4);
#pragma unroll
          for (int it = 0; it < 8; ++it) { const int row = row0 + it * 16; const f32x2 st = stats[row];
            u32x4 o;
            o.x = cvtpk((bflo(w[it].x) - st.x) * st.y * g0[0] + b0[0], (bfhi(w[it].x) - st.x) * st.y * g0[1] + b0[1]);
            o.y = cvtpk((bflo(w[it].y) - st.x) * st.y * g0[2] + b0[2], (bfhi(w[it].y) - st.x) * st.y * g0[3] + b0[3]);
            o.z = cvtpk((bflo(w[it].z) - st.x) * st.y * g1[0] + b1[0], (bfhi(w[it].z) - st.x) * st.y * g1[1] + b1[1]);
            o.w = cvtpk((bflo(w[it].w) - st.x) * st.y * g1[2] + b1[2], (bfhi(w[it].w) - st.x) * st.y * g1[3] + b1[3]);
            *(LAS u32x4*)(lds + row * 512 + ((lc ^ ((row & 3) << 2)) << 4)) = o; } }
        __syncthreads();
        f32x16 acc[4];
#pragma unroll
        for (int d = 0; d < 4; ++d)
#pragma unroll
            for (int i = 0; i < 16; ++i) acc[d][i] = 0.f;
        const bf16_t* wrow = Wb + (size_t)g * 16384 + (size_t)(ib * 32 + r) * 128 + 8 * h;
        bf16x8 afr[8];
#pragma unroll
        for (int ks = 0; ks < 8; ++ks) afr[ks] = *(const bf16x8*)(wrow + 16 * ks);
#pragma unroll
        for (int ks = 0; ks < 8; ++ks) {
            const bf16x8 af = afr[ks];
            const LAS unsigned char* vb = lds + (16 * ks + 8 * h + tq) * 512 + (2 * g16 + (tp >> 1)) * 16 + (tp & 1) * 8;
#pragma unroll
            for (int d = 0; d < 4; ++d) { const int db = dbh * 4 + d;
                const LAS unsigned char* vp = vb + (((db ^ tq) & 3) << 6) + (db >> 2) * 256;
                const s16x4 lo = vtr(vp), hi = vtr(vp + 4 * 512);
                const bf16x8 bfr = __builtin_shufflevector(lo, hi, 0, 1, 2, 3, 4, 5, 6, 7);
                acc[d] = MFMA32(af, bfr, acc[d]); }
        }
#pragma unroll
        for (int hh2 = 0; hh2 < 2; ++hh2) {
            bf16_t uv[8][4]; float bias[8];
#pragma unroll
            for (int ii = 0; ii < 8; ++ii) { const int i = hh2 * 8 + ii, il = ib * 32 + (i & 3) + 8 * (i >> 2) + 4 * h; bias[ii] = a.sg_b[g * 128 + il];
                const size_t off = (size_t)(tok0 + il) * DM + g * 256 + dbh * 128 + r;
#pragma unroll
                for (int d = 0; d < 4; ++d) uv[ii][d] = Up[off + 32 * d]; }
            asm volatile("" ::: "memory");
#pragma unroll
            for (int ii = 0; ii < 8; ++ii) { const int i = hh2 * 8 + ii, il = ib * 32 + (i & 3) + 8 * (i >> 2) + 4 * h;
                const size_t off = (size_t)(tok0 + il) * DM + g * 256 + dbh * 128 + r;
#pragma unroll
                for (int d = 0; d < 4; ++d) Up[off + 32 * d] = (bf16_t)(cvtpk(bf2f(uv[ii][d]) * (acc[d][i] + bias[ii]), 0.f) & 0xffffu); }
            asm volatile("" ::: "memory");
        }
        __syncthreads();
    }
}

#define XB_TMO      128
#define XB_XCNT(j)  (256  + 64 * (j))
#define XB_XSUB(j)  (1280 + 64 * (j))
#define XB_XGEN(j)  (2304 + 64 * (j))
#define XB_TOP      3328
#define XB_TOPGEN   3392
#define XCD_BAR_WORDS 3456
#define XB_SPIN_CAP (1u << 22)
__device__ __forceinline__ unsigned xb_ld(unsigned* p)              { return __hip_atomic_load(p, __ATOMIC_RELAXED, __HIP_MEMORY_SCOPE_AGENT); }
__device__ __forceinline__ unsigned xb_add(unsigned* p, unsigned v) { return __hip_atomic_fetch_add(p, v, __ATOMIC_RELAXED, __HIP_MEMORY_SCOPE_AGENT); }
__device__ __forceinline__ unsigned xb_xcc_id() { return (unsigned)__builtin_amdgcn_s_getreg((3 << 11) | 20) & 0xFu; }
#define XB_SPIN(cond, bar) do { unsigned _sp = 0; while (cond) { __builtin_amdgcn_s_sleep(1); \
    if ((++_sp & 255u) == 0u) { if (xb_ld(&(bar)[XB_TMO])) break; if (_sp > XB_SPIN_CAP) { atomicAdd(&(bar)[XB_TMO], 1u); break; } } } } while (0)
struct XcdBarrier { unsigned* bar; unsigned x; volatile LAS unsigned* st; };
__device__ __forceinline__ XcdBarrier xcd_barrier_post(unsigned* bar, volatile LAS unsigned* st) {
    XcdBarrier b; b.bar = bar; b.x = xb_xcc_id(); b.st = st;
    if (threadIdx.x == 0) (void)xb_add(&bar[XB_XCNT(b.x)], 1u);
    return b;
}
__device__ __forceinline__ void xcd_barrier_complete(unsigned* bar, unsigned x, unsigned& nloc, unsigned& nx) {
    const unsigned G = gridDim.x * gridDim.y * gridDim.z;
    unsigned sum, cnt, mine, sp = 0u;
    for (;;) {
        sum = 0u; cnt = 0u; mine = 0u;
#pragma unroll
        for (unsigned j = 0; j < 16; ++j) { const unsigned c = xb_ld(&bar[XB_XCNT(j)]); sum += c; cnt += (c > 0u) ? 1u : 0u; mine = (j == x) ? c : mine; }
        if (sum == G) break;
        __builtin_amdgcn_s_sleep(1);
        if ((++sp & 255u) == 0u) { if (xb_ld(&bar[XB_TMO])) break; if (sp > XB_SPIN_CAP) { atomicAdd(&bar[XB_TMO], 1u); break; } }
    }
    nloc = mine > 0u ? mine : 1u; nx = cnt > 0u ? cnt : 1u;
}
__device__ __forceinline__ void xcd_barrier(const XcdBarrier& b) {
    asm volatile("s_waitcnt vmcnt(0)" ::: "memory");
    __syncthreads();
    if (threadIdx.x == 0) {
        unsigned* bar = b.bar;
        __builtin_amdgcn_s_waitcnt(0);
        unsigned nloc = b.st[0], nx = b.st[1];
        if (nloc == 0u) { xcd_barrier_complete(bar, b.x, nloc, nx); b.st[0] = nloc; b.st[1] = nx; }
        const unsigned old = xb_add(&bar[XB_XSUB(b.x)], 1u);
        const unsigned gen = old / nloc;
        if (old + 1u == (gen + 1u) * nloc) {
            __builtin_amdgcn_fence(__ATOMIC_RELEASE, "agent");
            asm volatile("s_waitcnt vmcnt(0)" ::: "memory");
            const unsigned og = xb_add(&bar[XB_TOP], 1u);
            const unsigned tg = og / nx;
            if (og + 1u == (tg + 1u) * nx) xb_add(&bar[XB_TOPGEN], 1u);
            else XB_SPIN(xb_ld(&bar[XB_TOPGEN]) == tg, bar);
            __builtin_amdgcn_fence(__ATOMIC_ACQUIRE, "agent");
            xb_add(&bar[XB_XGEN(b.x)], 1u);
            asm volatile("s_waitcnt vmcnt(0)" ::: "memory");
        } else {
            XB_SPIN(xb_ld(&bar[XB_XGEN(b.x)]) == gen, bar);
            __builtin_amdgcn_fence(__ATOMIC_ACQUIRE, "agent");
            asm volatile("s_waitcnt vmcnt(0)" ::: "memory");
        }
    }
    __syncthreads();
}

__global__ void __launch_bounds__(512, 2) fwd_megakernel(Args a) {
    extern __shared__ __attribute__((aligned(16))) unsigned char lds_raw[];
    LAS unsigned char* lds = (LAS unsigned char*)lds_raw;
    cg::grid_group grid = cg::this_grid();
    const int tid = threadIdx.x, wid = __builtin_amdgcn_readfirstlane(tid >> 6), lane = tid & 63;
    const int G = gridDim.x, bx = blockIdx.x;
    unsigned char* ws = a.ws;
    const float* MOD = (const float*)(ws + WS_MOD);
    const int gw = bx * 8 + wid, NGW = G * 8;

    if (tid < 4) ((LAS unsigned*)(lds + LDS_BARST))[tid] = 0u;
    __syncthreads();
    const XcdBarrier xbar = xcd_barrier_post((unsigned*)(ws + WS_BAR), (volatile LAS unsigned*)(lds + LDS_BARST));
#define GRID_BAR() xcd_barrier(xbar)
    if (a.dec_f[0] < -1e30f) grid.sync();
    p0_prologue(a, lds, tid, wid, lane, G);
    GRID_BAR();
    rows_phase<false>(a.x, a.ctx, MTOK, MTOK + MCTX, a.norm1_g, MOD, 0, DM, (void*)(ws + WS_H), gw, NGW, lane);
    GRID_BAR();
    {
        EpiIn E{(bf16_t*)(ws + WS_Q), (bf16_t*)(ws + WS_K), (bf16_t*)(ws + WS_V), (bf16_t*)(ws + WS_G), (bf16_t*)a.out, (bf16_t*)a.out + (size_t)MTOK * DM,
                (bf16_t*)(ws + WS_KC), (bf16_t*)(ws + WS_VC), (const f32x4*)(ws + WS_ROPE)};
        pg8::Gemm g{(const bf16_t*)(ws + WS_H), (const bf16_t*)(ws + WS_WIN), nullptr, nullptr, DM}; pg8::Order S; S.init(64, 48, 0, 128, G, bx);
        pg8::gemm_phase(lds, g, S, E);
        if (G == 256) { if (bx >= 128) convert_ffn(a, lds, (bx - 128) * 8 + wid, 128 * 8, wid, lane); }
        else convert_ffn(a, lds, gw, NGW, wid, lane);
    }
    GRID_BAR();
    for (int i = 0; ; ++i) {
        int b, hh, qb;
        if (G == 256) { if (i >= 4) break; const int xcd = bx & 7, j = i * 32 + (bx >> 3); hh = xcd; b = j >> 4; qb = j & 15; }
        else { const int idx = i * G + bx; if (idx >= 1024) break; b = idx >> 7; hh = (idx >> 4) & 7; qb = idx & 15; }
        retention_unit(lds, a, b, hh, qb, wid, lane);
        __syncthreads();
    }
    for (int idx = bx; idx < 256; idx += G) { spatial_unit(lds, a, idx >> 5, (idx >> 1) & 15, idx & 1, tid, wid, lane); }
    GRID_BAR();
    {
        EpiIn E{(bf16_t*)(ws + WS_Q), (bf16_t*)(ws + WS_K), (bf16_t*)(ws + WS_V), (bf16_t*)(ws + WS_G), (bf16_t*)a.out, (bf16_t*)a.out + (size_t)MTOK * DM,
                (bf16_t*)(ws + WS_KC), (bf16_t*)(ws + WS_VC), (const f32x4*)(ws + WS_ROPE)};
        pg8::Gemm g{(const bf16_t*)(ws + WS_H), (const bf16_t*)(ws + WS_WIN), nullptr, nullptr, DM}; pg8::Order S; S.init(64, 16, 48, 0, G, bx);
        pg8::gemm_phase(lds, g, S, E);
    }
    GRID_BAR();
    {
        EpiDual E{(const bf16_t*)(ws + WS_K), (const bf16_t*)(ws + WS_V), (bf16_t*)(ws + WS_G)};
        pg8::Gemm g{(const bf16_t*)(ws + WS_Q), (const bf16_t*)(ws + WS_W3), (const bf16_t*)a.out, (const bf16_t*)(ws + WS_W3 + 8 * MiB), DM}; pg8::Order S; S.init(64, 8, 0, 0, G, bx, 1);
        pg8::gemm_phase(lds, g, S, E);
    }
    GRID_BAR();
    {
        EpiRes E{a.x, MOD + 2 * DM, a.out};
        pg8::Gemm g{(const bf16_t*)(ws + WS_G), (const bf16_t*)(ws + WS_W3 + 16 * MiB), nullptr, nullptr, DM}; pg8::Order S; S.init(64, 8, 0, 0, G, bx);
        pg8::gemm_phase(lds, g, S, E);
    }
    GRID_BAR();
    rows_phase<false>(a.out, a.out, MTOK, MTOK, a.norm2_g, MOD, 3 * DM, 4 * DM, (void*)(ws + WS_Q), gw, NGW, lane);
    GRID_BAR();
    {
        EpiSwiglu E{(bf16_t*)(ws + WS_HID)};
        pg8::Gemm g{(const bf16_t*)(ws + WS_Q), (const bf16_t*)(ws + WS_WF1), nullptr, nullptr, DM}; pg8::Order S; S.init(64, 44, 0, 0, G, bx);
        pg8::gemm_phase(lds, g, S, E);
    }
    GRID_BAR();
    {
        EpiRes E{a.out, MOD + 5 * DM, a.out};
        pg8::Gemm g{(const bf16_t*)(ws + WS_HID), (const bf16_t*)(ws + WS_WF2), nullptr, nullptr, FF}; pg8::Order S; S.init(64, 8, 0, 0, G, bx);
        pg8::gemm_phase(lds, g, S, E);
    }
    GRID_BAR();
    rows_phase<true>(a.out, a.out, MTOK, MTOK, a.final_g, MOD, 0, 0, (void*)a.out, gw, NGW, lane);
}

extern "C" void kernel_launch(void* const* d_in, const int* in_sizes, int n_in, void* d_out, int out_size, void* d_ws, size_t ws_size, hipStream_t stream) {
    static int grid_blocks = 0;
    if (grid_blocks == 0) {
        if (n_in != 21 || out_size != MTOK * DM || ws_size < WS_END) { fprintf(stderr, "kernel_launch: unexpected problem (n_in %d, out %d, ws %zu)\n", n_in, out_size, ws_size); grid_blocks = -1; return; }
        int dev = 0, cus = 0, per_cu = 0;
        hipGetDevice(&dev);
        hipDeviceGetAttribute(&cus, hipDeviceAttributeMultiprocessorCount, dev);
        if (hipFuncSetAttribute((const void*)fwd_megakernel, hipFuncAttributeMaxDynamicSharedMemorySize, LDS_BYTES) != hipSuccess) { fprintf(stderr, "kernel_launch: hipFuncSetAttribute failed\n"); grid_blocks = -1; return; }
        if (hipOccupancyMaxActiveBlocksPerMultiprocessor(&per_cu, (const void*)fwd_megakernel, 512, LDS_BYTES) != hipSuccess || per_cu < 1) { fprintf(stderr, "kernel_launch: occupancy query gave %d\n", per_cu); per_cu = 1; }
        (void)hipGetLastError();
        grid_blocks = cus * (per_cu > 1 ? 1 : per_cu);
        if (grid_blocks < 1) grid_blocks = 256;
    }
    if (grid_blocks < 0) return;
    if (hipMemsetAsync((char*)d_ws + WS_BAR, 0, XCD_BAR_WORDS * 4, stream) != hipSuccess) { fprintf(stderr, "kernel_launch: memset of the barrier words failed\n"); return; }
    Args a{};
    const float** pp = (const float**)&a;
    for (int i = 0; i < 21; ++i) pp[i] = (const float*)d_in[i];
    a.out = (float*)d_out; a.ws = (unsigned char*)d_ws;
    void* args[] = {&a};
    hipError_t e = hipLaunchCooperativeKernel((const void*)fwd_megakernel, dim3(grid_blocks), dim3(512), args, LDS_BYTES, stream);
    if (e != hipSuccess) fprintf(stderr, "cooperative launch failed: %s (grid %d)\n", hipGetErrorString(e), grid_blocks);
}
```

```cpp
#include <hip/hip_runtime.h>
#include <hip/hip_cooperative_groups.h>
#include <cstdio>
#include <cstdint>
namespace cg = cooperative_groups;

#define LAS __attribute__((address_space(3)))
typedef unsigned short bf16_t;
typedef short bf16x8 __attribute__((ext_vector_type(8)));
typedef short s16x4 __attribute__((ext_vector_type(4)));
typedef short v4i16_t __attribute__((ext_vector_type(4)));
typedef float f32x2 __attribute__((ext_vector_type(2)));
typedef float f32x4 __attribute__((ext_vector_type(4)));
typedef float f32x16 __attribute__((ext_vector_type(16)));
typedef unsigned u32x2 __attribute__((ext_vector_type(2)));
typedef unsigned u32x4 __attribute__((ext_vector_type(4)));
typedef __bf16 bf16x2_t __attribute__((ext_vector_type(2)));

constexpr int DM = 2048, NB = 8, SEQ = 2048, MTOK = NB * SEQ, LCTX = 256, MCTX = NB * LCTX, NH = 8, DIN = 16384, FF = 5632, NMOD = 12288;
constexpr float EPS = 1e-6f;
constexpr size_t MiB = 1u << 20;
constexpr size_t WS_MOD = 0, WS_ROPE = 512 * 1024, WS_SGW = 576 * 1024;
constexpr size_t WS_WF1 = 1 * MiB, WS_WF2 = 45 * MiB, WS_W3 = 67 * MiB, WS_Q = 91 * MiB, WS_WIN = 155 * MiB, WS_H = 219 * MiB, WS_K = 291 * MiB, WS_V = 355 * MiB,
                 WS_KC = 419 * MiB, WS_VC = 427 * MiB, WS_G = 435 * MiB, WS_END = 499 * MiB;
constexpr size_t WS_T = WS_WIN, WS_HID = WS_WIN;
constexpr int LDS_BYTES = 153600;
constexpr int LDS_XCH = 131072, LDS_XS = 147456, LDS_STATS = 148480, LDS_BARST = 149504;
constexpr size_t WS_BAR = 896 * 1024;

__device__ __forceinline__ unsigned cvtpk(float lo, float hi) { f32x2 v = {lo, hi}; bf16x2_t b = __builtin_convertvector(v, bf16x2_t); return __builtin_bit_cast(unsigned, b); }
__device__ __forceinline__ float bflo(unsigned w) { return __uint_as_float(w << 16); }
__device__ __forceinline__ float bfhi(unsigned w) { return __uint_as_float(w & 0xffff0000u); }
__device__ __forceinline__ float bf2f(bf16_t b) { return __uint_as_float(((unsigned)b) << 16); }
__device__ __forceinline__ float fast_sigmoid(float x) { return __builtin_amdgcn_rcpf(1.0f + __builtin_amdgcn_exp2f(-1.4426950408889634f * x)); }
__device__ __forceinline__ float fast_silu(float x) { return x * fast_sigmoid(x); }
__device__ __forceinline__ float fast_gelu(float x) { const float z = 0.7978845608028654f * (x + 0.044715f * x * x * x); return x * fast_sigmoid(2.0f * z); }
__device__ __forceinline__ float wave_sum(float v) {
#pragma unroll
    for (int o = 1; o < 64; o <<= 1) v += __shfl_xor(v, o);
    return v;
}

namespace pg8 {
constexpr int BM = 256, BK = 64, HALF = 128, HTB = HALF * BK * 2, STAGE_BYTES = 8 * HTB, NXCD = 8, WGM = 8;
__host__ __device__ __forceinline__ int lds_byte(int r, int c) { const int st = (r >> 4) * 2 + (c >> 5), rr = r & 15, cc = c & 31, ob = rr * 64 + cc * 2; return st * 1024 + (ob ^ (((ob >> 9) & 1) << 5)); }
__host__ __device__ __forceinline__ void stage_rc(int b, int& R, int& C) { const int st = b / 1024, sb = b % 1024, swz = sb ^ (((sb >> 9) & 1) << 5); R = (st >> 1) * 16 + swz / 64; C = (st & 1) * 32 + (swz % 64) / 2; }
__host__ __device__ __forceinline__ int perm32(int rho) { const int n = rho >> 4, i = rho & 15; return 8 * (i >> 2) + 4 * n + (i & 3); }

struct Unit { int pm, pn, which; };
struct Gemm { const bf16_t* A; const bf16_t* Bt; const bf16_t* A2; const bf16_t* Bt2; int K; };

struct Order {
    int nM, nN, pn0, nwg, G, c, nextra, dual;
    __device__ void init(int nM_, int nN_, int pn0_, int nextra_, int G_, int c_, int dual_ = 0) { nM = nM_; nN = nN_; pn0 = pn0_; nwg = nM * nN; nextra = nextra_; G = G_; c = c_; dual = dual_; }
    __device__ bool next(int i, Unit& u) const {
        u.which = dual ? (i & 1) : 0; if (dual) i >>= 1;
        long L = (long)i * G + c;
        if (L < nwg) {
            int wgid = (int)L; { const int q = nwg / NXCD, r = nwg % NXCD, xcd = wgid % NXCD, off = wgid / NXCD; wgid = (xcd < r ? xcd * (q + 1) : r * (q + 1) + (xcd - r) * q) + off; }
            const int nig = WGM * nN, gid = wgid / nig, fm = gid * WGM, gsz = (nM - fm) < WGM ? (nM - fm) : WGM;
            u.pm = fm + ((wgid % nig) % gsz); u.pn = pn0 + (wgid % nig) / gsz; return true;
        }
        L -= nwg;
        if (L < nextra) { u.pm = 64 + (int)(L & 7); u.pn = 8 + (int)(L >> 3); return true; }
        return false;
    }
};

template <class Epi>
__device__ __forceinline__ void gemm_phase(LAS unsigned char* lds, const Gemm g, const Order& S, const Epi& E) {
    int tid_ = threadIdx.x; asm volatile("" : "+v"(tid_));
    const int tid = tid_, wid = __builtin_amdgcn_readfirstlane(tid >> 6), lane = tid & 63, wr = wid >> 2, wc = wid & 3, fr = lane & 15, fq = lane >> 4;
    const int K = g.K, nt = K / BK;
    unsigned voffA[2], voffB[2];
#pragma unroll
    for (int i = 0; i < 2; ++i) { int R, C; stage_rc(tid * 16 + i * 8192, R, C); const int Rb = (R & ~31) + perm32(R & 31);
        voffA[i] = (unsigned)(R * K + C) * 2u; voffB[i] = (unsigned)(Rb * K + C) * 2u; }
    const size_t kstep = (size_t)(BK * 2);
    const size_t hstep = (size_t)HALF * K * 2;
    const size_t tstep = 2 * hstep;
    const unsigned ldsw = (unsigned)wid * 1024u;
    const int aoff = lds_byte(wr * 64 + fr, fq * 8), boff = lds_byte(wc * 32 + fr, fq * 8);
#define PG8_SA(b, h) (((b) * 2 + (h)) * HTB)
#define PG8_SB(b, h) ((4 + (b) * 2 + (h)) * HTB)
#define PG8_STAGE(bufoff, gbase, voff) do { _Pragma("unroll") for (int _i = 0; _i < 2; ++_i) \
        __builtin_amdgcn_global_load_lds((const unsigned*)((const char*)(gbase) + (voff)[_i]), (LAS unsigned*)(lds + (bufoff) + ldsw + _i * 8192), 16, 0, 0); } while (0)
#define PG8_LDA(dst, b, h) do { _Pragma("unroll") for (int m = 0; m < 4; ++m) _Pragma("unroll") for (int k = 0; k < 2; ++k) dst[m][k] = *(const LAS bf16x8*)(lds + PG8_SA(b, h) + aoff + m * 2048 + k * 1024); } while (0)
#define PG8_LDB(dst, b, h) do { _Pragma("unroll") for (int n = 0; n < 2; ++n) _Pragma("unroll") for (int k = 0; k < 2; ++k) dst[n][k] = *(const LAS bf16x8*)(lds + PG8_SB(b, h) + boff + n * 2048 + k * 1024); } while (0)
#define PG8_MMA(ai, bj, At, Bt) do { __builtin_amdgcn_s_setprio(1); _Pragma("unroll") for (int m = 0; m < 4; ++m) _Pragma("unroll") for (int n = 0; n < 2; ++n) _Pragma("unroll") for (int k = 0; k < 2; ++k) \
        acc[ai][bj][m][n] = __builtin_amdgcn_mfma_f32_16x16x32_bf16(Bt[n][k], At[m][k], acc[ai][bj][m][n], 0, 0, 0); __builtin_amdgcn_s_setprio(0); } while (0)
#define PG8_WAIT_V(n) asm volatile("s_waitcnt vmcnt(" #n ")" ::: "memory")
#define PG8_WAIT_L(n) asm volatile("s_waitcnt lgkmcnt(" #n ")" ::: "memory")
#define PG8_BAR __builtin_amdgcn_s_barrier()
#define PG8_SCHED __builtin_amdgcn_sched_barrier(0)
    Unit cur, nxt; int ui = 0;
    if (!S.next(0, cur)) return;
    f32x4 acc[2][2][4][2];
#pragma unroll
    for (int a = 0; a < 2; ++a)
#pragma unroll
        for (int b = 0; b < 2; ++b)
#pragma unroll
            for (int m = 0; m < 4; ++m)
#pragma unroll
                for (int n = 0; n < 2; ++n) acc[a][b][m][n] = (f32x4){0.f, 0.f, 0.f, 0.f};
    bf16x8 At[4][2], B0[2][2], B1[2][2];
    const char* cA = (const char*)(cur.which ? g.A2 : g.A) + (size_t)cur.pm * tstep; const char* cB = (const char*)(cur.which ? g.Bt2 : g.Bt) + (size_t)cur.pn * tstep;
    PG8_STAGE(PG8_SB(0, 0), cB, voffB); PG8_STAGE(PG8_SB(0, 1), cB + hstep, voffB); PG8_STAGE(PG8_SA(0, 0), cA, voffA); PG8_STAGE(PG8_SA(0, 1), cA + hstep, voffA);
    if (wr == 1) PG8_BAR;
    PG8_WAIT_V(2); PG8_BAR;
    PG8_STAGE(PG8_SB(1, 0), cB + kstep, voffB); PG8_STAGE(PG8_SA(1, 0), cA + kstep, voffA); PG8_STAGE(PG8_SB(1, 1), cB + hstep + kstep, voffB);
    PG8_WAIT_V(6); PG8_BAR;
    for (;;) {
        const bool has_next = S.next(ui + 1, nxt);
        const char* nA = has_next ? (const char*)(nxt.which ? g.A2 : g.A) + (size_t)nxt.pm * tstep : cA; const char* nB = has_next ? (const char*)(nxt.which ? g.Bt2 : g.Bt) + (size_t)nxt.pn * tstep : cB;
        for (int t = 0; t < nt; t += 2) {
            const bool last = (t == nt - 2);
            const char* a1 = cA + (size_t)(t + 1) * kstep;
            const char* a2 = last ? nA : cA + (size_t)(t + 2) * kstep; const char* b2 = last ? nB : cB + (size_t)(t + 2) * kstep;
            const char* a3 = a2 + kstep; const char* b3 = b2 + kstep;
            PG8_LDB(B0, 0, 0); PG8_LDB(B1, 0, 1); PG8_SCHED; PG8_LDA(At, 0, 0); PG8_STAGE(PG8_SA(1, 1), a1 + hstep, voffA);
            PG8_WAIT_V(8); PG8_WAIT_L(0); PG8_BAR; PG8_MMA(0, 0, At, B0); PG8_MMA(0, 1, At, B1); PG8_BAR; PG8_SCHED;
            PG8_LDA(At, 0, 1); PG8_STAGE(PG8_SB(0, 0), b2, voffB); PG8_STAGE(PG8_SB(0, 1), b2 + hstep, voffB); PG8_STAGE(PG8_SA(0, 0), a2, voffA);
            PG8_WAIT_V(8); PG8_WAIT_L(0); PG8_BAR; PG8_MMA(1, 0, At, B0); PG8_MMA(1, 1, At, B1); PG8_BAR; PG8_SCHED;
            PG8_LDB(B0, 1, 0); PG8_LDB(B1, 1, 1); PG8_SCHED; PG8_LDA(At, 1, 0); PG8_STAGE(PG8_SA(0, 1), a2 + hstep, voffA);
            PG8_WAIT_V(8); PG8_WAIT_L(0); PG8_BAR; PG8_MMA(0, 0, At, B0); PG8_MMA(0, 1, At, B1); PG8_BAR; PG8_SCHED;
            PG8_LDA(At, 1, 1); PG8_STAGE(PG8_SB(1, 0), b3, voffB); PG8_STAGE(PG8_SB(1, 1), b3 + hstep, voffB); PG8_STAGE(PG8_SA(1, 0), a3, voffA);
            PG8_WAIT_V(8); PG8_WAIT_L(0); PG8_BAR; PG8_MMA(1, 0, At, B0); PG8_MMA(1, 1, At, B1); PG8_BAR; PG8_SCHED;
        }
        if (wr == 0) PG8_BAR;
        const bool keep = E(acc, cur, wr, wc, fr, fq);
        if (!has_next) break;
        if (!keep)
#pragma unroll
        for (int a = 0; a < 2; ++a)
#pragma unroll
            for (int b = 0; b < 2; ++b)
#pragma unroll
                for (int m = 0; m < 4; ++m)
#pragma unroll
                    for (int n = 0; n < 2; ++n) acc[a][b][m][n] = (f32x4){0.f, 0.f, 0.f, 0.f};
        cur = nxt; cA = nA; cB = nB; ++ui;
        if (wr == 1) PG8_BAR;
    }
    PG8_WAIT_V(0);
    PG8_BAR;
#undef PG8_SA
#undef PG8_SB
#undef PG8_STAGE
#undef PG8_LDA
#undef PG8_LDB
#undef PG8_MMA
#undef PG8_WAIT_V
#undef PG8_WAIT_L
#undef PG8_BAR
#undef PG8_SCHED
}
}
using pg8::Unit;

#define EPI_ARGS f32x4 (&acc)[2][2][4][2], const Unit& u, int wr, int wc, int fr, int fq
#define EPI_FOR_ROWS _Pragma("unroll") for (int ai = 0; ai < 2; ++ai) _Pragma("unroll") for (int m = 0; m < 4; ++m)
#define EPI_FOR_BJ _Pragma("unroll") for (int bj = 0; bj < 2; ++bj)

struct EpiIn {
    bf16_t *Q, *K, *V, *G, *U, *VS, *KC, *VC; const f32x4* rope;
    __device__ __forceinline__ bool operator()(EPI_ARGS) const {
        const int region = u.pn >> 3, hcol = (u.pn & 7) * 256;
        const bool isctx = u.pm >= 64;
        bf16_t* base; int mode; float sc = 1.0f;
        switch (region) {
            case 0: base = Q; mode = 0; break;
            case 1: base = isctx ? KC : K; mode = isctx ? 1 : 0; sc = 0.0625f; break;
            case 2: base = isctx ? VC : V; mode = 1; break;
            case 3: base = G; mode = 2; break;
            case 4: base = U; mode = 3; break;
            case 5: base = VS; mode = 3; break;
            case 6: base = K; mode = 4; break;
            default: base = V; mode = 4; break;
        }
        const int prow = isctx ? (u.pm - 64) * 256 : u.pm * 256;
        const int col0 = hcol + wc * 32 + fq * 8;
        if (mode == 0) {
            const int lbase = (u.pm & 7) * 256, tcol = wc * 8 + fq * 2;
            f32x4 tr[2][2], tc[4][2];
#pragma unroll
            for (int ai = 0; ai < 2; ++ai) { const int pos = (lbase + ai * 128 + wr * 64) >> 6; tr[ai][0] = rope[pos * 32 + tcol]; tr[ai][1] = rope[pos * 32 + tcol + 1]; }
#pragma unroll
            for (int m = 0; m < 4; ++m) { const int pos = m * 16 + fr; tc[m][0] = rope[pos * 32 + tcol]; tc[m][1] = rope[pos * 32 + tcol + 1]; }
            EPI_FOR_ROWS {
                const int rl = ai * 128 + wr * 64 + m * 16 + fr;
                bf16_t* rowp = base + (size_t)(prow + rl) * DM + col0;
                EPI_FOR_BJ {
                    const f32x4 t0 = bj == 0 ? tr[ai][0] : tc[m][0], t1 = bj == 0 ? tr[ai][1] : tc[m][1];
                    const f32x4 v0 = acc[ai][bj][m][0] * sc, v1 = acc[ai][bj][m][1] * sc;
                    u32x4 w;
                    w.x = cvtpk(v0[0] * t0[0] - v0[1] * t0[1], v0[1] * t0[0] + v0[0] * t0[1]);
                    w.y = cvtpk(v0[2] * t0[2] - v0[3] * t0[3], v0[3] * t0[2] + v0[2] * t0[3]);
                    w.z = cvtpk(v1[0] * t1[0] - v1[1] * t1[1], v1[1] * t1[0] + v1[0] * t1[1]);
                    w.w = cvtpk(v1[2] * t1[2] - v1[3] * t1[3], v1[3] * t1[2] + v1[2] * t1[3]);
                    *(u32x4*)(rowp + bj * 128) = w;
                }
            }
        } else {
            EPI_FOR_ROWS {
                const int rl = ai * 128 + wr * 64 + m * 16 + fr;
                bf16_t* rowp = base + (size_t)(prow + rl) * DM + col0;
                EPI_FOR_BJ {
                    f32x4 v0 = acc[ai][bj][m][0], v1 = acc[ai][bj][m][1];
                    if (mode == 1) { v0 = v0 * sc; v1 = v1 * sc; }
                    else if (mode == 2) {
#pragma unroll
                        for (int e = 0; e < 4; ++e) { v0[e] = fast_silu(v0[e]); v1[e] = fast_silu(v1[e]); } }
                    else if (mode == 3) {
#pragma unroll
                        for (int e = 0; e < 4; ++e) { v0[e] = fast_gelu(v0[e]); v1[e] = fast_gelu(v1[e]); } }
                    else {
#pragma unroll
                        for (int e = 0; e < 4; ++e) { v0[e] = fast_sigmoid(v0[e]); v1[e] = fast_sigmoid(v1[e]); } }
                    u32x4 w; w.x = cvtpk(v0[0], v0[1]); w.y = cvtpk(v0[2], v0[3]); w.z = cvtpk(v1[0], v1[1]); w.w = cvtpk(v1[2], v1[3]);
                    *(u32x4*)(rowp + bj * 128) = w;
                }
            }
        }
        return false;
    }
};
struct EpiDual {
    const bf16_t* GR; const bf16_t* GS; bf16_t* MG;
    __device__ __forceinline__ bool operator()(EPI_ARGS) const {
        const int col0 = u.pn * 256 + wc * 32 + fq * 8;
        const size_t off0 = (size_t)(u.pm * 256 + wr * 64 + fr) * DM + col0;
        if (u.which == 0) {
#pragma unroll
            for (int ai = 0; ai < 2; ++ai) {
                u32x4 rw[4][2], sw[4][2];
#pragma unroll
                for (int m = 0; m < 4; ++m)
#pragma unroll
                    for (int bj = 0; bj < 2; ++bj) { const size_t off = off0 + (size_t)(ai * 128 + m * 16) * DM + bj * 128; rw[m][bj] = *(const u32x4*)(GR + off); sw[m][bj] = *(const u32x4*)(GS + off); }
                asm volatile("" ::: "memory");
#pragma unroll
                for (int m = 0; m < 4; ++m)
#pragma unroll
                    for (int bj = 0; bj < 2; ++bj)
#pragma unroll
                        for (int e = 0; e < 4; ++e) {
                            const float r0 = bflo(rw[m][bj][e]) * __builtin_amdgcn_rcpf(fmaxf(bflo(sw[m][bj][e]), 1e-30f)), r1 = bfhi(rw[m][bj][e]) * __builtin_amdgcn_rcpf(fmaxf(bfhi(sw[m][bj][e]), 1e-30f));
                            acc[ai][bj][m][e >> 1][(e & 1) * 2] *= r0; acc[ai][bj][m][e >> 1][(e & 1) * 2 + 1] *= r1; }
            }
            return true;
        }
#pragma unroll
        for (int ai = 0; ai < 2; ++ai) {
            u32x4 gw[4][2];
#pragma unroll
            for (int m = 0; m < 4; ++m)
#pragma unroll
                for (int bj = 0; bj < 2; ++bj) gw[m][bj] = *(const u32x4*)(GS + off0 + (size_t)(ai * 128 + m * 16) * DM + bj * 128);
            asm volatile("" ::: "memory");
#pragma unroll
            for (int m = 0; m < 4; ++m)
#pragma unroll
                for (int bj = 0; bj < 2; ++bj) {
                    const f32x4 v0 = acc[ai][bj][m][0], v1 = acc[ai][bj][m][1]; const u32x4 g = gw[m][bj];
                    u32x4 w; w.x = cvtpk(v0[0] * bflo(g.x), v0[1] * bfhi(g.x)); w.y = cvtpk(v0[2] * bflo(g.y), v0[3] * bfhi(g.y));
                    w.z = cvtpk(v1[0] * bflo(g.z), v1[1] * bfhi(g.z)); w.w = cvtpk(v1[2] * bflo(g.w), v1[3] * bfhi(g.w));
                    *(u32x4*)(MG + off0 + (size_t)(ai * 128 + m * 16) * DM + bj * 128) = w;
                }
            asm volatile("" ::: "memory");
        }
        return false;
    }
};
struct EpiRes {
    const float* res; const float* gate; float* out;
    __device__ __forceinline__ bool operator()(EPI_ARGS) const {
        const int col0 = u.pn * 256 + wc * 32 + fq * 8;
        const float* gp = gate + (size_t)(u.pm >> 3) * NMOD + col0;
        const size_t off0 = (size_t)(u.pm * 256 + wr * 64 + fr) * DM + col0;
        f32x4 g0[2], g1[2];
        EPI_FOR_BJ { g0[bj] = *(const f32x4*)(gp + bj * 128); g1[bj] = *(const f32x4*)(gp + bj * 128 + 4); }
#pragma unroll
        for (int ai = 0; ai < 2; ++ai) {
            f32x4 r0[4][2], r1[4][2];
#pragma unroll
            for (int m = 0; m < 4; ++m)
#pragma unroll
                for (int bj = 0; bj < 2; ++bj) { const float* p = res + off0 + (size_t)(ai * 128 + m * 16) * DM + bj * 128; r0[m][bj] = *(const f32x4*)p; r1[m][bj] = *(const f32x4*)(p + 4); }
            asm volatile("" ::: "memory");
#pragma unroll
            for (int m = 0; m < 4; ++m)
#pragma unroll
                for (int bj = 0; bj < 2; ++bj) { float* p = out + off0 + (size_t)(ai * 128 + m * 16) * DM + bj * 128;
                    *(f32x4*)p = r0[m][bj] + g0[bj] * acc[ai][bj][m][0]; *(f32x4*)(p + 4) = r1[m][bj] + g1[bj] * acc[ai][bj][m][1]; }
            asm volatile("" ::: "memory");
        }
        return false;
    }
};
struct EpiSwiglu {
    bf16_t* HID;
    __device__ __forceinline__ bool operator()(EPI_ARGS) const {
        const int col0 = u.pn * 128 + wc * 16 + fq * 4;
        EPI_FOR_ROWS {
            bf16_t* rowp = HID + (size_t)(u.pm * 256 + ai * 128 + wr * 64 + m * 16 + fr) * FF + col0;
            EPI_FOR_BJ {
                const f32x4 a = acc[ai][bj][m][0], b = acc[ai][bj][m][1];
                u32x2 w; w.x = cvtpk(fast_silu(a[0]) * b[0], fast_silu(a[1]) * b[1]); w.y = cvtpk(fast_silu(a[2]) * b[2], fast_silu(a[3]) * b[3]);
                *(u32x2*)(rowp + bj * 64) = w;
            }
        }
        return false;
    }
};

struct Args {
    const float *x, *c, *ctx, *c_ctx, *w_mod, *b_mod, *norm1_g, *w_in, *dec_f, *dec_b, *sg_ln_g, *sg_ln_b, *sg_w, *sg_b, *w_ret_o, *w_sg_o, *w_out, *norm2_g, *w_ffn_in, *w_ffn_out, *final_g;
    float* out; unsigned char* ws;
};

__device__ __forceinline__ int src_col(int kind, int n) {
    if (kind == 1) { if (n >= 4096) return n; const int cp = n & 255, half = cp >> 7, within = cp & 127; return (n & ~255) + half * 128 + (within & 1) * 64 + (within >> 1); }
    if (kind == 2) { const int grp = n >> 3, w = n & 7; return w < 4 ? grp * 4 + w : FF + grp * 4 + (w - 4); }
    return n;
}
__device__ __forceinline__ void transpose_item(const float* W, int K, int N, bf16_t* WT, int kind, LAS float* scr, int item, int lane) {
    const int nblk = N >> 6, kb = item / nblk, nb = item - kb * nblk, k0 = kb * 64, n0 = nb * 64;
    const float* src = W + (size_t)k0 * N + src_col(kind, n0 + lane);
#pragma unroll 8
    for (int i = 0; i < 64; ++i) scr[i * 65 + lane] = src[(size_t)i * N];
    asm volatile("s_waitcnt lgkmcnt(0)" ::: "memory");
    const int c = lane & 7;
#pragma unroll
    for (int j = 0; j < 8; ++j) { const int n = (lane >> 3) + 8 * j; const LAS float* s = scr + (8 * c) * 65 + n;
        u32x4 o; o.x = cvtpk(s[0 * 65], s[1 * 65]); o.y = cvtpk(s[2 * 65], s[3 * 65]); o.z = cvtpk(s[4 * 65], s[5 * 65]); o.w = cvtpk(s[6 * 65], s[7 * 65]);
        *(u32x4*)(WT + (size_t)(n0 + n) * K + k0 + 8 * c) = o; }
    asm volatile("s_waitcnt lgkmcnt(0)" ::: "memory");
}

__device__ __forceinline__ void p0_prologue(const Args& a, LAS unsigned char* lds, int tid, int wid, int lane, int G) {
    unsigned char* ws = a.ws;
    if ((int)blockIdx.x < 192) {
        LAS float* sl = (LAS float*)lds;
        LAS float* part = (LAS float*)(lds + 73728);
        for (int i = tid; i < 9 * DM; i += 512) { const float v = i < 8 * DM ? a.c[i] : a.c_ctx[i - 8 * DM]; sl[i] = fast_silu(v); }
        __syncthreads();
        const int n = blockIdx.x * 64 + lane;
        float accv[9];
#pragma unroll
        for (int r = 0; r < 9; ++r) accv[r] = 0.f;
        const float* wp = a.w_mod + (size_t)(wid * 256) * NMOD + n;
#pragma unroll 16
        for (int k = 0; k < 256; ++k) { const float wv = wp[(size_t)k * NMOD];
#pragma unroll
            for (int r = 0; r < 9; ++r) accv[r] += sl[r * DM + wid * 256 + k] * wv; }
#pragma unroll
        for (int r = 0; r < 9; ++r) part[(wid * 9 + r) * 64 + lane] = accv[r];
        __syncthreads();
        for (int i = tid; i < 9 * 64; i += 512) { const int r = i >> 6, cc = i & 63; float s = 0.f;
#pragma unroll
            for (int w = 0; w < 8; ++w) s += part[(w * 9 + r) * 64 + cc];
            ((float*)(ws + WS_MOD))[(size_t)r * NMOD + blockIdx.x * 64 + cc] = s + a.b_mod[blockIdx.x * 64 + cc]; }
        __syncthreads();
    } else if ((int)blockIdx.x == G - 1) {
        f32x2* tab = (f32x2*)(ws + WS_ROPE);
        for (int i = tid; i < 64 * 64; i += 512) { const int pos = i >> 6, f = i & 63; const float freq = exp2f(-(float)f * (13.287712379549449f / 64.0f)); const float ang = (float)pos * freq;
            tab[i] = (f32x2){cosf(ang), sinf(ang)}; }
    } else if ((int)blockIdx.x == G - 2) {
        bf16_t* sw = (bf16_t*)(ws + WS_SGW);
        for (int i = tid; i < 8 * 128 * 128 / 2; i += 512) ((unsigned*)sw)[i] = cvtpk(a.sg_w[2 * i], a.sg_w[2 * i + 1]);
    }
    LAS float* scr = (LAS float*)(lds + wid * 16640);
    const int gw = blockIdx.x * 8 + wid, NGW = G * 8;
    constexpr int I_IN = 32 * 256, I_SQ = 32 * 32, NITEMS = I_IN + 3 * I_SQ;
    const int nfree = G > 192 ? G - 192 : 0, E = nfree * 8 * 4 < NITEMS ? nfree * 8 * 4 : NITEMS;
    const bool isfree = (int)blockIdx.x >= 192;
    for (int it = isfree ? ((int)blockIdx.x - 192) * 8 + wid : E + gw; it < NITEMS; ) {
        int r = it;
        it = (it < E) ? ((it + nfree * 8 < E) ? it + nfree * 8 : E + gw) : it + NGW;
        if (r < I_IN) { transpose_item(a.w_in, DM, DIN, (bf16_t*)(ws + WS_WIN), 1, scr, r, lane); continue; } r -= I_IN;
        if (r < I_SQ) { transpose_item(a.w_ret_o, DM, DM, (bf16_t*)(ws + WS_W3), 0, scr, r, lane); continue; } r -= I_SQ;
        if (r < I_SQ) { transpose_item(a.w_sg_o, DM, DM, (bf16_t*)(ws + WS_W3 + 8 * MiB), 0, scr, r, lane); continue; } r -= I_SQ;
        transpose_item(a.w_out, DM, DM, (bf16_t*)(ws + WS_W3 + 16 * MiB), 0, scr, r, lane);
    }
}
__device__ __forceinline__ void convert_ffn(const Args& a, LAS unsigned char* lds, int cw, int ncw, int wid, int lane) {
    LAS float* scr = (LAS float*)(lds + wid * 16640);
    constexpr int I_F1 = 32 * 176, I_F2 = 88 * 32;
    for (int it = cw; it < I_F1 + I_F2; it += ncw) {
        if (it < I_F1) transpose_item(a.w_ffn_in, DM, 2 * FF, (bf16_t*)(a.ws + WS_WF1), 2, scr, it, lane);
        else transpose_item(a.w_ffn_out, FF, DM, (bf16_t*)(a.ws + WS_WF2), 0, scr, it - I_F1, lane);
    }
}

template <bool FINAL>
__device__ __forceinline__ void rows_phase(const float* srcL, const float* srcC, int nL, int nTot, const float* g, const float* mod, int sh_off, int sc_off, void* dst, int gw, int NGW, int lane) {
    asm volatile("" : "+v"(lane));
    const int per = (nTot + NGW - 1) / NGW; const int r0 = gw * per; int r1 = r0 + per; if (r1 > nTot) r1 = nTot;
    if (r0 >= r1) return;
    f32x4 v[8], A[8], B[8]; int cur = -1;
    { const float* p = (r0 < nL ? srcL + (size_t)r0 * DM : srcC + (size_t)(r0 - nL) * DM) + lane * 4;
#pragma unroll
      for (int j = 0; j < 8; ++j) v[j] = *(const f32x4*)(p + j * 256); }
#pragma unroll 1
    for (int row = r0; row < r1; ++row) {
        f32x4 vn[8];
        const bool more = row + 1 < r1;
        if (more) { const int rn = row + 1; const float* p = (rn < nL ? srcL + (size_t)rn * DM : srcC + (size_t)(rn - nL) * DM) + lane * 4;
#pragma unroll
            for (int j = 0; j < 8; ++j) vn[j] = *(const f32x4*)(p + j * 256); }
        const int mr = FINAL ? 0 : (row < nL ? (row >> 11) : 8);
        if (mr != cur) { cur = mr;
#pragma unroll
            for (int j = 0; j < 8; ++j) { const int o = j * 256 + lane * 4; const f32x4 gg = *(const f32x4*)(g + o);
                if (FINAL) { A[j] = gg; B[j] = (f32x4){0.f, 0.f, 0.f, 0.f}; }
                else { const float* mp = mod + (size_t)mr * NMOD + o; A[j] = gg * (*(const f32x4*)(mp + sc_off) + 1.0f); B[j] = *(const f32x4*)(mp + sh_off); } } }
        float ss = 0.f;
#pragma unroll
        for (int j = 0; j < 8; ++j) ss += (v[j][0] * v[j][0] + v[j][1] * v[j][1]) + (v[j][2] * v[j][2] + v[j][3] * v[j][3]);
        const float rstd = 1.0f / sqrtf(wave_sum(ss) * (1.0f / DM) + EPS);
#pragma unroll
        for (int j = 0; j < 8; ++j) { const int o = j * 256 + lane * 4;
            if (FINAL) *(f32x4*)((float*)dst + (size_t)row * DM + o) = v[j] * rstd * A[j];
            else { const f32x4 y = v[j] * rstd * A[j] + B[j]; u32x2 w; w.x = cvtpk(y[0], y[1]); w.y = cvtpk(y[2], y[3]); *(u32x2*)((bf16_t*)dst + (size_t)row * DM + o) = w; } }
        if (more) {
#pragma unroll
            for (int j = 0; j < 8; ++j) v[j] = vn[j]; }
    }
}

__device__ __forceinline__ s16x4 vtr(const LAS unsigned char* p) { return __builtin_bit_cast(s16x4, __builtin_amdgcn_ds_read_tr16_b64_v4i16((LAS v4i16_t*)p)); }
#define MFMA32(a, b, c) __builtin_amdgcn_mfma_f32_32x32x16_bf16((a), (b), (c), 0, 0, 0)

__device__ __forceinline__ void glds16(const void* gsrc, unsigned lds_dst) { unsigned keep;
    asm volatile("s_mov_b32 %0, m0\n\ts_mov_b32 m0, %2\n\ts_nop 0\n\tglobal_load_lds_dwordx4 %1, off\n\ts_mov_b32 m0, %0" : "=&s"(keep) : "v"(gsrc), "s"(lds_dst) : "memory"); }
template <bool ISV>
__device__ __forceinline__ void ret_issue(LAS unsigned char* dst, const bf16_t* T, int wid, int lane) {
    const int rsub = lane >> 5, pc = lane & 31;
    const unsigned d0 = (unsigned)(__UINTPTR_TYPE__)dst;
#pragma unroll
    for (int cc = 0; cc < 4; ++cc) {
        const int c = wid * 4 + cc, row = 2 * c + rsub;
        const int lc = ISV ? (pc ^ ((row & 3) << 2)) : (pc ^ (row & 15));
        glds16(T + (size_t)row * DM + lc * 8, (unsigned)__builtin_amdgcn_readfirstlane(d0 + c * 1024));
    }
}
struct RetC { const bf16_t *Kl0, *Vl0, *Kc0, *Vc0; float lf2, lb2, gi, gi8, gb, gb8; int iabs, qr0, r, h, hf, tq, vlane, myx, pbx; };
template <bool PV, bool CTX>
__device__ __forceinline__ void ret_iter(LAS unsigned char* lds, const RetC& c, int kt, f32x16 (&O)[4], const bf16x8 (&qf)[16], int wid, int lane) {
    LAS unsigned char* xch = lds + LDS_XCH;
    asm volatile("s_waitcnt vmcnt(0) lgkmcnt(0)" ::: "memory");
    __builtin_amdgcn_s_barrier();
    asm volatile("" ::: "memory");
    if (kt + 1 < 36) { const int k1 = kt + 1; ret_issue<false>(lds + (k1 & 1) * 65536, k1 < 32 ? c.Kl0 + (size_t)(k1 * 64) * DM : c.Kc0 + (size_t)((k1 - 32) * 64) * DM, wid, lane); }
    if (kt < 36) ret_issue<true>(lds + 32768 + (kt & 1) * 65536, kt < 32 ? c.Vl0 + (size_t)(kt * 64) * DM : c.Vc0 + (size_t)((kt - 32) * 64) * DM, wid, lane);
    const LAS unsigned char* Kl = lds + (kt & 1) * 65536;
    int krow = 32 * c.hf + c.r; asm volatile("" : "+v"(krow));
    const LAS unsigned char* kb = Kl + krow * 512; const int cx = ((krow & 15) ^ c.h) << 4;
    f32x16 st;
#pragma unroll
    for (int i = 0; i < 16; ++i) st[i] = 0.f;
    bf16x8 kf[2][4];
#define RET_PIN asm volatile("" ::: "memory")
#define RET_SB __builtin_amdgcn_sched_barrier(0)
#define RET_KREAD(g) do { _Pragma("unroll") for (int j = 0; j < 4; ++j) kf[(g) & 1][j] = *(const LAS bf16x8*)(kb + ((32 * (4 * (g) + j)) ^ cx)); RET_PIN; } while (0)
#define RET_KMMA(g) do { _Pragma("unroll") for (int j = 0; j < 4; ++j) st = MFMA32(kf[(g) & 1][j], qf[4 * (g) + j], st); } while (0)
    RET_KREAD(0); RET_SB;
    RET_KREAD(1); RET_KMMA(0); RET_SB;
    RET_KREAD(2); RET_KMMA(1); RET_SB;
    RET_KREAD(3); RET_KMMA(2); RET_SB;
    if (PV) {
        const LAS unsigned char* Vl = lds + 32768 + ((kt + 1) & 1) * 65536;
        int vb = c.vlane; asm volatile("" : "+v"(vb));
        const LAS unsigned char* vbase = Vl + vb;
        const LAS unsigned char* pbase = xch + c.pbx;
        const int vo0 = ((0 ^ c.tq) & 3) << 6, vo1 = ((1 ^ c.tq) & 3) << 6, vo2 = ((2 ^ c.tq) & 3) << 6, vo3 = ((3 ^ c.tq) & 3) << 6;
        s16x4 vlo[2][4], vhi[2][4]; bf16x8 pf[2];
#define RET_VREAD(g) do { const LAS unsigned char* _p = vbase + ((g) * 16) * 512; pf[(g) & 1] = *(const LAS bf16x8*)(pbase + (g) * 1024); \
            vlo[(g) & 1][0] = vtr(_p + vo0); vhi[(g) & 1][0] = vtr(_p + vo0 + 4096); vlo[(g) & 1][1] = vtr(_p + vo1); vhi[(g) & 1][1] = vtr(_p + vo1 + 4096); \
            vlo[(g) & 1][2] = vtr(_p + vo2); vhi[(g) & 1][2] = vtr(_p + vo2 + 4096); vlo[(g) & 1][3] = vtr(_p + vo3); vhi[(g) & 1][3] = vtr(_p + vo3 + 4096); RET_PIN; } while (0)
#define RET_VMMA(g) do { _Pragma("unroll") for (int d = 0; d < 4; ++d) O[d] = MFMA32(pf[(g) & 1], __builtin_shufflevector(vlo[(g) & 1][d], vhi[(g) & 1][d], 0, 1, 2, 3, 4, 5, 6, 7), O[d]); } while (0)
        RET_VREAD(0); RET_KMMA(3); RET_SB;
        RET_VREAD(1); RET_VMMA(0); RET_SB;
        RET_VREAD(2); RET_VMMA(1); RET_SB;
        RET_VREAD(3); RET_VMMA(2); RET_SB;
        RET_VMMA(3); RET_SB;
#undef RET_VREAD
#undef RET_VMMA
    } else {
        RET_KMMA(3); RET_SB;
    }
#undef RET_KREAD
#undef RET_KMMA
#undef RET_SB
#undef RET_PIN
    {
        const int k0 = kt * 64 + 32 * c.hf;
        if (!CTX) {
            const int d0 = c.iabs - (k0 + 4 * c.h);
            if (k0 != c.qr0) {
                const bool fwd = c.qr0 > k0;
                const float m = fwd ? c.gi : c.gb, m8 = fwd ? c.gi8 : c.gb8;
                float w[4]; w[0] = __builtin_amdgcn_exp2f((float)d0 * (fwd ? c.lf2 : -c.lb2)); w[1] = w[0] * m; w[2] = w[1] * m; w[3] = w[2] * m;
#pragma unroll
                for (int q4 = 0; q4 < 4; ++q4) {
#pragma unroll
                    for (int e = 0; e < 4; ++e) { st[4 * q4 + e] *= w[e]; w[e] *= m8; } }
            } else {
#pragma unroll
                for (int i = 0; i < 16; ++i) { const int dist = d0 - ((i & 3) + 8 * (i >> 2)); const float fd = (float)dist; st[i] *= __builtin_amdgcn_exp2f(fd * (dist >= 0 ? c.lf2 : -c.lb2)); }
            }
        } else {
            const int l0 = (kt - 32) * 64 + 32 * c.hf + 4 * c.h;
            float wf[4], wb[4];
            wf[0] = __builtin_amdgcn_exp2f(c.lf2 * (float)(c.iabs + LCTX - l0)); wf[1] = wf[0] * c.gi; wf[2] = wf[1] * c.gi; wf[3] = wf[2] * c.gi;
            wb[0] = __builtin_amdgcn_exp2f(c.lb2 * (float)(SEQ + l0 - c.iabs)); wb[1] = wb[0] * c.gb; wb[2] = wb[1] * c.gb; wb[3] = wb[2] * c.gb;
#pragma unroll
            for (int q4 = 0; q4 < 4; ++q4) {
#pragma unroll
                for (int e = 0; e < 4; ++e) { st[4 * q4 + e] *= wf[e] + wb[e]; wf[e] *= c.gi8; wb[e] *= c.gb8; } }
        }
    }
    u32x4 p0, p1;
    p0.x = cvtpk(st[0], st[1]); p0.y = cvtpk(st[2], st[3]); p0.z = cvtpk(st[4], st[5]); p0.w = cvtpk(st[6], st[7]);
    p1.x = cvtpk(st[8], st[9]); p1.y = cvtpk(st[10], st[11]); p1.z = cvtpk(st[12], st[13]); p1.w = cvtpk(st[14], st[15]);
    asm volatile("s_waitcnt lgkmcnt(0)" ::: "memory");
    __builtin_amdgcn_s_barrier();
    asm volatile("" ::: "memory");
    *(LAS u32x4*)(xch + c.myx) = p0; *(LAS u32x4*)(xch + c.myx + 1024) = p1;
}

__device__ __forceinline__ void retention_unit(LAS unsigned char* lds, const Args& a, int b, int hh, int qb, int wid, int lane) {
    unsigned char* ws = a.ws;
    bf16_t* Qp = (bf16_t*)(ws + WS_Q); const bf16_t* Kp = (const bf16_t*)(ws + WS_K); const bf16_t* Vp = (const bf16_t*)(ws + WS_V);
    const bf16_t* KCp = (const bf16_t*)(ws + WS_KC); const bf16_t* VCp = (const bf16_t*)(ws + WS_VC); const bf16_t* Gp = (const bf16_t*)(ws + WS_G);
    asm volatile("" : "+v"(lane));
    const int r = lane & 31, h = lane >> 5, rg = wid >> 1, hf = wid & 1;
    RetC c;
    c.lf2 = -log1pf(expf(-a.dec_f[hh])) * 1.4426950408889634f; c.lb2 = -log1pf(expf(-a.dec_b[hh])) * 1.4426950408889634f;
    c.iabs = qb * 128 + rg * 32 + r; c.qr0 = qb * 128 + rg * 32; c.r = r; c.h = h; c.hf = hf;
    c.gi = exp2f(-c.lf2); { const float t2 = c.gi * c.gi, t4 = t2 * t2; c.gi8 = t4 * t4; } c.gb = exp2f(c.lb2); { const float t2 = c.gb * c.gb, t4 = t2 * t2; c.gb8 = t4 * t4; }
#define RET_UNI(x) x = __uint_as_float(__builtin_amdgcn_readfirstlane(__float_as_uint(x)))
    RET_UNI(c.lf2); RET_UNI(c.lb2); RET_UNI(c.gi); RET_UNI(c.gi8); RET_UNI(c.gb); RET_UNI(c.gb8);
#undef RET_UNI
    bf16x8 qf[16];
    { const bf16_t* qp = Qp + (size_t)(b * SEQ + c.iabs) * DM + hh * 256 + 8 * h;
#pragma unroll
      for (int s = 0; s < 16; ++s) qf[s] = *(const bf16x8*)(qp + 16 * s); }
    f32x16 O[4];
#pragma unroll
    for (int d = 0; d < 4; ++d)
#pragma unroll
        for (int i = 0; i < 16; ++i) O[d][i] = 0.f;
    c.Kl0 = Kp + (size_t)(b * SEQ) * DM + hh * 256; c.Vl0 = Vp + (size_t)(b * SEQ) * DM + hh * 256;
    c.Kc0 = KCp + (size_t)(b * LCTX) * DM + hh * 256; c.Vc0 = VCp + (size_t)(b * LCTX) * DM + hh * 256;
    const int tq = (lane & 15) >> 2, tp = lane & 3, g16 = (lane >> 4) & 1;
    c.tq = tq; c.vlane = (4 * h + tq) * 512 + (2 * g16 + (tp >> 1)) * 16 + (tp & 1) * 8 + hf * 256;
    c.myx = ((wid * 2) * 64 + lane) * 16; c.pbx = (((wid & ~1) * 2) * 64 + lane) * 16;
    ret_issue<false>(lds, c.Kl0, wid, lane);
    ret_iter<false, false>(lds, c, 0, O, qf, wid, lane);
#pragma unroll 1
    for (int kt = 1; kt < 32; ++kt) ret_iter<true, false>(lds, c, kt, O, qf, wid, lane);
#pragma unroll 1
    for (int kt = 32; kt <= 36; ++kt) ret_iter<true, true>(lds, c, kt, O, qf, wid, lane);
    LAS float* xs = (LAS float*)(lds + LDS_XS);
    float rs[16];
#pragma unroll
    for (int i = 0; i < 16; ++i) { float s = 0.f;
#pragma unroll
        for (int d = 0; d < 4; ++d) s += O[d][i] * O[d][i];
        s += __shfl_xor(s, 1); s += __shfl_xor(s, 2); s += __shfl_xor(s, 4); s += __shfl_xor(s, 8); s += __shfl_xor(s, 16);
        rs[i] = s; if (r == 0) xs[wid * 32 + (i & 3) + 8 * (i >> 2) + 4 * h] = s; }
    __syncthreads();
#pragma unroll
    for (int i = 0; i < 16; ++i) { const float s = rs[i] + xs[(wid ^ 1) * 32 + (i & 3) + 8 * (i >> 2) + 4 * h]; rs[i] = 1.0f / sqrtf(s * (1.0f / 256.0f) + EPS); }
    const size_t obase = (size_t)(b * SEQ + qb * 128 + rg * 32 + 4 * h) * DM + hh * 256 + hf * 128 + r;
#pragma unroll
    for (int hh2 = 0; hh2 < 2; ++hh2) {
        bf16_t gv[8][4];
#pragma unroll
        for (int ii = 0; ii < 8; ++ii) { const int i = hh2 * 8 + ii; const size_t off = obase + (size_t)((i & 3) + 8 * (i >> 2)) * DM;
#pragma unroll
            for (int d = 0; d < 4; ++d) gv[ii][d] = Gp[off + 32 * d]; }
        asm volatile("" ::: "memory");
#pragma unroll
        for (int ii = 0; ii < 8; ++ii) { const int i = hh2 * 8 + ii; const size_t off = obase + (size_t)((i & 3) + 8 * (i >> 2)) * DM;
#pragma unroll
            for (int d = 0; d < 4; ++d) Qp[off + 32 * d] = (bf16_t)(cvtpk(O[d][i] * rs[i] * bf2f(gv[ii][d]), 0.f) & 0xffffu); }
        asm volatile("" ::: "memory");
    }
}

__device__ __forceinline__ void spatial_unit(LAS unsigned char* lds, const Args& a, int b, int n, int ghalf, int tid, int wid, int lane) {
    bf16_t* Up = (bf16_t*)a.out; const bf16_t* VSp = (const bf16_t*)a.out + (size_t)MTOK * DM;
    const bf16_t* Wb = (const bf16_t*)(a.ws + WS_SGW);
    asm volatile("" : "+v"(lane)); asm volatile("" : "+v"(tid));
    LAS f32x2* stats = (LAS f32x2*)(lds + LDS_STATS);
    const int tok0 = b * SEQ + n * 128;
#pragma unroll 1
    for (int t0 = wid * 16; t0 < wid * 16 + 16; t0 += 4) {
        u32x4 w[4][4];
#pragma unroll
        for (int tt = 0; tt < 4; ++tt)
#pragma unroll
            for (int j = 0; j < 4; ++j) w[tt][j] = *(const u32x4*)(VSp + (size_t)(tok0 + t0 + tt) * DM + j * 512 + lane * 8);
#pragma unroll
        for (int tt = 0; tt < 4; ++tt) { float s = 0.f, ss = 0.f;
#pragma unroll
            for (int j = 0; j < 4; ++j)
#pragma unroll
                for (int e = 0; e < 4; ++e) { const float x0 = bflo(w[tt][j][e]), x1 = bfhi(w[tt][j][e]); s += x0 + x1; ss += x0 * x0 + x1 * x1; }
            s = wave_sum(s); ss = wave_sum(ss);
            const float mean = s * (1.0f / DM); float var = ss * (1.0f / DM) - mean * mean; var = var > 0.f ? var : 0.f;
            if (lane == 0) stats[t0 + tt] = (f32x2){mean, 1.0f / sqrtf(var + EPS)}; }
    }
    __syncthreads();
    const int r = lane & 31, h = lane >> 5, ib = wid & 3, dbh = wid >> 2;
    const int tq = (lane & 15) >> 2, tp = lane & 3, g16 = (lane >> 4) & 1;
    for (int gi = 0; gi < 4; ++gi) {
        const int g = ghalf * 4 + gi;
        { const int lc = tid & 31, ch = g * 256 + lc * 8, row0 = tid >> 5;
          u32x4 w[8];
#pragma unroll
          for (int it = 0; it < 8; ++it) w[it] = *(const u32x4*)(VSp + (size_t)(tok0 + row0 + it * 16) * DM + ch);
          const f32x4 g0 = *(const f32x4*)(a.sg_ln_g + ch), g1 = *(const f32x4*)(a.sg_ln_g + ch + 4), b0 = *(const f32x4*)(a.sg_ln_b + ch), b1 = *(const f32x4*)(a.sg_ln_b + ch + 4);
#pragma unroll
          for (int it = 0; it < 8; ++it) { const int row = row0 + it * 16; const f32x2 st = stats[row];
            u32x4 o;
            o.x = cvtpk((bflo(w[it].x) - st.x) * st.y * g0[0] + b0[0], (bfhi(w[it].x) - st.x) * st.y * g0[1] + b0[1]);
            o.y = cvtpk((bflo(w[it].y) - st.x) * st.y * g0[2] + b0[2], (bfhi(w[it].y) - st.x) * st.y * g0[3] + b0[3]);
            o.z = cvtpk((bflo(w[it].z) - st.x) * st.y * g1[0] + b1[0], (bfhi(w[it].z) - st.x) * st.y * g1[1] + b1[1]);
            o.w = cvtpk((bflo(w[it].w) - st.x) * st.y * g1[2] + b1[2], (bfhi(w[it].w) - st.x) * st.y * g1[3] + b1[3]);
            *(LAS u32x4*)(lds + row * 512 + ((lc ^ ((row & 3) << 2)) << 4)) = o; } }
        __syncthreads();
        f32x16 acc[4];
#pragma unroll
        for (int d = 0; d < 4; ++d)
#pragma unroll
            for (int i = 0; i < 16; ++i) acc[d][i] = 0.f;
        const bf16_t* wrow = Wb + (size_t)g * 16384 + (size_t)(ib * 32 + r) * 128 + 8 * h;
        bf16x8 afr[8];
#pragma unroll
        for (int ks = 0; ks < 8; ++ks) afr[ks] = *(const bf16x8*)(wrow + 16 * ks);
#pragma unroll
        for (int ks = 0; ks < 8; ++ks) {
            const bf16x8 af = afr[ks];
            const LAS unsigned char* vb = lds + (16 * ks + 8 * h + tq) * 512 + (2 * g16 + (tp >> 1)) * 16 + (tp & 1) * 8;
#pragma unroll
            for (int d = 0; d < 4; ++d) { const int db = dbh * 4 + d;
                const LAS unsigned char* vp = vb + (((db ^ tq) & 3) << 6) + (db >> 2) * 256;
                const s16x4 lo = vtr(vp), hi = vtr(vp + 4 * 512);
                const bf16x8 bfr = __builtin_shufflevector(lo, hi, 0, 1, 2, 3, 4, 5, 6, 7);
                acc[d] = MFMA32(af, bfr, acc[d]); }
        }
#pragma unroll
        for (int hh2 = 0; hh2 < 2; ++hh2) {
            bf16_t uv[8][4]; float bias[8];
#pragma unroll
            for (int ii = 0; ii < 8; ++ii) { const int i = hh2 * 8 + ii, il = ib * 32 + (i & 3) + 8 * (i >> 2) + 4 * h; bias[ii] = a.sg_b[g * 128 + il];
                const size_t off = (size_t)(tok0 + il) * DM + g * 256 + dbh * 128 + r;
#pragma unroll
                for (int d = 0; d < 4; ++d) uv[ii][d] = Up[off + 32 * d]; }
            asm volatile("" ::: "memory");
#pragma unroll
            for (int ii = 0; ii < 8; ++ii) { const int i = hh2 * 8 + ii, il = ib * 32 + (i & 3) + 8 * (i >> 2) + 4 * h;
                const size_t off = (size_t)(tok0 + il) * DM + g * 256 + dbh * 128 + r;
#pragma unroll
                for (int d = 0; d < 4; ++d) Up[off + 32 * d] = (bf16_t)(cvtpk(bf2f(uv[ii][d]) * (acc[d][i] + bias[ii]), 0.f) & 0xffffu); }
            asm volatile("" ::: "memory");
        }
        __syncthreads();
    }
}

#define XB_TMO      128
#define XB_XCNT(j)  (256  + 64 * (j))
#define XB_XSUB(j)  (1280 + 64 * (j))
#define XB_XGEN(j)  (2304 + 64 * (j))
#define XB_TOP      3328
#define XB_TOPGEN   3392
#define XCD_BAR_WORDS 3456
#define XB_SPIN_CAP (1u << 22)
__device__ __forceinline__ unsigned xb_ld(unsigned* p)              { return __hip_atomic_load(p, __ATOMIC_RELAXED, __HIP_MEMORY_SCOPE_AGENT); }
__device__ __forceinline__ unsigned xb_add(unsigned* p, unsigned v) { return __hip_atomic_fetch_add(p, v, __ATOMIC_RELAXED, __HIP_MEMORY_SCOPE_AGENT); }
__device__ __forceinline__ unsigned xb_xcc_id() { return (unsigned)__builtin_amdgcn_s_getreg((3 << 11) | 20) & 0xFu; }
#define XB_SPIN(cond, bar) do { unsigned _sp = 0; while (cond) { __builtin_amdgcn_s_sleep(1); \
    if ((++_sp & 255u) == 0u) { if (xb_ld(&(bar)[XB_TMO])) break; if (_sp > XB_SPIN_CAP) { atomicAdd(&(bar)[XB_TMO], 1u); break; } } } } while (0)
struct XcdBarrier { unsigned* bar; unsigned x; volatile LAS unsigned* st; };
__device__ __forceinline__ XcdBarrier xcd_barrier_post(unsigned* bar, volatile LAS unsigned* st) {
    XcdBarrier b; b.bar = bar; b.x = xb_xcc_id(); b.st = st;
    if (threadIdx.x == 0) (void)xb_add(&bar[XB_XCNT(b.x)], 1u);
    return b;
}
__device__ __forceinline__ void xcd_barrier_complete(unsigned* bar, unsigned x, unsigned& nloc, unsigned& nx) {
    const unsigned G = gridDim.x * gridDim.y * gridDim.z;
    unsigned sum, cnt, mine, sp = 0u;
    for (;;) {
        sum = 0u; cnt = 0u; mine = 0u;
#pragma unroll
        for (unsigned j = 0; j < 16; ++j) { const unsigned c = xb_ld(&bar[XB_XCNT(j)]); sum += c; cnt += (c > 0u) ? 1u : 0u; mine = (j == x) ? c : mine; }
        if (sum == G) break;
        __builtin_amdgcn_s_sleep(1);
        if ((++sp & 255u) == 0u) { if (xb_ld(&bar[XB_TMO])) break; if (sp > XB_SPIN_CAP) { atomicAdd(&bar[XB_TMO], 1u); break; } }
    }
    nloc = mine > 0u ? mine : 1u; nx = cnt > 0u ? cnt : 1u;
}
__device__ __forceinline__ void xcd_barrier(const XcdBarrier& b) {
    asm volatile("s_waitcnt vmcnt(0)" ::: "memory");
    __syncthreads();
    if (threadIdx.x == 0) {
        unsigned* bar = b.bar;
        __builtin_amdgcn_s_waitcnt(0);
        unsigned nloc = b.st[0], nx = b.st[1];
        if (nloc == 0u) { xcd_barrier_complete(bar, b.x, nloc, nx); b.st[0] = nloc; b.st[1] = nx; }
        const unsigned old = xb_add(&bar[XB_XSUB(b.x)], 1u);
        const unsigned gen = old / nloc;
        if (old + 1u == (gen + 1u) * nloc) {
            __builtin_amdgcn_fence(__ATOMIC_RELEASE, "agent");
            asm volatile("s_waitcnt vmcnt(0)" ::: "memory");
            const unsigned og = xb_add(&bar[XB_TOP], 1u);
            const unsigned tg = og / nx;
            if (og + 1u == (tg + 1u) * nx) xb_add(&bar[XB_TOPGEN], 1u);
            else XB_SPIN(xb_ld(&bar[XB_TOPGEN]) == tg, bar);
            __builtin_amdgcn_fence(__ATOMIC_ACQUIRE, "agent");
            xb_add(&bar[XB_XGEN(b.x)], 1u);
            asm volatile("s_waitcnt vmcnt(0)" ::: "memory");
        } else {
            XB_SPIN(xb_ld(&bar[XB_XGEN(b.x)]) == gen, bar);
            __builtin_amdgcn_fence(__ATOMIC_ACQUIRE, "agent");
            asm volatile("s_waitcnt vmcnt(0)" ::: "memory");
        }
    }
    __syncthreads();
}

__global__ void __launch_bounds__(512, 2) fwd_megakernel(Args a) {
    extern __shared__ __attribute__((aligned(16))) unsigned char lds_raw[];
    LAS unsigned char* lds = (LAS unsigned char*)lds_raw;
    cg::grid_group grid = cg::this_grid();
    const int tid = threadIdx.x, wid = __builtin_amdgcn_readfirstlane(tid >> 6), lane = tid & 63;
    const int G = gridDim.x, bx = blockIdx.x;
    unsigned char* ws = a.ws;
    const float* MOD = (const float*)(ws + WS_MOD);
    const int gw = bx * 8 + wid, NGW = G * 8;

    if (tid < 4) ((LAS unsigned*)(lds + LDS_BARST))[tid] = 0u;
    __syncthreads();
    const XcdBarrier xbar = xcd_barrier_post((unsigned*)(ws + WS_BAR), (volatile LAS unsigned*)(lds + LDS_BARST));
#define GRID_BAR() xcd_barrier(xbar)
    if (a.dec_f[0] < -1e30f) grid.sync();
    p0_prologue(a, lds, tid, wid, lane, G);
    GRID_BAR();
    rows_phase<false>(a.x, a.ctx, MTOK, MTOK + MCTX, a.norm1_g, MOD, 0, DM, (void*)(ws + WS_H), gw, NGW, lane);
    GRID_BAR();
    {
        EpiIn E{(bf16_t*)(ws + WS_Q), (bf16_t*)(ws + WS_K), (bf16_t*)(ws + WS_V), (bf16_t*)(ws + WS_G), (bf16_t*)a.out, (bf16_t*)a.out + (size_t)MTOK * DM,
                (bf16_t*)(ws + WS_KC), (bf16_t*)(ws + WS_VC), (const f32x4*)(ws + WS_ROPE)};
        pg8::Gemm g{(const bf16_t*)(ws + WS_H), (const bf16_t*)(ws + WS_WIN), nullptr, nullptr, DM}; pg8::Order S; S.init(64, 48, 0, 128, G, bx);
        pg8::gemm_phase(lds, g, S, E);
        if (G == 256) { if (bx >= 128) convert_ffn(a, lds, (bx - 128) * 8 + wid, 128 * 8, wid, lane); }
        else convert_ffn(a, lds, gw, NGW, wid, lane);
    }
    GRID_BAR();
    for (int i = 0; ; ++i) {
        int b, hh, qb;
        if (G == 256) { if (i >= 4) break; const int xcd = bx & 7, j = i * 32 + (bx >> 3); hh = xcd; b = j >> 4; qb = j & 15; }
        else { const int idx = i * G + bx; if (idx >= 1024) break; b = idx >> 7; hh = (idx >> 4) & 7; qb = idx & 15; }
        retention_unit(lds, a, b, hh, qb, wid, lane);
        __syncthreads();
    }
    for (int idx = bx; idx < 256; idx += G) { spatial_unit(lds, a, idx >> 5, (idx >> 1) & 15, idx & 1, tid, wid, lane); }
    GRID_BAR();
    {
        EpiIn E{(bf16_t*)(ws + WS_Q), (bf16_t*)(ws + WS_K), (bf16_t*)(ws + WS_V), (bf16_t*)(ws + WS_G), (bf16_t*)a.out, (bf16_t*)a.out + (size_t)MTOK * DM,
                (bf16_t*)(ws + WS_KC), (bf16_t*)(ws + WS_VC), (const f32x4*)(ws + WS_ROPE)};
        pg8::Gemm g{(const bf16_t*)(ws + WS_H), (const bf16_t*)(ws + WS_WIN), nullptr, nullptr, DM}; pg8::Order S; S.init(64, 16, 48, 0, G, bx);
        pg8::gemm_phase(lds, g, S, E);
    }
    GRID_BAR();
    {
        EpiDual E{(const bf16_t*)(ws + WS_K), (const bf16_t*)(ws + WS_V), (bf16_t*)(ws + WS_G)};
        pg8::Gemm g{(const bf16_t*)(ws + WS_Q), (const bf16_t*)(ws + WS_W3), (const bf16_t*)a.out, (const bf16_t*)(ws + WS_W3 + 8 * MiB), DM}; pg8::Order S; S.init(64, 8, 0, 0, G, bx, 1);
        pg8::gemm_phase(lds, g, S, E);
    }
    GRID_BAR();
    {
        EpiRes E{a.x, MOD + 2 * DM, a.out};
        pg8::Gemm g{(const bf16_t*)(ws + WS_G), (const bf16_t*)(ws + WS_W3 + 16 * MiB), nullptr, nullptr, DM}; pg8::Order S; S.init(64, 8, 0, 0, G, bx);
        pg8::gemm_phase(lds, g, S, E);
    }
    GRID_BAR();
    rows_phase<false>(a.out, a.out, MTOK, MTOK, a.norm2_g, MOD, 3 * DM, 4 * DM, (void*)(ws + WS_Q), gw, NGW, lane);
    GRID_BAR();
    {
        EpiSwiglu E{(bf16_t*)(ws + WS_HID)};
        pg8::Gemm g{(const bf16_t*)(ws + WS_Q), (const bf16_t*)(ws + WS_WF1), nullptr, nullptr, DM}; pg8::Order S; S.init(64, 44, 0, 0, G, bx);
        pg8::gemm_phase(lds, g, S, E);
    }
    GRID_BAR();
    {
        EpiRes E{a.out, MOD + 5 * DM, a.out};
        pg8::Gemm g{(const bf16_t*)(ws + WS_HID), (const bf16_t*)(ws + WS_WF2), nullptr, nullptr, FF}; pg8::Order S; S.init(64, 8, 0, 0, G, bx);
        pg8::gemm_phase(lds, g, S, E);
    }
    GRID_BAR();
    rows_phase<true>(a.out, a.out, MTOK, MTOK, a.final_g, MOD, 0, 0, (void*)a.out, gw, NGW, lane);
}

extern "C" void kernel_launch(void* const* d_in, const int* in_sizes, int n_in, void* d_out, int out_size, void* d_ws, size_t ws_size, hipStream_t stream) {
    static int grid_blocks = 0;
    if (grid_blocks == 0) {
        if (n_in != 21 || out_size != MTOK * DM || ws_size < WS_END) { fprintf(stderr, "kernel_launch: unexpected problem (n_in %d, out %d, ws %zu)\n", n_in, out_size, ws_size); grid_blocks = -1; return; }
        int dev = 0, cus = 0, per_cu = 0;
        hipGetDevice(&dev);
        hipDeviceGetAttribute(&cus, hipDeviceAttributeMultiprocessorCount, dev);
        if (hipFuncSetAttribute((const void*)fwd_megakernel, hipFuncAttributeMaxDynamicSharedMemorySize, LDS_BYTES) != hipSuccess) { fprintf(stderr, "kernel_launch: hipFuncSetAttribute failed\n"); grid_blocks = -1; return; }
        if (hipOccupancyMaxActiveBlocksPerMultiprocessor(&per_cu, (const void*)fwd_megakernel, 512, LDS_BYTES) != hipSuccess || per_cu < 1) { fprintf(stderr, "kernel_launch: occupancy query gave %d\n", per_cu); per_cu = 1; }
        (void)hipGetLastError();
        grid_blocks = cus * (per_cu > 1 ? 1 : per_cu);
        if (grid_blocks < 1) grid_blocks = 256;
    }
    if (grid_blocks < 0) return;
    if (hipMemsetAsync((char*)d_ws + WS_BAR, 0, XCD_BAR_WORDS * 4, stream) != hipSuccess) { fprintf(stderr, "kernel_launch: memset of the barrier words failed\n"); return; }
    Args a{};
    const float** pp = (const float**)&a;
    for (int i = 0; i < 21; ++i) pp[i] = (const float*)d_in[i];
    a.out = (float*)d_out; a.ws = (unsigned char*)d_ws;
    void* args[] = {&a};
    hipError_t e = hipLaunchCooperativeKernel((const void*)fwd_megakernel, dim3(grid_blocks), dim3(512), args, LDS_BYTES, stream);
    if (e != hipSuccess) fprintf(stderr, "cooperative launch failed: %s (grid %d)\n", hipGetErrorString(e), grid_blocks);
}
```

```cpp
#include <hip/hip_runtime.h>
#include <hip/hip_cooperative_groups.h>
#include <cstdio>
#include <cstdint>
namespace cg = cooperative_groups;

#define LAS __attribute__((address_space(3)))
typedef unsigned short bf16_t;
typedef short bf16x8 __attribute__((ext_vector_type(8)));
typedef short s16x4 __attribute__((ext_vector_type(4)));
typedef short v4i16_t __attribute__((ext_vector_type(4)));
typedef float f32x2 __attribute__((ext_vector_type(2)));
typedef float f32x4 __attribute__((ext_vector_type(4)));
typedef float f32x16 __attribute__((ext_vector_type(16)));
typedef unsigned u32x2 __attribute__((ext_vector_type(2)));
typedef unsigned u32x4 __attribute__((ext_vector_type(4)));
typedef __bf16 bf16x2_t __attribute__((ext_vector_type(2)));

constexpr int DM = 2048, NB = 8, SEQ = 2048, MTOK = NB * SEQ, LCTX = 256, MCTX = NB * LCTX, NH = 8, DIN = 16384, FF = 5632, NMOD = 12288;
constexpr float EPS = 1e-6f;
constexpr size_t MiB = 1u << 20;
constexpr size_t WS_MOD = 0, WS_ROPE = 512 * 1024, WS_SGW = 576 * 1024;
constexpr size_t WS_WF1 = 1 * MiB, WS_WF2 = 45 * MiB, WS_W3 = 67 * MiB, WS_Q = 91 * MiB, WS_WIN = 155 * MiB, WS_H = 219 * MiB, WS_K = 291 * MiB, WS_V = 355 * MiB,
                 WS_KC = 419 * MiB, WS_VC = 427 * MiB, WS_G = 435 * MiB, WS_ST = 499 * MiB, WS_END = 531 * MiB;
constexpr size_t WS_T = WS_WIN, WS_HID = WS_WIN;
constexpr int LDS_BYTES = 153600;
constexpr int LDS_XCH = 131072, LDS_XS = 147456, LDS_STATS = 148480, LDS_BARST = 149504;
constexpr size_t WS_BAR = 896 * 1024;

__device__ __forceinline__ unsigned cvtpk(float lo, float hi) { f32x2 v = {lo, hi}; bf16x2_t b = __builtin_convertvector(v, bf16x2_t); return __builtin_bit_cast(unsigned, b); }
__device__ __forceinline__ float bflo(unsigned w) { return __uint_as_float(w << 16); }
__device__ __forceinline__ float bfhi(unsigned w) { return __uint_as_float(w & 0xffff0000u); }
__device__ __forceinline__ float bf2f(bf16_t b) { return __uint_as_float(((unsigned)b) << 16); }
__device__ __forceinline__ float fast_sigmoid(float x) { return __builtin_amdgcn_rcpf(1.0f + __builtin_amdgcn_exp2f(-1.4426950408889634f * x)); }
__device__ __forceinline__ float fast_silu(float x) { return x * fast_sigmoid(x); }
__device__ __forceinline__ float fast_gelu(float x) { const float z = 0.7978845608028654f * (x + 0.044715f * x * x * x); return x * fast_sigmoid(2.0f * z); }
__device__ __forceinline__ float wave_sum(float v) {
#pragma unroll
    for (int o = 1; o < 64; o <<= 1) v += __shfl_xor(v, o);
    return v;
}

namespace pg8 {
constexpr int BM = 256, BK = 64, HALF = 128, HTB = HALF * BK * 2, STAGE_BYTES = 8 * HTB, NXCD = 8, WGM = 8;
__host__ __device__ __forceinline__ int lds_byte(int r, int c) { const int st = (r >> 4) * 2 + (c >> 5), rr = r & 15, cc = c & 31, ob = rr * 64 + cc * 2; return st * 1024 + (ob ^ (((ob >> 9) & 1) << 5)); }
__host__ __device__ __forceinline__ void stage_rc(int b, int& R, int& C) { const int st = b / 1024, sb = b % 1024, swz = sb ^ (((sb >> 9) & 1) << 5); R = (st >> 1) * 16 + swz / 64; C = (st & 1) * 32 + (swz % 64) / 2; }
__host__ __device__ __forceinline__ int perm32(int rho) { const int n = rho >> 4, i = rho & 15; return 8 * (i >> 2) + 4 * n + (i & 3); }

struct Unit { int pm, pn, which; };
struct Gemm { const bf16_t* A; const bf16_t* Bt; const bf16_t* A2; const bf16_t* Bt2; int K; };

struct Order {
    int nM, nN, pn0, nwg, G, c, nextra, dual;
    __device__ void init(int nM_, int nN_, int pn0_, int nextra_, int G_, int c_, int dual_ = 0) { nM = nM_; nN = nN_; pn0 = pn0_; nwg = nM * nN; nextra = nextra_; G = G_; c = c_; dual = dual_; }
    __device__ bool next(int i, Unit& u) const {
        u.which = dual ? (i & 1) : 0; if (dual) i >>= 1;
        long L = (long)i * G + c;
        if (L < nwg) {
            int wgid = (int)L; { const int q = nwg / NXCD, r = nwg % NXCD, xcd = wgid % NXCD, off = wgid / NXCD; wgid = (xcd < r ? xcd * (q + 1) : r * (q + 1) + (xcd - r) * q) + off; }
            const int nig = WGM * nN, gid = wgid / nig, fm = gid * WGM, gsz = (nM - fm) < WGM ? (nM - fm) : WGM;
            u.pm = fm + ((wgid % nig) % gsz); u.pn = pn0 + (wgid % nig) / gsz; return true;
        }
        L -= nwg;
        if (L < nextra) { u.pm = 64 + (int)(L & 7); u.pn = 8 + (int)(L >> 3); return true; }
        return false;
    }
};

template <class Epi>
__device__ __forceinline__ void gemm_phase(LAS unsigned char* lds, const Gemm g, const Order& S, const Epi& E) {
    int tid_ = threadIdx.x; asm volatile("" : "+v"(tid_));
    const int tid = tid_, wid = __builtin_amdgcn_readfirstlane(tid >> 6), lane = tid & 63, wr = wid >> 2, wc = wid & 3, fr = lane & 15, fq = lane >> 4;
    const int K = g.K, nt = K / BK;
    unsigned voffA[2], voffB[2];
#pragma unroll
    for (int i = 0; i < 2; ++i) { int R, C; stage_rc(tid * 16 + i * 8192, R, C); const int Rb = (R & ~31) + perm32(R & 31);
        voffA[i] = (unsigned)(R * K + C) * 2u; voffB[i] = (unsigned)(Rb * K + C) * 2u; }
    const size_t kstep = (size_t)(BK * 2);
    const size_t hstep = (size_t)HALF * K * 2;
    const size_t tstep = 2 * hstep;
    const unsigned ldsw = (unsigned)wid * 1024u;
    const int aoff = lds_byte(wr * 64 + fr, fq * 8), boff = lds_byte(wc * 32 + fr, fq * 8);
#define PG8_SA(b, h) (((b) * 2 + (h)) * HTB)
#define PG8_SB(b, h) ((4 + (b) * 2 + (h)) * HTB)
#define PG8_STAGE(bufoff, gbase, voff) do { _Pragma("unroll") for (int _i = 0; _i < 2; ++_i) \
        __builtin_amdgcn_global_load_lds((const unsigned*)((const char*)(gbase) + (voff)[_i]), (LAS unsigned*)(lds + (bufoff) + ldsw + _i * 8192), 16, 0, 0); } while (0)
#define PG8_LDA(dst, b, h) do { _Pragma("unroll") for (int m = 0; m < 4; ++m) _Pragma("unroll") for (int k = 0; k < 2; ++k) dst[m][k] = *(const LAS bf16x8*)(lds + PG8_SA(b, h) + aoff + m * 2048 + k * 1024); } while (0)
#define PG8_LDB(dst, b, h) do { _Pragma("unroll") for (int n = 0; n < 2; ++n) _Pragma("unroll") for (int k = 0; k < 2; ++k) dst[n][k] = *(const LAS bf16x8*)(lds + PG8_SB(b, h) + boff + n * 2048 + k * 1024); } while (0)
#define PG8_MMA(ai, bj, At, Bt) do { __builtin_amdgcn_s_setprio(1); _Pragma("unroll") for (int m = 0; m < 4; ++m) _Pragma("unroll") for (int n = 0; n < 2; ++n) _Pragma("unroll") for (int k = 0; k < 2; ++k) \
        acc[ai][bj][m][n] = __builtin_amdgcn_mfma_f32_16x16x32_bf16(Bt[n][k], At[m][k], acc[ai][bj][m][n], 0, 0, 0); __builtin_amdgcn_s_setprio(0); } while (0)
#define PG8_WAIT_V(n) asm volatile("s_waitcnt vmcnt(" #n ")" ::: "memory")
#define PG8_WAIT_L(n) asm volatile("s_waitcnt lgkmcnt(" #n ")" ::: "memory")
#define PG8_BAR __builtin_amdgcn_s_barrier()
#define PG8_SCHED __builtin_amdgcn_sched_barrier(0)
    Unit cur, nxt; int ui = 0;
    if (!S.next(0, cur)) return;
    f32x4 acc[2][2][4][2];
#pragma unroll
    for (int a = 0; a < 2; ++a)
#pragma unroll
        for (int b = 0; b < 2; ++b)
#pragma unroll
            for (int m = 0; m < 4; ++m)
#pragma unroll
                for (int n = 0; n < 2; ++n) acc[a][b][m][n] = (f32x4){0.f, 0.f, 0.f, 0.f};
    bf16x8 At[4][2], B0[2][2], B1[2][2];
    const char* cA = (const char*)(cur.which ? g.A2 : g.A) + (size_t)cur.pm * tstep; const char* cB = (const char*)(cur.which ? g.Bt2 : g.Bt) + (size_t)cur.pn * tstep;
    PG8_STAGE(PG8_SB(0, 0), cB, voffB); PG8_STAGE(PG8_SB(0, 1), cB + hstep, voffB); PG8_STAGE(PG8_SA(0, 0), cA, voffA); PG8_STAGE(PG8_SA(0, 1), cA + hstep, voffA);
    if (wr == 1) PG8_BAR;
    PG8_WAIT_V(2); PG8_BAR;
    PG8_STAGE(PG8_SB(1, 0), cB + kstep, voffB); PG8_STAGE(PG8_SA(1, 0), cA + kstep, voffA); PG8_STAGE(PG8_SB(1, 1), cB + hstep + kstep, voffB);
    PG8_WAIT_V(6); PG8_BAR;
    for (;;) {
        const bool has_next = S.next(ui + 1, nxt);
        const char* nA = has_next ? (const char*)(nxt.which ? g.A2 : g.A) + (size_t)nxt.pm * tstep : cA; const char* nB = has_next ? (const char*)(nxt.which ? g.Bt2 : g.Bt) + (size_t)nxt.pn * tstep : cB;
        for (int t = 0; t < nt; t += 2) {
            const bool last = (t == nt - 2);
            const char* a1 = cA + (size_t)(t + 1) * kstep;
            const char* a2 = last ? nA : cA + (size_t)(t + 2) * kstep; const char* b2 = last ? nB : cB + (size_t)(t + 2) * kstep;
            const char* a3 = a2 + kstep; const char* b3 = b2 + kstep;
            PG8_LDB(B0, 0, 0); PG8_LDB(B1, 0, 1); PG8_SCHED; PG8_LDA(At, 0, 0); PG8_STAGE(PG8_SA(1, 1), a1 + hstep, voffA);
            PG8_WAIT_V(8); PG8_WAIT_L(0); PG8_BAR; PG8_MMA(0, 0, At, B0); PG8_MMA(0, 1, At, B1); PG8_BAR; PG8_SCHED;
            PG8_LDA(At, 0, 1); PG8_STAGE(PG8_SB(0, 0), b2, voffB); PG8_STAGE(PG8_SB(0, 1), b2 + hstep, voffB); PG8_STAGE(PG8_SA(0, 0), a2, voffA);
            PG8_WAIT_V(8); PG8_WAIT_L(0); PG8_BAR; PG8_MMA(1, 0, At, B0); PG8_MMA(1, 1, At, B1); PG8_BAR; PG8_SCHED;
            PG8_LDB(B0, 1, 0); PG8_LDB(B1, 1, 1); PG8_SCHED; PG8_LDA(At, 1, 0); PG8_STAGE(PG8_SA(0, 1), a2 + hstep, voffA);
            PG8_WAIT_V(8); PG8_WAIT_L(0); PG8_BAR; PG8_MMA(0, 0, At, B0); PG8_MMA(0, 1, At, B1); PG8_BAR; PG8_SCHED;
            PG8_LDA(At, 1, 1); PG8_STAGE(PG8_SB(1, 0), b3, voffB); PG8_STAGE(PG8_SB(1, 1), b3 + hstep, voffB); PG8_STAGE(PG8_SA(1, 0), a3, voffA);
            PG8_WAIT_V(8); PG8_WAIT_L(0); PG8_BAR; PG8_MMA(1, 0, At, B0); PG8_MMA(1, 1, At, B1); PG8_BAR; PG8_SCHED;
        }
        if (wr == 0) PG8_BAR;
        const bool keep = E(acc, cur, wr, wc, fr, fq);
        if (!has_next) break;
        if (!keep)
#pragma unroll
        for (int a = 0; a < 2; ++a)
#pragma unroll
            for (int b = 0; b < 2; ++b)
#pragma unroll
                for (int m = 0; m < 4; ++m)
#pragma unroll
                    for (int n = 0; n < 2; ++n) acc[a][b][m][n] = (f32x4){0.f, 0.f, 0.f, 0.f};
        cur = nxt; cA = nA; cB = nB; ++ui;
        if (wr == 1) PG8_BAR;
    }
    PG8_WAIT_V(0);
    PG8_BAR;
#undef PG8_SA
#undef PG8_SB
#undef PG8_STAGE
#undef PG8_LDA
#undef PG8_LDB
#undef PG8_MMA
#undef PG8_WAIT_V
#undef PG8_WAIT_L
#undef PG8_BAR
#undef PG8_SCHED
}
}
using pg8::Unit;

#define EPI_ARGS f32x4 (&acc)[2][2][4][2], const Unit& u, int wr, int wc, int fr, int fq
#define EPI_FOR_ROWS _Pragma("unroll") for (int ai = 0; ai < 2; ++ai) _Pragma("unroll") for (int m = 0; m < 4; ++m)
#define EPI_FOR_BJ _Pragma("unroll") for (int bj = 0; bj < 2; ++bj)

struct EpiIn {
    bf16_t *Q, *K, *V, *G, *U, *VS, *KC, *VC; const f32x4* rope;
    __device__ __forceinline__ bool operator()(EPI_ARGS) const {
        const int region = u.pn >> 3, hcol = (u.pn & 7) * 256;
        const bool isctx = u.pm >= 64;
        bf16_t* base; int mode; float sc = 1.0f;
        switch (region) {
            case 0: base = Q; mode = 0; break;
            case 1: base = isctx ? KC : K; mode = isctx ? 1 : 0; sc = 0.0625f; break;
            case 2: base = isctx ? VC : V; mode = 1; break;
            case 3: base = G; mode = 2; break;
            case 4: base = U; mode = 3; break;
            case 5: base = VS; mode = 3; break;
            case 6: base = K; mode = 4; break;
            default: base = V; mode = 4; break;
        }
        const int prow = isctx ? (u.pm - 64) * 256 : u.pm * 256;
        const int col0 = hcol + wc * 32 + fq * 8;
        if (mode == 0) {
            const int lbase = (u.pm & 7) * 256, tcol = wc * 8 + fq * 2;
            f32x4 tr[2][2], tc[4][2];
#pragma unroll
            for (int ai = 0; ai < 2; ++ai) { const int pos = (lbase + ai * 128 + wr * 64) >> 6; tr[ai][0] = rope[pos * 32 + tcol]; tr[ai][1] = rope[pos * 32 + tcol + 1]; }
#pragma unroll
            for (int m = 0; m < 4; ++m) { const int pos = m * 16 + fr; tc[m][0] = rope[pos * 32 + tcol]; tc[m][1] = rope[pos * 32 + tcol + 1]; }
            EPI_FOR_ROWS {
                const int rl = ai * 128 + wr * 64 + m * 16 + fr;
                bf16_t* rowp = base + (size_t)(prow + rl) * DM + col0;
                EPI_FOR_BJ {
                    const f32x4 t0 = bj == 0 ? tr[ai][0] : tc[m][0], t1 = bj == 0 ? tr[ai][1] : tc[m][1];
                    const f32x4 v0 = acc[ai][bj][m][0] * sc, v1 = acc[ai][bj][m][1] * sc;
                    u32x4 w;
                    w.x = cvtpk(v0[0] * t0[0] - v0[1] * t0[1], v0[1] * t0[0] + v0[0] * t0[1]);
                    w.y = cvtpk(v0[2] * t0[2] - v0[3] * t0[3], v0[3] * t0[2] + v0[2] * t0[3]);
                    w.z = cvtpk(v1[0] * t1[0] - v1[1] * t1[1], v1[1] * t1[0] + v1[0] * t1[1]);
                    w.w = cvtpk(v1[2] * t1[2] - v1[3] * t1[3], v1[3] * t1[2] + v1[2] * t1[3]);
                    *(u32x4*)(rowp + bj * 128) = w;
                }
            }
        } else {
            EPI_FOR_ROWS {
                const int rl = ai * 128 + wr * 64 + m * 16 + fr;
                bf16_t* rowp = base + (size_t)(prow + rl) * DM + col0;
                EPI_FOR_BJ {
                    f32x4 v0 = acc[ai][bj][m][0], v1 = acc[ai][bj][m][1];
                    if (mode == 1) { v0 = v0 * sc; v1 = v1 * sc; }
                    else if (mode == 2) {
#pragma unroll
                        for (int e = 0; e < 4; ++e) { v0[e] = fast_silu(v0[e]); v1[e] = fast_silu(v1[e]); } }
                    else if (mode == 3) {
#pragma unroll
                        for (int e = 0; e < 4; ++e) { v0[e] = fast_gelu(v0[e]); v1[e] = fast_gelu(v1[e]); } }
                    else {
#pragma unroll
                        for (int e = 0; e < 4; ++e) { v0[e] = fast_sigmoid(v0[e]); v1[e] = fast_sigmoid(v1[e]); } }
                    u32x4 w; w.x = cvtpk(v0[0], v0[1]); w.y = cvtpk(v0[2], v0[3]); w.z = cvtpk(v1[0], v1[1]); w.w = cvtpk(v1[2], v1[3]);
                    *(u32x4*)(rowp + bj * 128) = w;
                }
            }
        }
        return false;
    }
};
struct EpiDual {
    const bf16_t* GR; const bf16_t* GS; bf16_t* MG;
    __device__ __forceinline__ bool operator()(EPI_ARGS) const {
        const int col0 = u.pn * 256 + wc * 32 + fq * 8;
        const size_t off0 = (size_t)(u.pm * 256 + wr * 64 + fr) * DM + col0;
        if (u.which == 0) {
#pragma unroll
            for (int ai = 0; ai < 2; ++ai) {
                u32x4 rw[4][2], sw[4][2];
#pragma unroll
                for (int m = 0; m < 4; ++m)
#pragma unroll
                    for (int bj = 0; bj < 2; ++bj) { const size_t off = off0 + (size_t)(ai * 128 + m * 16) * DM + bj * 128; rw[m][bj] = *(const u32x4*)(GR + off); sw[m][bj] = *(const u32x4*)(GS + off); }
                asm volatile("" ::: "memory");
#pragma unroll
                for (int m = 0; m < 4; ++m)
#pragma unroll
                    for (int bj = 0; bj < 2; ++bj)
#pragma unroll
                        for (int e = 0; e < 4; ++e) {
                            const float r0 = bflo(rw[m][bj][e]) * __builtin_amdgcn_rcpf(fmaxf(bflo(sw[m][bj][e]), 1e-30f)), r1 = bfhi(rw[m][bj][e]) * __builtin_amdgcn_rcpf(fmaxf(bfhi(sw[m][bj][e]), 1e-30f));
                            acc[ai][bj][m][e >> 1][(e & 1) * 2] *= r0; acc[ai][bj][m][e >> 1][(e & 1) * 2 + 1] *= r1; }
            }
            return true;
        }
#pragma unroll
        for (int ai = 0; ai < 2; ++ai) {
            u32x4 gw[4][2];
#pragma unroll
            for (int m = 0; m < 4; ++m)
#pragma unroll
                for (int bj = 0; bj < 2; ++bj) gw[m][bj] = *(const u32x4*)(GS + off0 + (size_t)(ai * 128 + m * 16) * DM + bj * 128);
            asm volatile("" ::: "memory");
#pragma unroll
            for (int m = 0; m < 4; ++m)
#pragma unroll
                for (int bj = 0; bj < 2; ++bj) {
                    const f32x4 v0 = acc[ai][bj][m][0], v1 = acc[ai][bj][m][1]; const u32x4 g = gw[m][bj];
                    u32x4 w; w.x = cvtpk(v0[0] * bflo(g.x), v0[1] * bfhi(g.x)); w.y = cvtpk(v0[2] * bflo(g.y), v0[3] * bfhi(g.y));
                    w.z = cvtpk(v1[0] * bflo(g.z), v1[1] * bfhi(g.z)); w.w = cvtpk(v1[2] * bflo(g.w), v1[3] * bfhi(g.w));
                    *(u32x4*)(MG + off0 + (size_t)(ai * 128 + m * 16) * DM + bj * 128) = w;
                }
            asm volatile("" ::: "memory");
        }
        return false;
    }
};
struct EpiRes {
    const float* res; const float* gate; float* out;
    __device__ __forceinline__ bool operator()(EPI_ARGS) const {
        const int col0 = u.pn * 256 + wc * 32 + fq * 8;
        const float* gp = gate + (size_t)(u.pm >> 3) * NMOD + col0;
        const size_t off0 = (size_t)(u.pm * 256 + wr * 64 + fr) * DM + col0;
        f32x4 g0[2], g1[2];
        EPI_FOR_BJ { g0[bj] = *(const f32x4*)(gp + bj * 128); g1[bj] = *(const f32x4*)(gp + bj * 128 + 4); }
#pragma unroll
        for (int ai = 0; ai < 2; ++ai) {
            f32x4 r0[4][2], r1[4][2];
#pragma unroll
            for (int m = 0; m < 4; ++m)
#pragma unroll
                for (int bj = 0; bj < 2; ++bj) { const float* p = res + off0 + (size_t)(ai * 128 + m * 16) * DM + bj * 128; r0[m][bj] = *(const f32x4*)p; r1[m][bj] = *(const f32x4*)(p + 4); }
            asm volatile("" ::: "memory");
#pragma unroll
            for (int m = 0; m < 4; ++m)
#pragma unroll
                for (int bj = 0; bj < 2; ++bj) { float* p = out + off0 + (size_t)(ai * 128 + m * 16) * DM + bj * 128;
                    *(f32x4*)p = r0[m][bj] + g0[bj] * acc[ai][bj][m][0]; *(f32x4*)(p + 4) = r1[m][bj] + g1[bj] * acc[ai][bj][m][1]; }
            asm volatile("" ::: "memory");
        }
        return false;
    }
};
struct EpiSwiglu {
    bf16_t* HID;
    __device__ __forceinline__ bool operator()(EPI_ARGS) const {
        const int col0 = u.pn * 128 + wc * 16 + fq * 4;
        EPI_FOR_ROWS {
            bf16_t* rowp = HID + (size_t)(u.pm * 256 + ai * 128 + wr * 64 + m * 16 + fr) * FF + col0;
            EPI_FOR_BJ {
                const f32x4 a = acc[ai][bj][m][0], b = acc[ai][bj][m][1];
                u32x2 w; w.x = cvtpk(fast_silu(a[0]) * b[0], fast_silu(a[1]) * b[1]); w.y = cvtpk(fast_silu(a[2]) * b[2], fast_silu(a[3]) * b[3]);
                *(u32x2*)(rowp + bj * 64) = w;
            }
        }
        return false;
    }
};

struct Args {
    const float *x, *c, *ctx, *c_ctx, *w_mod, *b_mod, *norm1_g, *w_in, *dec_f, *dec_b, *sg_ln_g, *sg_ln_b, *sg_w, *sg_b, *w_ret_o, *w_sg_o, *w_out, *norm2_g, *w_ffn_in, *w_ffn_out, *final_g;
    float* out; unsigned char* ws;
};

__device__ __forceinline__ int src_col(int kind, int n) {
    if (kind == 1) { if (n >= 4096) return n; const int cp = n & 255, half = cp >> 7, within = cp & 127; return (n & ~255) + half * 128 + (within & 1) * 64 + (within >> 1); }
    if (kind == 2) { const int grp = n >> 3, w = n & 7; return w < 4 ? grp * 4 + w : FF + grp * 4 + (w - 4); }
    return n;
}
__device__ __forceinline__ void transpose_item(const float* W, int K, int N, bf16_t* WT, int kind, LAS float* scr, int item, int lane) {
    const int nblk = N >> 6, kb = item / nblk, nb = item - kb * nblk, k0 = kb * 64, n0 = nb * 64;
    const float* src = W + (size_t)k0 * N + src_col(kind, n0 + lane);
#pragma unroll 8
    for (int i = 0; i < 64; ++i) scr[i * 65 + lane] = src[(size_t)i * N];
    asm volatile("s_waitcnt lgkmcnt(0)" ::: "memory");
    const int c = lane & 7;
#pragma unroll
    for (int j = 0; j < 8; ++j) { const int n = (lane >> 3) + 8 * j; const LAS float* s = scr + (8 * c) * 65 + n;
        u32x4 o; o.x = cvtpk(s[0 * 65], s[1 * 65]); o.y = cvtpk(s[2 * 65], s[3 * 65]); o.z = cvtpk(s[4 * 65], s[5 * 65]); o.w = cvtpk(s[6 * 65], s[7 * 65]);
        *(u32x4*)(WT + (size_t)(n0 + n) * K + k0 + 8 * c) = o; }
    asm volatile("s_waitcnt lgkmcnt(0)" ::: "memory");
}

__device__ __forceinline__ void p0_prologue(const Args& a, LAS unsigned char* lds, int tid, int wid, int lane, int G) {
    unsigned char* ws = a.ws;
    if ((int)blockIdx.x < 192) {
        LAS float* sl = (LAS float*)lds;
        LAS float* part = (LAS float*)(lds + 73728);
        for (int i = tid; i < 9 * DM; i += 512) { const float v = i < 8 * DM ? a.c[i] : a.c_ctx[i - 8 * DM]; sl[i] = fast_silu(v); }
        __syncthreads();
        const int n = blockIdx.x * 64 + lane;
        float accv[9];
#pragma unroll
        for (int r = 0; r < 9; ++r) accv[r] = 0.f;
        const float* wp = a.w_mod + (size_t)(wid * 256) * NMOD + n;
#pragma unroll 16
        for (int k = 0; k < 256; ++k) { const float wv = wp[(size_t)k * NMOD];
#pragma unroll
            for (int r = 0; r < 9; ++r) accv[r] += sl[r * DM + wid * 256 + k] * wv; }
#pragma unroll
        for (int r = 0; r < 9; ++r) part[(wid * 9 + r) * 64 + lane] = accv[r];
        __syncthreads();
        for (int i = tid; i < 9 * 64; i += 512) { const int r = i >> 6, cc = i & 63; float s = 0.f;
#pragma unroll
            for (int w = 0; w < 8; ++w) s += part[(w * 9 + r) * 64 + cc];
            ((float*)(ws + WS_MOD))[(size_t)r * NMOD + blockIdx.x * 64 + cc] = s + a.b_mod[blockIdx.x * 64 + cc]; }
        __syncthreads();
    } else if ((int)blockIdx.x == G - 1) {
        f32x2* tab = (f32x2*)(ws + WS_ROPE);
        for (int i = tid; i < 64 * 64; i += 512) { const int pos = i >> 6, f = i & 63; const float freq = exp2f(-(float)f * (13.287712379549449f / 64.0f)); const float ang = (float)pos * freq;
            tab[i] = (f32x2){cosf(ang), sinf(ang)}; }
    } else if ((int)blockIdx.x == G - 2) {
        bf16_t* sw = (bf16_t*)(ws + WS_SGW);
        for (int i = tid; i < 8 * 128 * 128 / 2; i += 512) ((unsigned*)sw)[i] = cvtpk(a.sg_w[2 * i], a.sg_w[2 * i + 1]);
    }
    LAS float* scr = (LAS float*)(lds + wid * 16640);
    const int gw = blockIdx.x * 8 + wid, NGW = G * 8;
    constexpr int I_IN = 32 * 256, I_SQ = 32 * 32, NITEMS = I_IN + 3 * I_SQ;
    const int nfree = G > 192 ? G - 192 : 0, E = nfree * 8 * 4 < NITEMS ? nfree * 8 * 4 : NITEMS;
    const bool isfree = (int)blockIdx.x >= 192;
    for (int it = isfree ? ((int)blockIdx.x - 192) * 8 + wid : E + gw; it < NITEMS; ) {
        int r = it;
        it = (it < E) ? ((it + nfree * 8 < E) ? it + nfree * 8 : E + gw) : it + NGW;
        if (r < I_IN) { transpose_item(a.w_in, DM, DIN, (bf16_t*)(ws + WS_WIN), 1, scr, r, lane); continue; } r -= I_IN;
        if (r < I_SQ) { transpose_item(a.w_ret_o, DM, DM, (bf16_t*)(ws + WS_W3), 0, scr, r, lane); continue; } r -= I_SQ;
        if (r < I_SQ) { transpose_item(a.w_sg_o, DM, DM, (bf16_t*)(ws + WS_W3 + 8 * MiB), 0, scr, r, lane); continue; } r -= I_SQ;
        transpose_item(a.w_out, DM, DM, (bf16_t*)(ws + WS_W3 + 16 * MiB), 0, scr, r, lane);
    }
}
__device__ __forceinline__ void convert_ffn(const Args& a, LAS unsigned char* lds, int cw, int ncw, int wid, int lane) {
    LAS float* scr = (LAS float*)(lds + wid * 16640);
    constexpr int I_F1 = 32 * 176, I_F2 = 88 * 32;
    for (int it = cw; it < I_F1 + I_F2; it += ncw) {
        if (it < I_F1) transpose_item(a.w_ffn_in, DM, 2 * FF, (bf16_t*)(a.ws + WS_WF1), 2, scr, it, lane);
        else transpose_item(a.w_ffn_out, FF, DM, (bf16_t*)(a.ws + WS_WF2), 0, scr, it - I_F1, lane);
    }
}

template <bool FINAL>
__device__ __forceinline__ void rows_phase(const float* srcL, const float* srcC, int nL, int nTot, const float* g, const float* mod, int sh_off, int sc_off, void* dst, int gw, int NGW, int lane) {
    asm volatile("" : "+v"(lane));
    const int per = (nTot + NGW - 1) / NGW; const int r0 = gw * per; int r1 = r0 + per; if (r1 > nTot) r1 = nTot;
    if (r0 >= r1) return;
    f32x4 v[8], A[8], B[8]; int cur = -1;
    { const float* p = (r0 < nL ? srcL + (size_t)r0 * DM : srcC + (size_t)(r0 - nL) * DM) + lane * 4;
#pragma unroll
      for (int j = 0; j < 8; ++j) v[j] = *(const f32x4*)(p + j * 256); }
#pragma unroll 1
    for (int row = r0; row < r1; ++row) {
        f32x4 vn[8];
        const bool more = row + 1 < r1;
        if (more) { const int rn = row + 1; const float* p = (rn < nL ? srcL + (size_t)rn * DM : srcC + (size_t)(rn - nL) * DM) + lane * 4;
#pragma unroll
            for (int j = 0; j < 8; ++j) vn[j] = *(const f32x4*)(p + j * 256); }
        const int mr = FINAL ? 0 : (row < nL ? (row >> 11) : 8);
        if (mr != cur) { cur = mr;
#pragma unroll
            for (int j = 0; j < 8; ++j) { const int o = j * 256 + lane * 4; const f32x4 gg = *(const f32x4*)(g + o);
                if (FINAL) { A[j] = gg; B[j] = (f32x4){0.f, 0.f, 0.f, 0.f}; }
                else { const float* mp = mod + (size_t)mr * NMOD + o; A[j] = gg * (*(const f32x4*)(mp + sc_off) + 1.0f); B[j] = *(const f32x4*)(mp + sh_off); } } }
        float ss = 0.f;
#pragma unroll
        for (int j = 0; j < 8; ++j) ss += (v[j][0] * v[j][0] + v[j][1] * v[j][1]) + (v[j][2] * v[j][2] + v[j][3] * v[j][3]);
        const float rstd = 1.0f / sqrtf(wave_sum(ss) * (1.0f / DM) + EPS);
#pragma unroll
        for (int j = 0; j < 8; ++j) { const int o = j * 256 + lane * 4;
            if (FINAL) *(f32x4*)((float*)dst + (size_t)row * DM + o) = v[j] * rstd * A[j];
            else { const f32x4 y = v[j] * rstd * A[j] + B[j]; u32x2 w; w.x = cvtpk(y[0], y[1]); w.y = cvtpk(y[2], y[3]); *(u32x2*)((bf16_t*)dst + (size_t)row * DM + o) = w; } }
        if (more) {
#pragma unroll
            for (int j = 0; j < 8; ++j) v[j] = vn[j]; }
    }
}

__device__ __forceinline__ s16x4 vtr(const LAS unsigned char* p) { return __builtin_bit_cast(s16x4, __builtin_amdgcn_ds_read_tr16_b64_v4i16((LAS v4i16_t*)p)); }
#define MFMA32(a, b, c) __builtin_amdgcn_mfma_f32_32x32x16_bf16((a), (b), (c), 0, 0, 0)

__device__ __forceinline__ void glds16(const void* gsrc, unsigned lds_dst) { unsigned keep;
    asm volatile("s_mov_b32 %0, m0\n\ts_mov_b32 m0, %2\n\ts_nop 0\n\tglobal_load_lds_dwordx4 %1, off\n\ts_mov_b32 m0, %0" : "=&s"(keep) : "v"(gsrc), "s"(lds_dst) : "memory"); }
template <bool ISV>
__device__ __forceinline__ void ret_issue(LAS unsigned char* dst, const bf16_t* T, int wid, int lane) {
    const int rsub = lane >> 5, pc = lane & 31;
    const unsigned d0 = (unsigned)(__UINTPTR_TYPE__)dst;
#pragma unroll
    for (int cc = 0; cc < 4; ++cc) {
        const int c = wid * 4 + cc, row = 2 * c + rsub;
        const int lc = ISV ? (pc ^ ((row & 3) << 2)) : (pc ^ (row & 15));
        glds16(T + (size_t)row * DM + lc * 8, (unsigned)__builtin_amdgcn_readfirstlane(d0 + c * 1024));
    }
}
struct RetC { const bf16_t *Kl0, *Vl0; float lf2, lb2, gi, gi8, gb, gb8; int iabs, qr0, r, h, hf, tq, vlane, myx, pbx, kend; };
template <bool PV, bool CTX>
__device__ __forceinline__ void ret_iter(LAS unsigned char* lds, const RetC& c, int kt, f32x16 (&O)[4], const bf16x8 (&qf)[16], int wid, int lane) {
    LAS unsigned char* xch = lds + LDS_XCH;
    asm volatile("s_waitcnt vmcnt(0) lgkmcnt(0)" ::: "memory");
    __builtin_amdgcn_s_barrier();
    asm volatile("" ::: "memory");
    if (kt + 1 < c.kend) { const int k1 = kt + 1; ret_issue<false>(lds + (k1 & 1) * 65536, c.Kl0 + (size_t)(k1 * 64) * DM, wid, lane); }
    if (kt < c.kend) ret_issue<true>(lds + 32768 + (kt & 1) * 65536, c.Vl0 + (size_t)(kt * 64) * DM, wid, lane);
    const LAS unsigned char* Kl = lds + (kt & 1) * 65536;
    int krow = 32 * c.hf + c.r; asm volatile("" : "+v"(krow));
    const LAS unsigned char* kb = Kl + krow * 512; const int cx = ((krow & 15) ^ c.h) << 4;
    f32x16 st;
#pragma unroll
    for (int i = 0; i < 16; ++i) st[i] = 0.f;
    bf16x8 kf[2][4];
#define RET_PIN asm volatile("" ::: "memory")
#define RET_SB __builtin_amdgcn_sched_barrier(0)
#define RET_KREAD(g) do { _Pragma("unroll") for (int j = 0; j < 4; ++j) kf[(g) & 1][j] = *(const LAS bf16x8*)(kb + ((32 * (4 * (g) + j)) ^ cx)); RET_PIN; } while (0)
#define RET_KMMA(g) do { _Pragma("unroll") for (int j = 0; j < 4; ++j) st = MFMA32(kf[(g) & 1][j], qf[4 * (g) + j], st); } while (0)
    RET_KREAD(0); RET_SB;
    RET_KREAD(1); RET_KMMA(0); RET_SB;
    RET_KREAD(2); RET_KMMA(1); RET_SB;
    RET_KREAD(3); RET_KMMA(2); RET_SB;
    if (PV) {
        const LAS unsigned char* Vl = lds + 32768 + ((kt + 1) & 1) * 65536;
        int vb = c.vlane; asm volatile("" : "+v"(vb));
        const LAS unsigned char* vbase = Vl + vb;
        const LAS unsigned char* pbase = xch + c.pbx;
        const int vo0 = ((0 ^ c.tq) & 3) << 6, vo1 = ((1 ^ c.tq) & 3) << 6, vo2 = ((2 ^ c.tq) & 3) << 6, vo3 = ((3 ^ c.tq) & 3) << 6;
        s16x4 vlo[2][4], vhi[2][4]; bf16x8 pf[2];
#define RET_VREAD(g) do { const LAS unsigned char* _p = vbase + ((g) * 16) * 512; pf[(g) & 1] = *(const LAS bf16x8*)(pbase + (g) * 1024); \
            vlo[(g) & 1][0] = vtr(_p + vo0); vhi[(g) & 1][0] = vtr(_p + vo0 + 4096); vlo[(g) & 1][1] = vtr(_p + vo1); vhi[(g) & 1][1] = vtr(_p + vo1 + 4096); \
            vlo[(g) & 1][2] = vtr(_p + vo2); vhi[(g) & 1][2] = vtr(_p + vo2 + 4096); vlo[(g) & 1][3] = vtr(_p + vo3); vhi[(g) & 1][3] = vtr(_p + vo3 + 4096); RET_PIN; } while (0)
#define RET_VMMA(g) do { _Pragma("unroll") for (int d = 0; d < 4; ++d) O[d] = MFMA32(pf[(g) & 1], __builtin_shufflevector(vlo[(g) & 1][d], vhi[(g) & 1][d], 0, 1, 2, 3, 4, 5, 6, 7), O[d]); } while (0)
        RET_VREAD(0); RET_KMMA(3); RET_SB;
        RET_VREAD(1); RET_VMMA(0); RET_SB;
        RET_VREAD(2); RET_VMMA(1); RET_SB;
        RET_VREAD(3); RET_VMMA(2); RET_SB;
        RET_VMMA(3); RET_SB;
#undef RET_VREAD
#undef RET_VMMA
    } else {
        RET_KMMA(3); RET_SB;
    }
#undef RET_KREAD
#undef RET_KMMA
#undef RET_SB
#undef RET_PIN
    {
        const int k0 = kt * 64 + 32 * c.hf;
        if (!CTX) {
            const int d0 = c.iabs - (k0 + 4 * c.h);
            if (k0 != c.qr0) {
                const bool fwd = c.qr0 > k0;
                const float m = fwd ? c.gi : c.gb, m8 = fwd ? c.gi8 : c.gb8;
                float w[4]; w[0] = __builtin_amdgcn_exp2f((float)d0 * (fwd ? c.lf2 : -c.lb2)); w[1] = w[0] * m; w[2] = w[1] * m; w[3] = w[2] * m;
#pragma unroll
                for (int q4 = 0; q4 < 4; ++q4) {
#pragma unroll
                    for (int e = 0; e < 4; ++e) { st[4 * q4 + e] *= w[e]; w[e] *= m8; } }
            } else {
#pragma unroll
                for (int i = 0; i < 16; ++i) { const int dist = d0 - ((i & 3) + 8 * (i >> 2)); const float fd = (float)dist; st[i] *= __builtin_amdgcn_exp2f(fd * (dist >= 0 ? c.lf2 : -c.lb2)); }
            }
        } else {
            const int l0 = (kt - 32) * 64 + 32 * c.hf + 4 * c.h;
            float wf[4], wb[4];
            wf[0] = __builtin_amdgcn_exp2f(c.lf2 * (float)(c.iabs + LCTX - l0)); wf[1] = wf[0] * c.gi; wf[2] = wf[1] * c.gi; wf[3] = wf[2] * c.gi;
            wb[0] = __builtin_amdgcn_exp2f(c.lb2 * (float)(SEQ + l0 - c.iabs)); wb[1] = wb[0] * c.gb; wb[2] = wb[1] * c.gb; wb[3] = wb[2] * c.gb;
#pragma unroll
            for (int q4 = 0; q4 < 4; ++q4) {
#pragma unroll
                for (int e = 0; e < 4; ++e) { st[4 * q4 + e] *= wf[e] + wb[e]; wf[e] *= c.gi8; wb[e] *= c.gb8; } }
        }
    }
    u32x4 p0, p1;
    p0.x = cvtpk(st[0], st[1]); p0.y = cvtpk(st[2], st[3]); p0.z = cvtpk(st[4], st[5]); p0.w = cvtpk(st[6], st[7]);
    p1.x = cvtpk(st[8], st[9]); p1.y = cvtpk(st[10], st[11]); p1.z = cvtpk(st[12], st[13]); p1.w = cvtpk(st[14], st[15]);
    asm volatile("s_waitcnt lgkmcnt(0)" ::: "memory");
    __builtin_amdgcn_s_barrier();
    asm volatile("" ::: "memory");
    *(LAS u32x4*)(xch + c.myx) = p0; *(LAS u32x4*)(xch + c.myx + 1024) = p1;
}

__device__ __forceinline__ void retention_unit(LAS unsigned char* lds, const Args& a, int b, int hh, int qb, int wid, int lane) {
    unsigned char* ws = a.ws;
    bf16_t* Qp = (bf16_t*)(ws + WS_Q); const bf16_t* Kp = (const bf16_t*)(ws + WS_K); const bf16_t* Vp = (const bf16_t*)(ws + WS_V);
    const bf16_t* Gp = (const bf16_t*)(ws + WS_G);
    asm volatile("" : "+v"(lane));
    const int r = lane & 31, h = lane >> 5, rg = wid >> 1, hf = wid & 1;
    const int ch = qb >> 3, kbeg = 16 * ch;
    RetC c; c.kend = kbeg + 16;
    c.lf2 = -log1pf(expf(-a.dec_f[hh])) * 1.4426950408889634f; c.lb2 = -log1pf(expf(-a.dec_b[hh])) * 1.4426950408889634f;
    c.iabs = qb * 128 + rg * 32 + r; c.qr0 = qb * 128 + rg * 32; c.r = r; c.h = h; c.hf = hf;
    c.gi = exp2f(-c.lf2); { const float t2 = c.gi * c.gi, t4 = t2 * t2; c.gi8 = t4 * t4; } c.gb = exp2f(c.lb2); { const float t2 = c.gb * c.gb, t4 = t2 * t2; c.gb8 = t4 * t4; }
#define RET_UNI(x) x = __uint_as_float(__builtin_amdgcn_readfirstlane(__float_as_uint(x)))
    RET_UNI(c.lf2); RET_UNI(c.lb2); RET_UNI(c.gi); RET_UNI(c.gi8); RET_UNI(c.gb); RET_UNI(c.gb8);
#undef RET_UNI
    bf16x8 qf[16];
    { const bf16_t* qp = Qp + (size_t)(b * SEQ + c.iabs) * DM + hh * 256 + 8 * h;
#pragma unroll
      for (int s = 0; s < 16; ++s) qf[s] = *(const bf16x8*)(qp + 16 * s); }
    f32x16 O[4];
#pragma unroll
    for (int d = 0; d < 4; ++d)
#pragma unroll
        for (int i = 0; i < 16; ++i) O[d][i] = 0.f;
    c.Kl0 = Kp + (size_t)(b * SEQ) * DM + hh * 256; c.Vl0 = Vp + (size_t)(b * SEQ) * DM + hh * 256;
    const int tq = (lane & 15) >> 2, tp = lane & 3, g16 = (lane >> 4) & 1;
    c.tq = tq; c.vlane = (4 * h + tq) * 512 + (2 * g16 + (tp >> 1)) * 16 + (tp & 1) * 8 + hf * 256;
    c.myx = ((wid * 2) * 64 + lane) * 16; c.pbx = (((wid & ~1) * 2) * 64 + lane) * 16;
    ret_issue<false>(lds, c.Kl0 + (size_t)(kbeg * 64) * DM, wid, lane);
    ret_iter<false, false>(lds, c, kbeg, O, qf, wid, lane);
#pragma unroll 1
    for (int kt = kbeg + 1; kt <= kbeg + 16; ++kt) ret_iter<true, false>(lds, c, kt, O, qf, wid, lane);
    {
        const bf16_t* ST = (const bf16_t*)(ws + WS_ST) + (size_t)((b * 8 + hh) * 4) * 65536;
        const int g16 = (lane >> 4) & 1, tp = lane & 3, tq = c.tq;
        const unsigned l0 = (unsigned)(__UINTPTR_TYPE__)lds;
#pragma unroll 1
        for (int dir = 0; dir < 2; ++dir) {
            __syncthreads();
            const bf16_t* S = ST + (size_t)(dir * 2 + ch) * 65536;
            { const int row0 = 32 * wid + (lane >> 5), pc = lane & 31;
              const bf16_t* sp = S + (size_t)row0 * 256; unsigned ld = l0 + wid * 16384;
#pragma unroll 1
              for (int cc = 0; cc < 16; ++cc) { const int lc = pc ^ (((2 * cc + (lane >> 5)) & 3) << 2);
                  glds16(sp + lc * 8, (unsigned)__builtin_amdgcn_readfirstlane(ld)); sp += 512; ld += 1024; } }
            asm volatile("s_waitcnt vmcnt(0)" ::: "memory");
            __syncthreads();
            const float aq = __builtin_amdgcn_exp2f(dir == 0 ? c.lf2 * (float)(c.iabs - 1024 * ch + 1) : c.lb2 * (float)(1024 * (ch + 1) - c.iabs));
#pragma unroll
            for (int s = 0; s < 16; ++s) {
                const u32x4 qw = __builtin_bit_cast(u32x4, qf[s]); u32x4 pw;
                pw.x = cvtpk(bflo(qw.x) * aq, bfhi(qw.x) * aq); pw.y = cvtpk(bflo(qw.y) * aq, bfhi(qw.y) * aq);
                pw.z = cvtpk(bflo(qw.z) * aq, bfhi(qw.z) * aq); pw.w = cvtpk(bflo(qw.w) * aq, bfhi(qw.w) * aq);
                const bf16x8 af = __builtin_bit_cast(bf16x8, pw);
                const LAS unsigned char* vb = lds + (16 * s + 8 * h + tq) * 512 + (2 * g16 + (tp >> 1)) * 16 + (tp & 1) * 8;
#pragma unroll
                for (int d = 0; d < 4; ++d) { const int blk = 4 * hf + d;
                    const LAS unsigned char* vp = vb + (((blk ^ tq) & 3) << 6) + (blk >> 2) * 256;
                    const s16x4 lo = vtr(vp), hi = vtr(vp + 4 * 512);
                    O[d] = MFMA32(af, __builtin_shufflevector(lo, hi, 0, 1, 2, 3, 4, 5, 6, 7), O[d]); }
            }
        }
    }
    LAS float* xs = (LAS float*)(lds + LDS_XS);
    float rs[16];
#pragma unroll
    for (int i = 0; i < 16; ++i) { float s = 0.f;
#pragma unroll
        for (int d = 0; d < 4; ++d) s += O[d][i] * O[d][i];
        s += __shfl_xor(s, 1); s += __shfl_xor(s, 2); s += __shfl_xor(s, 4); s += __shfl_xor(s, 8); s += __shfl_xor(s, 16);
        rs[i] = s; if (r == 0) xs[wid * 32 + (i & 3) + 8 * (i >> 2) + 4 * h] = s; }
    __syncthreads();
#pragma unroll
    for (int i = 0; i < 16; ++i) { const float s = rs[i] + xs[(wid ^ 1) * 32 + (i & 3) + 8 * (i >> 2) + 4 * h]; rs[i] = 1.0f / sqrtf(s * (1.0f / 256.0f) + EPS); }
    const size_t obase = (size_t)(b * SEQ + qb * 128 + rg * 32 + 4 * h) * DM + hh * 256 + hf * 128 + r;
#pragma unroll
    for (int hh2 = 0; hh2 < 2; ++hh2) {
        bf16_t gv[8][4];
#pragma unroll
        for (int ii = 0; ii < 8; ++ii) { const int i = hh2 * 8 + ii; const size_t off = obase + (size_t)((i & 3) + 8 * (i >> 2)) * DM;
#pragma unroll
            for (int d = 0; d < 4; ++d) gv[ii][d] = Gp[off + 32 * d]; }
        asm volatile("" ::: "memory");
#pragma unroll
        for (int ii = 0; ii < 8; ++ii) { const int i = hh2 * 8 + ii; const size_t off = obase + (size_t)((i & 3) + 8 * (i >> 2)) * DM;
#pragma unroll
            for (int d = 0; d < 4; ++d) Qp[off + 32 * d] = (bf16_t)(cvtpk(O[d][i] * rs[i] * bf2f(gv[ii][d]), 0.f) & 0xffffu); }
        asm volatile("" ::: "memory");
    }
}

__device__ __forceinline__ void state_unit(LAS unsigned char* lds, const Args& a, int b, int hh, int dir, int eh, int wid, int lane) {
    unsigned char* ws = a.ws;
    asm volatile("" : "+v"(lane));
    const int r = lane & 31, h = lane >> 5, tq = (lane & 15) >> 2, tp = lane & 3, g16 = (lane >> 4) & 1;
    float lg2 = -log1pf(expf(-(dir ? a.dec_b[hh] : a.dec_f[hh]))) * 1.4426950408889634f;
    lg2 = __uint_as_float(__builtin_amdgcn_readfirstlane(__float_as_uint(lg2)));
    const float m = exp2f(dir ? lg2 : -lg2);
    const float g1024 = exp2f(1024.0f * lg2);
    const bf16_t* Kc = (const bf16_t*)(ws + WS_KC) + (size_t)(b * LCTX) * DM + hh * 256; const bf16_t* Vc = (const bf16_t*)(ws + WS_VC) + (size_t)(b * LCTX) * DM + hh * 256;
    const bf16_t* Kl = (const bf16_t*)(ws + WS_K) + (size_t)(b * SEQ + dir * 1024) * DM + hh * 256; const bf16_t* Vl = (const bf16_t*)(ws + WS_V) + (size_t)(b * SEQ + dir * 1024) * DM + hh * 256;
    bf16_t* ST = (bf16_t*)(ws + WS_ST) + (size_t)((b * 8 + hh) * 4) * 65536;
    f32x16 acc[4];
#pragma unroll
    for (int d = 0; d < 4; ++d)
#pragma unroll
        for (int i = 0; i < 16; ++i) acc[d][i] = 0.f;
    const int lanec = (2 * g16 + (tp >> 1)) * 16 + (tp & 1) * 8;
    ret_issue<true>(lds, Kc, wid, lane); ret_issue<true>(lds + 32768, Vc, wid, lane);
#pragma unroll 1
    for (int t = 0; t < 20; ++t) {
        asm volatile("s_waitcnt vmcnt(0) lgkmcnt(0)" ::: "memory");
        __builtin_amdgcn_s_barrier();
        asm volatile("" ::: "memory");
        if (t + 1 < 20) { const int t1 = t + 1; const bf16_t* kp = t1 < 4 ? Kc + (size_t)(t1 * 64) * DM : Kl + (size_t)((t1 - 4) * 64) * DM; const bf16_t* vp = t1 < 4 ? Vc + (size_t)(t1 * 64) * DM : Vl + (size_t)((t1 - 4) * 64) * DM;
            ret_issue<true>(lds + (t1 & 1) * 65536, kp, wid, lane); ret_issue<true>(lds + (t1 & 1) * 65536 + 32768, vp, wid, lane); }
        if (t == 4) {
            bf16_t* S = ST + (size_t)(dir ? 3 : 0) * 65536;
#pragma unroll
            for (int d = 0; d < 4; ++d)
#pragma unroll
                for (int i = 0; i < 16; ++i) { S[(size_t)(32 * wid + (i & 3) + 8 * (i >> 2) + 4 * h) * 256 + 128 * eh + 32 * d + r] = (bf16_t)(cvtpk(acc[d][i], 0.f) & 0xffffu); acc[d][i] *= g1024; }
        }
        const LAS unsigned char* Kt = lds + (t & 1) * 65536; const LAS unsigned char* Vt = Kt + 32768;
        const int p0 = (t < 4 ? 64 * t : 64 * (t - 4)) + 8 * h, last = t < 4 ? 255 : 1023;
#pragma unroll
        for (int s = 0; s < 4; ++s) {
            const LAS unsigned char* kb = Kt + (16 * s + 8 * h + tq) * 512 + lanec + (((wid ^ tq) & 3) << 6) + (wid >> 2) * 256;
            const s16x4 klo = vtr(kb), khi = vtr(kb + 4 * 512);
            const int p = p0 + 16 * s;
            float w = __builtin_amdgcn_exp2f(lg2 * (float)(dir ? p : last - p));
            const u32x2 lw = __builtin_bit_cast(u32x2, klo), hw = __builtin_bit_cast(u32x2, khi);
            float kv[8] = {bflo(lw.x), bfhi(lw.x), bflo(lw.y), bfhi(lw.y), bflo(hw.x), bfhi(hw.x), bflo(hw.y), bfhi(hw.y)};
#pragma unroll
            for (int j = 0; j < 8; ++j) { kv[j] *= w; w *= m; }
            u32x4 pw; pw.x = cvtpk(kv[0], kv[1]); pw.y = cvtpk(kv[2], kv[3]); pw.z = cvtpk(kv[4], kv[5]); pw.w = cvtpk(kv[6], kv[7]);
            const bf16x8 af = __builtin_bit_cast(bf16x8, pw);
            const LAS unsigned char* vb = Vt + (16 * s + 8 * h + tq) * 512 + lanec;
#pragma unroll
            for (int d = 0; d < 4; ++d) { const int blk = 4 * eh + d;
                const LAS unsigned char* vp = vb + (((blk ^ tq) & 3) << 6) + (blk >> 2) * 256;
                const s16x4 lo = vtr(vp), hi = vtr(vp + 4 * 512);
                acc[d] = MFMA32(af, __builtin_shufflevector(lo, hi, 0, 1, 2, 3, 4, 5, 6, 7), acc[d]); }
        }
    }
    { bf16_t* S = ST + (size_t)(dir ? 2 : 1) * 65536;
#pragma unroll
      for (int d = 0; d < 4; ++d)
#pragma unroll
          for (int i = 0; i < 16; ++i) S[(size_t)(32 * wid + (i & 3) + 8 * (i >> 2) + 4 * h) * 256 + 128 * eh + 32 * d + r] = (bf16_t)(cvtpk(acc[d][i], 0.f) & 0xffffu); }
}

__device__ __forceinline__ void spatial_unit(LAS unsigned char* lds, const Args& a, int b, int n, int ghalf, int tid, int wid, int lane) {
    bf16_t* Up = (bf16_t*)a.out; const bf16_t* VSp = (const bf16_t*)a.out + (size_t)MTOK * DM;
    const bf16_t* Wb = (const bf16_t*)(a.ws + WS_SGW);
    asm volatile("" : "+v"(lane)); asm volatile("" : "+v"(tid));
    LAS f32x2* stats = (LAS f32x2*)(lds + LDS_STATS);
    const int tok0 = b * SEQ + n * 128;
#pragma unroll 1
    for (int t0 = wid * 16; t0 < wid * 16 + 16; t0 += 4) {
        u32x4 w[4][4];
#pragma unroll
        for (int tt = 0; tt < 4; ++tt)
#pragma unroll
            for (int j = 0; j < 4; ++j) w[tt][j] = *(const u32x4*)(VSp + (size_t)(tok0 + t0 + tt) * DM + j * 512 + lane * 8);
#pragma unroll
        for (int tt = 0; tt < 4; ++tt) { float s = 0.f, ss = 0.f;
#pragma unroll
            for (int j = 0; j < 4; ++j)
#pragma unroll
                for (int e = 0; e < 4; ++e) { const float x0 = bflo(w[tt][j][e]), x1 = bfhi(w[tt][j][e]); s += x0 + x1; ss += x0 * x0 + x1 * x1; }
            s = wave_sum(s); ss = wave_sum(ss);
            const float mean = s * (1.0f / DM); float var = ss * (1.0f / DM) - mean * mean; var = var > 0.f ? var : 0.f;
            if (lane == 0) stats[t0 + tt] = (f32x2){mean, 1.0f / sqrtf(var + EPS)}; }
    }
    __syncthreads();
    const int r = lane & 31, h = lane >> 5, ib = wid & 3, dbh = wid >> 2;
    const int tq = (lane & 15) >> 2, tp = lane & 3, g16 = (lane >> 4) & 1;
    for (int gi = 0; gi < 4; ++gi) {
        const int g = ghalf * 4 + gi;
        { const int lc = tid & 31, ch = g * 256 + lc * 8, row0 = tid >> 5;
          u32x4 w[8];
#pragma unroll
          for (int it = 0; it < 8; ++it) w[it] = *(const u32x4*)(VSp + (size_t)(tok0 + row0 + it * 16) * DM + ch);
          const f32x4 g0 = *(const f32x4*)(a.sg_ln_g + ch), g1 = *(const f32x4*)(a.sg_ln_g + ch + 4), b0 = *(const f32x4*)(a.sg_ln_b + ch), b1 = *(const f32x4*)(a.sg_ln_b + ch + 4);
#pragma unroll
          for (int it = 0; it < 8; ++it) { const int row = row0 + it * 16; const f32x2 st = stats[row];
            u32x4 o;
            o.x = cvtpk((bflo(w[it].x) - st.x) * st.y * g0[0] + b0[0], (bfhi(w[it].x) - st.x) * st.y * g0[1] + b0[1]);
            o.y = cvtpk((bflo(w[it].y) - st.x) * st.y * g0[2] + b0[2], (bfhi(w[it].y) - st.x) * st.y * g0[3] + b0[3]);
            o.z = cvtpk((bflo(w[it].z) - st.x) * st.y * g1[0] + b1[0], (bfhi(w[it].z) - st.x) * st.y * g1[1] + b1[1]);
            o.w = cvtpk((bflo(w[it].w) - st.x) * st.y * g1[2] + b1[2], (bfhi(w[it].w) - st.x) * st.y * g1[3] + b1[3]);
            *(LAS u32x4*)(lds + row * 512 + ((lc ^ ((row & 3) << 2)) << 4)) = o; } }
        __syncthreads();
        f32x16 acc[4];
#pragma unroll
        for (int d = 0; d < 4; ++d)
#pragma unroll
            for (int i = 0; i < 16; ++i) acc[d][i] = 0.f;
        const bf16_t* wrow = Wb + (size_t)g * 16384 + (size_t)(ib * 32 + r) * 128 + 8 * h;
        bf16x8 afr[8];
#pragma unroll
        for (int ks = 0; ks < 8; ++ks) afr[ks] = *(const bf16x8*)(wrow + 16 * ks);
#pragma unroll
        for (int ks = 0; ks < 8; ++ks) {
            const bf16x8 af = afr[ks];
            const LAS unsigned char* vb = lds + (16 * ks + 8 * h + tq) * 512 + (2 * g16 + (tp >> 1)) * 16 + (tp & 1) * 8;
#pragma unroll
            for (int d = 0; d < 4; ++d) { const int db = dbh * 4 + d;
                const LAS unsigned char* vp = vb + (((db ^ tq) & 3) << 6) + (db >> 2) * 256;
                const s16x4 lo = vtr(vp), hi = vtr(vp + 4 * 512);
                const bf16x8 bfr = __builtin_shufflevector(lo, hi, 0, 1, 2, 3, 4, 5, 6, 7);
                acc[d] = MFMA32(af, bfr, acc[d]); }
        }
#pragma unroll
        for (int hh2 = 0; hh2 < 2; ++hh2) {
            bf16_t uv[8][4]; float bias[8];
#pragma unroll
            for (int ii = 0; ii < 8; ++ii) { const int i = hh2 * 8 + ii, il = ib * 32 + (i & 3) + 8 * (i >> 2) + 4 * h; bias[ii] = a.sg_b[g * 128 + il];
                const size_t off = (size_t)(tok0 + il) * DM + g * 256 + dbh * 128 + r;
#pragma unroll
                for (int d = 0; d < 4; ++d) uv[ii][d] = Up[off + 32 * d]; }
            asm volatile("" ::: "memory");
#pragma unroll
            for (int ii = 0; ii < 8; ++ii) { const int i = hh2 * 8 + ii, il = ib * 32 + (i & 3) + 8 * (i >> 2) + 4 * h;
                const size_t off = (size_t)(tok0 + il) * DM + g * 256 + dbh * 128 + r;
#pragma unroll
                for (int d = 0; d < 4; ++d) Up[off + 32 * d] = (bf16_t)(cvtpk(bf2f(uv[ii][d]) * (acc[d][i] + bias[ii]), 0.f) & 0xffffu); }
            asm volatile("" ::: "memory");
        }
        __syncthreads();
    }
}

#define XB_TMO      128
#define XB_XCNT(j)  (256  + 64 * (j))
#define XB_XSUB(j)  (1280 + 64 * (j))
#define XB_XGEN(j)  (2304 + 64 * (j))
#define XB_TOP      3328
#define XB_TOPGEN   3392
#define XCD_BAR_WORDS 3456
#define XB_SPIN_CAP (1u << 22)
__device__ __forceinline__ unsigned xb_ld(unsigned* p)              { return __hip_atomic_load(p, __ATOMIC_RELAXED, __HIP_MEMORY_SCOPE_AGENT); }
__device__ __forceinline__ unsigned xb_add(unsigned* p, unsigned v) { return __hip_atomic_fetch_add(p, v, __ATOMIC_RELAXED, __HIP_MEMORY_SCOPE_AGENT); }
__device__ __forceinline__ unsigned xb_xcc_id() { return (unsigned)__builtin_amdgcn_s_getreg((3 << 11) | 20) & 0xFu; }
#define XB_SPIN(cond, bar) do { unsigned _sp = 0; while (cond) { __builtin_amdgcn_s_sleep(1); \
    if ((++_sp & 255u) == 0u) { if (xb_ld(&(bar)[XB_TMO])) break; if (_sp > XB_SPIN_CAP) { atomicAdd(&(bar)[XB_TMO], 1u); break; } } } } while (0)
struct XcdBarrier { unsigned* bar; unsigned x; volatile LAS unsigned* st; };
__device__ __forceinline__ XcdBarrier xcd_barrier_post(unsigned* bar, volatile LAS unsigned* st) {
    XcdBarrier b; b.bar = bar; b.x = xb_xcc_id(); b.st = st;
    if (threadIdx.x == 0) (void)xb_add(&bar[XB_XCNT(b.x)], 1u);
    return b;
}
__device__ __forceinline__ void xcd_barrier_complete(unsigned* bar, unsigned x, unsigned& nloc, unsigned& nx) {
    const unsigned G = gridDim.x * gridDim.y * gridDim.z;
    unsigned sum, cnt, mine, sp = 0u;
    for (;;) {
        sum = 0u; cnt = 0u; mine = 0u;
#pragma unroll
        for (unsigned j = 0; j < 16; ++j) { const unsigned c = xb_ld(&bar[XB_XCNT(j)]); sum += c; cnt += (c > 0u) ? 1u : 0u; mine = (j == x) ? c : mine; }
        if (sum == G) break;
        __builtin_amdgcn_s_sleep(1);
        if ((++sp & 255u) == 0u) { if (xb_ld(&bar[XB_TMO])) break; if (sp > XB_SPIN_CAP) { atomicAdd(&bar[XB_TMO], 1u); break; } }
    }
    nloc = mine > 0u ? mine : 1u; nx = cnt > 0u ? cnt : 1u;
}
__device__ __forceinline__ void xcd_barrier(const XcdBarrier& b) {
    asm volatile("s_waitcnt vmcnt(0)" ::: "memory");
    __syncthreads();
    if (threadIdx.x == 0) {
        unsigned* bar = b.bar;
        __builtin_amdgcn_s_waitcnt(0);
        unsigned nloc = b.st[0], nx = b.st[1];
        if (nloc == 0u) { xcd_barrier_complete(bar, b.x, nloc, nx); b.st[0] = nloc; b.st[1] = nx; }
        const unsigned old = xb_add(&bar[XB_XSUB(b.x)], 1u);
        const unsigned gen = old / nloc;
        if (old + 1u == (gen + 1u) * nloc) {
            __builtin_amdgcn_fence(__ATOMIC_RELEASE, "agent");
            asm volatile("s_waitcnt vmcnt(0)" ::: "memory");
            const unsigned og = xb_add(&bar[XB_TOP], 1u);
            const unsigned tg = og / nx;
            if (og + 1u == (tg + 1u) * nx) xb_add(&bar[XB_TOPGEN], 1u);
            else XB_SPIN(xb_ld(&bar[XB_TOPGEN]) == tg, bar);
            __builtin_amdgcn_fence(__ATOMIC_ACQUIRE, "agent");
            xb_add(&bar[XB_XGEN(b.x)], 1u);
            asm volatile("s_waitcnt vmcnt(0)" ::: "memory");
        } else {
            XB_SPIN(xb_ld(&bar[XB_XGEN(b.x)]) == gen, bar);
            __builtin_amdgcn_fence(__ATOMIC_ACQUIRE, "agent");
            asm volatile("s_waitcnt vmcnt(0)" ::: "memory");
        }
    }
    __syncthreads();
}

__global__ void __launch_bounds__(512, 2) fwd_megakernel(Args a) {
    extern __shared__ __attribute__((aligned(16))) unsigned char lds_raw[];
    LAS unsigned char* lds = (LAS unsigned char*)lds_raw;
    cg::grid_group grid = cg::this_grid();
    const int tid = threadIdx.x, wid = __builtin_amdgcn_readfirstlane(tid >> 6), lane = tid & 63;
    const int G = gridDim.x, bx = blockIdx.x;
    unsigned char* ws = a.ws;
    const float* MOD = (const float*)(ws + WS_MOD);
    const int gw = bx * 8 + wid, NGW = G * 8;

    if (tid < 4) ((LAS unsigned*)(lds + LDS_BARST))[tid] = 0u;
    __syncthreads();
    const XcdBarrier xbar = xcd_barrier_post((unsigned*)(ws + WS_BAR), (volatile LAS unsigned*)(lds + LDS_BARST));
#define GRID_BAR() xcd_barrier(xbar)
    if (a.dec_f[0] < -1e30f) grid.sync();
    p0_prologue(a, lds, tid, wid, lane, G);
    GRID_BAR();
    rows_phase<false>(a.x, a.ctx, MTOK, MTOK + MCTX, a.norm1_g, MOD, 0, DM, (void*)(ws + WS_H), gw, NGW, lane);
    GRID_BAR();
    {
        EpiIn E{(bf16_t*)(ws + WS_Q), (bf16_t*)(ws + WS_K), (bf16_t*)(ws + WS_V), (bf16_t*)(ws + WS_G), (bf16_t*)a.out, (bf16_t*)a.out + (size_t)MTOK * DM,
                (bf16_t*)(ws + WS_KC), (bf16_t*)(ws + WS_VC), (const f32x4*)(ws + WS_ROPE)};
        pg8::Gemm g{(const bf16_t*)(ws + WS_H), (const bf16_t*)(ws + WS_WIN), nullptr, nullptr, DM}; pg8::Order S; S.init(64, 48, 0, 128, G, bx);
        pg8::gemm_phase(lds, g, S, E);
        if (G == 256) { if (bx >= 128) convert_ffn(a, lds, (bx - 128) * 8 + wid, 128 * 8, wid, lane); }
        else convert_ffn(a, lds, gw, NGW, wid, lane);
    }
    GRID_BAR();
    for (int idx = bx; idx < 256; idx += G) { state_unit(lds, a, idx >> 5, (idx >> 2) & 7, (idx >> 1) & 1, idx & 1, wid, lane); __syncthreads(); }
    for (int idx = bx; idx < 256; idx += G) { spatial_unit(lds, a, idx >> 5, (idx >> 1) & 15, idx & 1, tid, wid, lane); }
    GRID_BAR();
    for (int i = 0; ; ++i) {
        int b, hh, qb;
        if (G == 256) { if (i >= 4) break; const int xcd = bx & 7, j = i * 32 + (bx >> 3); hh = xcd; b = j >> 4; qb = j & 15; }
        else { const int idx = i * G + bx; if (idx >= 1024) break; b = idx >> 7; hh = (idx >> 4) & 7; qb = idx & 15; }
        retention_unit(lds, a, b, hh, qb, wid, lane);
        __syncthreads();
    }
    GRID_BAR();
    {
        EpiIn E{(bf16_t*)(ws + WS_Q), (bf16_t*)(ws + WS_K), (bf16_t*)(ws + WS_V), (bf16_t*)(ws + WS_G), (bf16_t*)a.out, (bf16_t*)a.out + (size_t)MTOK * DM,
                (bf16_t*)(ws + WS_KC), (bf16_t*)(ws + WS_VC), (const f32x4*)(ws + WS_ROPE)};
        pg8::Gemm g{(const bf16_t*)(ws + WS_H), (const bf16_t*)(ws + WS_WIN), nullptr, nullptr, DM}; pg8::Order S; S.init(64, 16, 48, 0, G, bx);
        pg8::gemm_phase(lds, g, S, E);
    }
    GRID_BAR();
    {
        EpiDual E{(const bf16_t*)(ws + WS_K), (const bf16_t*)(ws + WS_V), (bf16_t*)(ws + WS_G)};
        pg8::Gemm g{(const bf16_t*)(ws + WS_Q), (const bf16_t*)(ws + WS_W3), (const bf16_t*)a.out, (const bf16_t*)(ws + WS_W3 + 8 * MiB), DM}; pg8::Order S; S.init(64, 8, 0, 0, G, bx, 1);
        pg8::gemm_phase(lds, g, S, E);
    }
    GRID_BAR();
    {
        EpiRes E{a.x, MOD + 2 * DM, a.out};
        pg8::Gemm g{(const bf16_t*)(ws + WS_G), (const bf16_t*)(ws + WS_W3 + 16 * MiB), nullptr, nullptr, DM}; pg8::Order S; S.init(64, 8, 0, 0, G, bx);
        pg8::gemm_phase(lds, g, S, E);
    }
    GRID_BAR();
    rows_phase<false>(a.out, a.out, MTOK, MTOK, a.norm2_g, MOD, 3 * DM, 4 * DM, (void*)(ws + WS_Q), gw, NGW, lane);
    GRID_BAR();
    {
        EpiSwiglu E{(bf16_t*)(ws + WS_HID)};
        pg8::Gemm g{(const bf16_t*)(ws + WS_Q), (const bf16_t*)(ws + WS_WF1), nullptr, nullptr, DM}; pg8::Order S; S.init(64, 44, 0, 0, G, bx);
        pg8::gemm_phase(lds, g, S, E);
    }
    GRID_BAR();
    {
        EpiRes E{a.out, MOD + 5 * DM, a.out};
        pg8::Gemm g{(const bf16_t*)(ws + WS_HID), (const bf16_t*)(ws + WS_WF2), nullptr, nullptr, FF}; pg8::Order S; S.init(64, 8, 0, 0, G, bx);
        pg8::gemm_phase(lds, g, S, E);
    }
    GRID_BAR();
    rows_phase<true>(a.out, a.out, MTOK, MTOK, a.final_g, MOD, 0, 0, (void*)a.out, gw, NGW, lane);
}

extern "C" void kernel_launch(void* const* d_in, const int* in_sizes, int n_in, void* d_out, int out_size, void* d_ws, size_t ws_size, hipStream_t stream) {
    static int grid_blocks = 0;
    if (grid_blocks == 0) {
        if (n_in != 21 || out_size != MTOK * DM || ws_size < WS_END) { fprintf(stderr, "kernel_launch: unexpected problem (n_in %d, out %d, ws %zu)\n", n_in, out_size, ws_size); grid_blocks = -1; return; }
        int dev = 0, cus = 0, per_cu = 0;
        hipGetDevice(&dev);
        hipDeviceGetAttribute(&cus, hipDeviceAttributeMultiprocessorCount, dev);
        if (hipFuncSetAttribute((const void*)fwd_megakernel, hipFuncAttributeMaxDynamicSharedMemorySize, LDS_BYTES) != hipSuccess) { fprintf(stderr, "kernel_launch: hipFuncSetAttribute failed\n"); grid_blocks = -1; return; }
        if (hipOccupancyMaxActiveBlocksPerMultiprocessor(&per_cu, (const void*)fwd_megakernel, 512, LDS_BYTES) != hipSuccess || per_cu < 1) { fprintf(stderr, "kernel_launch: occupancy query gave %d\n", per_cu); per_cu = 1; }
        (void)hipGetLastError();
        grid_blocks = cus * (per_cu > 1 ? 1 : per_cu);
        if (grid_blocks < 1) grid_blocks = 256;
    }
    if (grid_blocks < 0) return;
    if (hipMemsetAsync((char*)d_ws + WS_BAR, 0, XCD_BAR_WORDS * 4, stream) != hipSuccess) { fprintf(stderr, "kernel_launch: memset of the barrier words failed\n"); return; }
    Args a{};
    const float** pp = (const float**)&a;
    for (int i = 0; i < 21; ++i) pp[i] = (const float*)d_in[i];
    a.out = (float*)d_out; a.ws = (unsigned char*)d_ws;
    void* args[] = {&a};
    hipError_t e = hipLaunchCooperativeKernel((const void*)fwd_megakernel, dim3(grid_blocks), dim3(512), args, LDS_BYTES, stream);
    if (e != hipSuccess) fprintf(stderr, "cooperative launch failed: %s (grid %d)\n", hipGetErrorString(e), grid_blocks);
}
```

```cpp
#include <hip/hip_runtime.h>
#include <hip/hip_cooperative_groups.h>
#include <cstdio>
#include <cstdint>
namespace cg = cooperative_groups;

#define LAS __attribute__((address_space(3)))
typedef unsigned short bf16_t;
typedef short bf16x8 __attribute__((ext_vector_type(8)));
typedef short s16x4 __attribute__((ext_vector_type(4)));
typedef short v4i16_t __attribute__((ext_vector_type(4)));
typedef float f32x2 __attribute__((ext_vector_type(2)));
typedef float f32x4 __attribute__((ext_vector_type(4)));
typedef float f32x16 __attribute__((ext_vector_type(16)));
typedef unsigned u32x2 __attribute__((ext_vector_type(2)));
typedef unsigned u32x4 __attribute__((ext_vector_type(4)));
typedef __bf16 bf16x2_t __attribute__((ext_vector_type(2)));

constexpr int DM = 2048, NB = 8, SEQ = 2048, MTOK = NB * SEQ, LCTX = 256, MCTX = NB * LCTX, NH = 8, DIN = 16384, FF = 5632, NMOD = 12288;
constexpr float EPS = 1e-6f;
constexpr size_t MiB = 1u << 20;
constexpr size_t WS_MOD = 0, WS_ROPE = 512 * 1024, WS_SGW = 576 * 1024;
constexpr size_t WS_WF1 = 1 * MiB, WS_WF2 = 45 * MiB, WS_W3 = 67 * MiB, WS_Q = 91 * MiB, WS_WIN = 155 * MiB, WS_H = 219 * MiB, WS_K = 291 * MiB, WS_V = 355 * MiB,
                 WS_KC = 419 * MiB, WS_VC = 427 * MiB, WS_G = 435 * MiB, WS_END = 499 * MiB;
constexpr int RCH = 512, NRCH = SEQ / RCH;
constexpr size_t WS_T = WS_WIN, WS_HID = WS_WIN;
constexpr int LDS_BYTES = 153600;
constexpr int LDS_XCH = 131072, LDS_XS = 147456, LDS_STATS = 148480, LDS_BARST = 149504;
constexpr size_t WS_BAR = 896 * 1024;

__device__ __forceinline__ unsigned cvtpk(float lo, float hi) { f32x2 v = {lo, hi}; bf16x2_t b = __builtin_convertvector(v, bf16x2_t); return __builtin_bit_cast(unsigned, b); }
__device__ __forceinline__ float bflo(unsigned w) { return __uint_as_float(w << 16); }
__device__ __forceinline__ float bfhi(unsigned w) { return __uint_as_float(w & 0xffff0000u); }
__device__ __forceinline__ float bf2f(bf16_t b) { return __uint_as_float(((unsigned)b) << 16); }
__device__ __forceinline__ float fast_sigmoid(float x) { return __builtin_amdgcn_rcpf(1.0f + __builtin_amdgcn_exp2f(-1.4426950408889634f * x)); }
__device__ __forceinline__ float fast_silu(float x) { return x * fast_sigmoid(x); }
__device__ __forceinline__ float fast_gelu(float x) { const float z = 0.7978845608028654f * (x + 0.044715f * x * x * x); return x * fast_sigmoid(2.0f * z); }
__device__ __forceinline__ float wave_sum(float v) {
#pragma unroll
    for (int o = 1; o < 64; o <<= 1) v += __shfl_xor(v, o);
    return v;
}

namespace pg8 {
constexpr int BM = 256, BK = 64, HALF = 128, HTB = HALF * BK * 2, STAGE_BYTES = 8 * HTB, NXCD = 8, WGM = 8;
__host__ __device__ __forceinline__ int lds_byte(int r, int c) { const int st = (r >> 4) * 2 + (c >> 5), rr = r & 15, cc = c & 31, ob = rr * 64 + cc * 2; return st * 1024 + (ob ^ (((ob >> 9) & 1) << 5)); }
__host__ __device__ __forceinline__ void stage_rc(int b, int& R, int& C) { const int st = b / 1024, sb = b % 1024, swz = sb ^ (((sb >> 9) & 1) << 5); R = (st >> 1) * 16 + swz / 64; C = (st & 1) * 32 + (swz % 64) / 2; }
__host__ __device__ __forceinline__ int perm32(int rho) { const int n = rho >> 4, i = rho & 15; return 8 * (i >> 2) + 4 * n + (i & 3); }

struct Unit { int pm, pn, which; };
struct Gemm { const bf16_t* A; const bf16_t* Bt; const bf16_t* A2; const bf16_t* Bt2; int K; };

struct Order {
    int nM, nN, pn0, nwg, G, c, nextra, dual;
    __device__ void init(int nM_, int nN_, int pn0_, int nextra_, int G_, int c_, int dual_ = 0) { nM = nM_; nN = nN_; pn0 = pn0_; nwg = nM * nN; nextra = nextra_; G = G_; c = c_; dual = dual_; }
    __device__ bool next(int i, Unit& u) const {
        u.which = dual ? (i & 1) : 0; if (dual) i >>= 1;
        long L = (long)i * G + c;
        if (L < nwg) {
            int wgid = (int)L; { const int q = nwg / NXCD, r = nwg % NXCD, xcd = wgid % NXCD, off = wgid / NXCD; wgid = (xcd < r ? xcd * (q + 1) : r * (q + 1) + (xcd - r) * q) + off; }
            const int nig = WGM * nN, gid = wgid / nig, fm = gid * WGM, gsz = (nM - fm) < WGM ? (nM - fm) : WGM;
            u.pm = fm + ((wgid % nig) % gsz); u.pn = pn0 + (wgid % nig) / gsz; return true;
        }
        L -= nwg;
        if (L < nextra) { u.pm = 64 + (int)(L & 7); u.pn = 8 + (int)(L >> 3); return true; }
        return false;
    }
};

template <class Epi>
__device__ __forceinline__ void gemm_phase(LAS unsigned char* lds, const Gemm g, const Order& S, const Epi& E) {
    int tid_ = threadIdx.x; asm volatile("" : "+v"(tid_));
    const int tid = tid_, wid = __builtin_amdgcn_readfirstlane(tid >> 6), lane = tid & 63, wr = wid >> 2, wc = wid & 3, fr = lane & 15, fq = lane >> 4;
    const int K = g.K, nt = K / BK;
    unsigned voffA[2], voffB[2];
#pragma unroll
    for (int i = 0; i < 2; ++i) { int R, C; stage_rc(tid * 16 + i * 8192, R, C); const int Rb = (R & ~31) + perm32(R & 31);
        voffA[i] = (unsigned)(R * K + C) * 2u; voffB[i] = (unsigned)(Rb * K + C) * 2u; }
    const size_t kstep = (size_t)(BK * 2);
    const size_t hstep = (size_t)HALF * K * 2;
    const size_t tstep = 2 * hstep;
    const unsigned ldsw = (unsigned)wid * 1024u;
    const int aoff = lds_byte(wr * 64 + fr, fq * 8), boff = lds_byte(wc * 32 + fr, fq * 8);
#define PG8_SA(b, h) (((b) * 2 + (h)) * HTB)
#define PG8_SB(b, h) ((4 + (b) * 2 + (h)) * HTB)
#define PG8_STAGE(bufoff, gbase, voff) do { _Pragma("unroll") for (int _i = 0; _i < 2; ++_i) \
        __builtin_amdgcn_global_load_lds((const unsigned*)((const char*)(gbase) + (voff)[_i]), (LAS unsigned*)(lds + (bufoff) + ldsw + _i * 8192), 16, 0, 0); } while (0)
#define PG8_LDA(dst, b, h) do { _Pragma("unroll") for (int m = 0; m < 4; ++m) _Pragma("unroll") for (int k = 0; k < 2; ++k) dst[m][k] = *(const LAS bf16x8*)(lds + PG8_SA(b, h) + aoff + m * 2048 + k * 1024); } while (0)
#define PG8_LDB(dst, b, h) do { _Pragma("unroll") for (int n = 0; n < 2; ++n) _Pragma("unroll") for (int k = 0; k < 2; ++k) dst[n][k] = *(const LAS bf16x8*)(lds + PG8_SB(b, h) + boff + n * 2048 + k * 1024); } while (0)
#define PG8_MMA(ai, bj, At, Bt) do { __builtin_amdgcn_s_setprio(1); _Pragma("unroll") for (int m = 0; m < 4; ++m) _Pragma("unroll") for (int n = 0; n < 2; ++n) _Pragma("unroll") for (int k = 0; k < 2; ++k) \
        acc[ai][bj][m][n] = __builtin_amdgcn_mfma_f32_16x16x32_bf16(Bt[n][k], At[m][k], acc[ai][bj][m][n], 0, 0, 0); __builtin_amdgcn_s_setprio(0); } while (0)
#define PG8_WAIT_V(n) asm volatile("s_waitcnt vmcnt(" #n ")" ::: "memory")
#define PG8_WAIT_L(n) asm volatile("s_waitcnt lgkmcnt(" #n ")" ::: "memory")
#define PG8_BAR __builtin_amdgcn_s_barrier()
#define PG8_SCHED __builtin_amdgcn_sched_barrier(0)
    Unit cur, nxt; int ui = 0;
    if (!S.next(0, cur)) return;
    f32x4 acc[2][2][4][2];
#pragma unroll
    for (int a = 0; a < 2; ++a)
#pragma unroll
        for (int b = 0; b < 2; ++b)
#pragma unroll
            for (int m = 0; m < 4; ++m)
#pragma unroll
                for (int n = 0; n < 2; ++n) acc[a][b][m][n] = (f32x4){0.f, 0.f, 0.f, 0.f};
    bf16x8 At[4][2], B0[2][2], B1[2][2];
    const char* cA = (const char*)(cur.which ? g.A2 : g.A) + (size_t)cur.pm * tstep; const char* cB = (const char*)(cur.which ? g.Bt2 : g.Bt) + (size_t)cur.pn * tstep;
    PG8_STAGE(PG8_SB(0, 0), cB, voffB); PG8_STAGE(PG8_SB(0, 1), cB + hstep, voffB); PG8_STAGE(PG8_SA(0, 0), cA, voffA); PG8_STAGE(PG8_SA(0, 1), cA + hstep, voffA);
    if (wr == 1) PG8_BAR;
    PG8_WAIT_V(2); PG8_BAR;
    PG8_STAGE(PG8_SB(1, 0), cB + kstep, voffB); PG8_STAGE(PG8_SA(1, 0), cA + kstep, voffA); PG8_STAGE(PG8_SB(1, 1), cB + hstep + kstep, voffB);
    PG8_WAIT_V(6); PG8_BAR;
    for (;;) {
        const bool has_next = S.next(ui + 1, nxt);
        const char* nA = has_next ? (const char*)(nxt.which ? g.A2 : g.A) + (size_t)nxt.pm * tstep : cA; const char* nB = has_next ? (const char*)(nxt.which ? g.Bt2 : g.Bt) + (size_t)nxt.pn * tstep : cB;
        for (int t = 0; t < nt; t += 2) {
            const bool last = (t == nt - 2);
            const char* a1 = cA + (size_t)(t + 1) * kstep;
            const char* a2 = last ? nA : cA + (size_t)(t + 2) * kstep; const char* b2 = last ? nB : cB + (size_t)(t + 2) * kstep;
            const char* a3 = a2 + kstep; const char* b3 = b2 + kstep;
            PG8_LDB(B0, 0, 0); PG8_LDB(B1, 0, 1); PG8_SCHED; PG8_LDA(At, 0, 0); PG8_STAGE(PG8_SA(1, 1), a1 + hstep, voffA);
            PG8_WAIT_V(8); PG8_WAIT_L(0); PG8_BAR; PG8_MMA(0, 0, At, B0); PG8_MMA(0, 1, At, B1); PG8_BAR; PG8_SCHED;
            PG8_LDA(At, 0, 1); PG8_STAGE(PG8_SB(0, 0), b2, voffB); PG8_STAGE(PG8_SB(0, 1), b2 + hstep, voffB); PG8_STAGE(PG8_SA(0, 0), a2, voffA);
            PG8_WAIT_V(8); PG8_WAIT_L(0); PG8_BAR; PG8_MMA(1, 0, At, B0); PG8_MMA(1, 1, At, B1); PG8_BAR; PG8_SCHED;
            PG8_LDB(B0, 1, 0); PG8_LDB(B1, 1, 1); PG8_SCHED; PG8_LDA(At, 1, 0); PG8_STAGE(PG8_SA(0, 1), a2 + hstep, voffA);
            PG8_WAIT_V(8); PG8_WAIT_L(0); PG8_BAR; PG8_MMA(0, 0, At, B0); PG8_MMA(0, 1, At, B1); PG8_BAR; PG8_SCHED;
            PG8_LDA(At, 1, 1); PG8_STAGE(PG8_SB(1, 0), b3, voffB); PG8_STAGE(PG8_SB(1, 1), b3 + hstep, voffB); PG8_STAGE(PG8_SA(1, 0), a3, voffA);
            PG8_WAIT_V(8); PG8_WAIT_L(0); PG8_BAR; PG8_MMA(1, 0, At, B0); PG8_MMA(1, 1, At, B1); PG8_BAR; PG8_SCHED;
        }
        if (wr == 0) PG8_BAR;
        const bool keep = E(acc, cur, wr, wc, fr, fq);
        if (!has_next) break;
        if (!keep)
#pragma unroll
        for (int a = 0; a < 2; ++a)
#pragma unroll
            for (int b = 0; b < 2; ++b)
#pragma unroll
                for (int m = 0; m < 4; ++m)
#pragma unroll
                    for (int n = 0; n < 2; ++n) acc[a][b][m][n] = (f32x4){0.f, 0.f, 0.f, 0.f};
        cur = nxt; cA = nA; cB = nB; ++ui;
        if (wr == 1) PG8_BAR;
    }
    PG8_WAIT_V(0);
    PG8_BAR;
#undef PG8_SA
#undef PG8_SB
#undef PG8_STAGE
#undef PG8_LDA
#undef PG8_LDB
#undef PG8_MMA
#undef PG8_WAIT_V
#undef PG8_WAIT_L
#undef PG8_BAR
#undef PG8_SCHED
}
}
using pg8::Unit;

#define EPI_ARGS f32x4 (&acc)[2][2][4][2], const Unit& u, int wr, int wc, int fr, int fq
#define EPI_FOR_ROWS _Pragma("unroll") for (int ai = 0; ai < 2; ++ai) _Pragma("unroll") for (int m = 0; m < 4; ++m)
#define EPI_FOR_BJ _Pragma("unroll") for (int bj = 0; bj < 2; ++bj)

struct EpiIn {
    bf16_t *Q, *K, *V, *G, *U, *VS, *KC, *VC; const f32x4* rope;
    __device__ __forceinline__ bool operator()(EPI_ARGS) const {
        const int region = u.pn >> 3, hcol = (u.pn & 7) * 256;
        const bool isctx = u.pm >= 64;
        bf16_t* base; int mode; float sc = 1.0f;
        switch (region) {
            case 0: base = Q; mode = 0; break;
            case 1: base = isctx ? KC : K; mode = isctx ? 1 : 0; sc = 0.0625f; break;
            case 2: base = isctx ? VC : V; mode = 1; break;
            case 3: base = G; mode = 2; break;
            case 4: base = U; mode = 3; break;
            case 5: base = VS; mode = 3; break;
            case 6: base = K; mode = 4; break;
            default: base = V; mode = 4; break;
        }
        const int prow = isctx ? (u.pm - 64) * 256 : u.pm * 256;
        const int col0 = hcol + wc * 32 + fq * 8;
        if (mode == 0) {
            const int lbase = (u.pm & 7) * 256, tcol = wc * 8 + fq * 2;
            f32x4 tr[2][2], tc[4][2];
#pragma unroll
            for (int ai = 0; ai < 2; ++ai) { const int pos = (lbase + ai * 128 + wr * 64) >> 6; tr[ai][0] = rope[pos * 32 + tcol]; tr[ai][1] = rope[pos * 32 + tcol + 1]; }
#pragma unroll
            for (int m = 0; m < 4; ++m) { const int pos = m * 16 + fr; tc[m][0] = rope[pos * 32 + tcol]; tc[m][1] = rope[pos * 32 + tcol + 1]; }
            EPI_FOR_ROWS {
                const int rl = ai * 128 + wr * 64 + m * 16 + fr;
                bf16_t* rowp = base + (size_t)(prow + rl) * DM + col0;
                EPI_FOR_BJ {
                    const f32x4 t0 = bj == 0 ? tr[ai][0] : tc[m][0], t1 = bj == 0 ? tr[ai][1] : tc[m][1];
                    const f32x4 v0 = acc[ai][bj][m][0] * sc, v1 = acc[ai][bj][m][1] * sc;
                    u32x4 w;
                    w.x = cvtpk(v0[0] * t0[0] - v0[1] * t0[1], v0[1] * t0[0] + v0[0] * t0[1]);
                    w.y = cvtpk(v0[2] * t0[2] - v0[3] * t0[3], v0[3] * t0[2] + v0[2] * t0[3]);
                    w.z = cvtpk(v1[0] * t1[0] - v1[1] * t1[1], v1[1] * t1[0] + v1[0] * t1[1]);
                    w.w = cvtpk(v1[2] * t1[2] - v1[3] * t1[3], v1[3] * t1[2] + v1[2] * t1[3]);
                    *(u32x4*)(rowp + bj * 128) = w;
                }
            }
        } else {
            EPI_FOR_ROWS {
                const int rl = ai * 128 + wr * 64 + m * 16 + fr;
                bf16_t* rowp = base + (size_t)(prow + rl) * DM + col0;
                EPI_FOR_BJ {
                    f32x4 v0 = acc[ai][bj][m][0], v1 = acc[ai][bj][m][1];
                    if (mode == 1) { v0 = v0 * sc; v1 = v1 * sc; }
                    else if (mode == 2) {
#pragma unroll
                        for (int e = 0; e < 4; ++e) { v0[e] = fast_silu(v0[e]); v1[e] = fast_silu(v1[e]); } }
                    else if (mode == 3) {
#pragma unroll
                        for (int e = 0; e < 4; ++e) { v0[e] = fast_gelu(v0[e]); v1[e] = fast_gelu(v1[e]); } }
                    else {
#pragma unroll
                        for (int e = 0; e < 4; ++e) { v0[e] = fast_sigmoid(v0[e]); v1[e] = fast_sigmoid(v1[e]); } }
                    u32x4 w; w.x = cvtpk(v0[0], v0[1]); w.y = cvtpk(v0[2], v0[3]); w.z = cvtpk(v1[0], v1[1]); w.w = cvtpk(v1[2], v1[3]);
                    *(u32x4*)(rowp + bj * 128) = w;
                }
            }
        }
        return false;
    }
};
struct EpiDual {
    const bf16_t* GR; const bf16_t* GS; bf16_t* MG;
    __device__ __forceinline__ bool operator()(EPI_ARGS) const {
        const int col0 = u.pn * 256 + wc * 32 + fq * 8;
        const size_t off0 = (size_t)(u.pm * 256 + wr * 64 + fr) * DM + col0;
        if (u.which == 0) {
#pragma unroll
            for (int ai = 0; ai < 2; ++ai) {
                u32x4 rw[4][2], sw[4][2];
#pragma unroll
                for (int m = 0; m < 4; ++m)
#pragma unroll
                    for (int bj = 0; bj < 2; ++bj) { const size_t off = off0 + (size_t)(ai * 128 + m * 16) * DM + bj * 128; rw[m][bj] = *(const u32x4*)(GR + off); sw[m][bj] = *(const u32x4*)(GS + off); }
                asm volatile("" ::: "memory");
#pragma unroll
                for (int m = 0; m < 4; ++m)
#pragma unroll
                    for (int bj = 0; bj < 2; ++bj)
#pragma unroll
                        for (int e = 0; e < 4; ++e) {
                            const float r0 = bflo(rw[m][bj][e]) * __builtin_amdgcn_rcpf(fmaxf(bflo(sw[m][bj][e]), 1e-30f)), r1 = bfhi(rw[m][bj][e]) * __builtin_amdgcn_rcpf(fmaxf(bfhi(sw[m][bj][e]), 1e-30f));
                            acc[ai][bj][m][e >> 1][(e & 1) * 2] *= r0; acc[ai][bj][m][e >> 1][(e & 1) * 2 + 1] *= r1; }
            }
            return true;
        }
#pragma unroll
        for (int ai = 0; ai < 2; ++ai) {
            u32x4 gw[4][2];
#pragma unroll
            for (int m = 0; m < 4; ++m)
#pragma unroll
                for (int bj = 0; bj < 2; ++bj) gw[m][bj] = *(const u32x4*)(GS + off0 + (size_t)(ai * 128 + m * 16) * DM + bj * 128);
            asm volatile("" ::: "memory");
#pragma unroll
            for (int m = 0; m < 4; ++m)
#pragma unroll
                for (int bj = 0; bj < 2; ++bj) {
                    const f32x4 v0 = acc[ai][bj][m][0], v1 = acc[ai][bj][m][1]; const u32x4 g = gw[m][bj];
                    u32x4 w; w.x = cvtpk(v0[0] * bflo(g.x), v0[1] * bfhi(g.x)); w.y = cvtpk(v0[2] * bflo(g.y), v0[3] * bfhi(g.y));
                    w.z = cvtpk(v1[0] * bflo(g.z), v1[1] * bfhi(g.z)); w.w = cvtpk(v1[2] * bflo(g.w), v1[3] * bfhi(g.w));
                    *(u32x4*)(MG + off0 + (size_t)(ai * 128 + m * 16) * DM + bj * 128) = w;
                }
            asm volatile("" ::: "memory");
        }
        return false;
    }
};
struct EpiRes {
    const float* res; const float* gate; float* out;
    __device__ __forceinline__ bool operator()(EPI_ARGS) const {
        const int col0 = u.pn * 256 + wc * 32 + fq * 8;
        const float* gp = gate + (size_t)(u.pm >> 3) * NMOD + col0;
        const size_t off0 = (size_t)(u.pm * 256 + wr * 64 + fr) * DM + col0;
        f32x4 g0[2], g1[2];
        EPI_FOR_BJ { g0[bj] = *(const f32x4*)(gp + bj * 128); g1[bj] = *(const f32x4*)(gp + bj * 128 + 4); }
#pragma unroll
        for (int ai = 0; ai < 2; ++ai) {
            f32x4 r0[4][2], r1[4][2];
#pragma unroll
            for (int m = 0; m < 4; ++m)
#pragma unroll
                for (int bj = 0; bj < 2; ++bj) { const float* p = res + off0 + (size_t)(ai * 128 + m * 16) * DM + bj * 128; r0[m][bj] = *(const f32x4*)p; r1[m][bj] = *(const f32x4*)(p + 4); }
            asm volatile("" ::: "memory");
#pragma unroll
            for (int m = 0; m < 4; ++m)
#pragma unroll
                for (int bj = 0; bj < 2; ++bj) { float* p = out + off0 + (size_t)(ai * 128 + m * 16) * DM + bj * 128;
                    *(f32x4*)p = r0[m][bj] + g0[bj] * acc[ai][bj][m][0]; *(f32x4*)(p + 4) = r1[m][bj] + g1[bj] * acc[ai][bj][m][1]; }
            asm volatile("" ::: "memory");
        }
        return false;
    }
};
struct EpiSwiglu {
    bf16_t* HID;
    __device__ __forceinline__ bool operator()(EPI_ARGS) const {
        const int col0 = u.pn * 128 + wc * 16 + fq * 4;
        EPI_FOR_ROWS {
            bf16_t* rowp = HID + (size_t)(u.pm * 256 + ai * 128 + wr * 64 + m * 16 + fr) * FF + col0;
            EPI_FOR_BJ {
                const f32x4 a = acc[ai][bj][m][0], b = acc[ai][bj][m][1];
                u32x2 w; w.x = cvtpk(fast_silu(a[0]) * b[0], fast_silu(a[1]) * b[1]); w.y = cvtpk(fast_silu(a[2]) * b[2], fast_silu(a[3]) * b[3]);
                *(u32x2*)(rowp + bj * 64) = w;
            }
        }
        return false;
    }
};

struct Args {
    const float *x, *c, *ctx, *c_ctx, *w_mod, *b_mod, *norm1_g, *w_in, *dec_f, *dec_b, *sg_ln_g, *sg_ln_b, *sg_w, *sg_b, *w_ret_o, *w_sg_o, *w_out, *norm2_g, *w_ffn_in, *w_ffn_out, *final_g;
    float* out; unsigned char* ws;
};

__device__ __forceinline__ int src_col(int kind, int n) {
    if (kind == 1) { if (n >= 4096) return n; const int cp = n & 255, half = cp >> 7, within = cp & 127; return (n & ~255) + half * 128 + (within & 1) * 64 + (within >> 1); }
    if (kind == 2) { const int grp = n >> 3, w = n & 7; return w < 4 ? grp * 4 + w : FF + grp * 4 + (w - 4); }
    return n;
}
__device__ __forceinline__ void transpose_item(const float* W, int K, int N, bf16_t* WT, int kind, LAS float* scr, int item, int lane) {
    const int nblk = N >> 6, kb = item / nblk, nb = item - kb * nblk, k0 = kb * 64, n0 = nb * 64;
    const float* src = W + (size_t)k0 * N + src_col(kind, n0 + lane);
#pragma unroll 8
    for (int i = 0; i < 64; ++i) scr[i * 65 + lane] = src[(size_t)i * N];
    asm volatile("s_waitcnt lgkmcnt(0)" ::: "memory");
    const int c = lane & 7;
#pragma unroll
    for (int j = 0; j < 8; ++j) { const int n = (lane >> 3) + 8 * j; const LAS float* s = scr + (8 * c) * 65 + n;
        u32x4 o; o.x = cvtpk(s[0 * 65], s[1 * 65]); o.y = cvtpk(s[2 * 65], s[3 * 65]); o.z = cvtpk(s[4 * 65], s[5 * 65]); o.w = cvtpk(s[6 * 65], s[7 * 65]);
        *(u32x4*)(WT + (size_t)(n0 + n) * K + k0 + 8 * c) = o; }
    asm volatile("s_waitcnt lgkmcnt(0)" ::: "memory");
}

__device__ __forceinline__ void p0_prologue(const Args& a, LAS unsigned char* lds, int tid, int wid, int lane, int G) {
    unsigned char* ws = a.ws;
    if ((int)blockIdx.x < 192) {
        LAS float* sl = (LAS float*)lds;
        LAS float* part = (LAS float*)(lds + 73728);
        for (int i = tid; i < 9 * DM; i += 512) { const float v = i < 8 * DM ? a.c[i] : a.c_ctx[i - 8 * DM]; sl[i] = fast_silu(v); }
        __syncthreads();
        const int n = blockIdx.x * 64 + lane;
        float accv[9];
#pragma unroll
        for (int r = 0; r < 9; ++r) accv[r] = 0.f;
        const float* wp = a.w_mod + (size_t)(wid * 256) * NMOD + n;
#pragma unroll 16
        for (int k = 0; k < 256; ++k) { const float wv = wp[(size_t)k * NMOD];
#pragma unroll
            for (int r = 0; r < 9; ++r) accv[r] += sl[r * DM + wid * 256 + k] * wv; }
#pragma unroll
        for (int r = 0; r < 9; ++r) part[(wid * 9 + r) * 64 + lane] = accv[r];
        __syncthreads();
        for (int i = tid; i < 9 * 64; i += 512) { const int r = i >> 6, cc = i & 63; float s = 0.f;
#pragma unroll
            for (int w = 0; w < 8; ++w) s += part[(w * 9 + r) * 64 + cc];
            ((float*)(ws + WS_MOD))[(size_t)r * NMOD + blockIdx.x * 64 + cc] = s + a.b_mod[blockIdx.x * 64 + cc]; }
        __syncthreads();
    } else if ((int)blockIdx.x == G - 1) {
        f32x2* tab = (f32x2*)(ws + WS_ROPE);
        for (int i = tid; i < 64 * 64; i += 512) { const int pos = i >> 6, f = i & 63; const float freq = exp2f(-(float)f * (13.287712379549449f / 64.0f)); const float ang = (float)pos * freq;
            tab[i] = (f32x2){cosf(ang), sinf(ang)}; }
    } else if ((int)blockIdx.x == G - 2) {
        bf16_t* sw = (bf16_t*)(ws + WS_SGW);
        for (int i = tid; i < 8 * 128 * 128 / 2; i += 512) ((unsigned*)sw)[i] = cvtpk(a.sg_w[2 * i], a.sg_w[2 * i + 1]);
    }
    LAS float* scr = (LAS float*)(lds + wid * 16640);
    const int gw = blockIdx.x * 8 + wid, NGW = G * 8;
    constexpr int I_IN = 32 * 256, I_SQ = 32 * 32, NITEMS = I_IN + 3 * I_SQ;
    const int nfree = G > 192 ? G - 192 : 0, E = nfree * 8 * 4 < NITEMS ? nfree * 8 * 4 : NITEMS;
    const bool isfree = (int)blockIdx.x >= 192;
    for (int it = isfree ? ((int)blockIdx.x - 192) * 8 + wid : E + gw; it < NITEMS; ) {
        int r = it;
        it = (it < E) ? ((it + nfree * 8 < E) ? it + nfree * 8 : E + gw) : it + NGW;
        if (r < I_IN) { transpose_item(a.w_in, DM, DIN, (bf16_t*)(ws + WS_WIN), 1, scr, r, lane); continue; } r -= I_IN;
        if (r < I_SQ) { transpose_item(a.w_ret_o, DM, DM, (bf16_t*)(ws + WS_W3), 0, scr, r, lane); continue; } r -= I_SQ;
        if (r < I_SQ) { transpose_item(a.w_sg_o, DM, DM, (bf16_t*)(ws + WS_W3 + 8 * MiB), 0, scr, r, lane); continue; } r -= I_SQ;
        transpose_item(a.w_out, DM, DM, (bf16_t*)(ws + WS_W3 + 16 * MiB), 0, scr, r, lane);
    }
}
__device__ __forceinline__ void convert_ffn(const Args& a, LAS unsigned char* lds, int cw, int ncw, int wid, int lane) {
    LAS float* scr = (LAS float*)(lds + wid * 16640);
    constexpr int I_F1 = 32 * 176, I_F2 = 88 * 32;
    for (int it = cw; it < I_F1 + I_F2; it += ncw) {
        if (it < I_F1) transpose_item(a.w_ffn_in, DM, 2 * FF, (bf16_t*)(a.ws + WS_WF1), 2, scr, it, lane);
        else transpose_item(a.w_ffn_out, FF, DM, (bf16_t*)(a.ws + WS_WF2), 0, scr, it - I_F1, lane);
    }
}

template <bool FINAL>
__device__ __forceinline__ void rows_phase(const float* srcL, const float* srcC, int nL, int nTot, const float* g, const float* mod, int sh_off, int sc_off, void* dst, int gw, int NGW, int lane) {
    asm volatile("" : "+v"(lane));
    const int per = (nTot + NGW - 1) / NGW; const int r0 = gw * per; int r1 = r0 + per; if (r1 > nTot) r1 = nTot;
    if (r0 >= r1) return;
    f32x4 v[8], A[8], B[8]; int cur = -1;
    { const float* p = (r0 < nL ? srcL + (size_t)r0 * DM : srcC + (size_t)(r0 - nL) * DM) + lane * 4;
#pragma unroll
      for (int j = 0; j < 8; ++j) v[j] = *(const f32x4*)(p + j * 256); }
#pragma unroll 1
    for (int row = r0; row < r1; ++row) {
        f32x4 vn[8];
        const bool more = row + 1 < r1;
        if (more) { const int rn = row + 1; const float* p = (rn < nL ? srcL + (size_t)rn * DM : srcC + (size_t)(rn - nL) * DM) + lane * 4;
#pragma unroll
            for (int j = 0; j < 8; ++j) vn[j] = *(const f32x4*)(p + j * 256); }
        const int mr = FINAL ? 0 : (row < nL ? (row >> 11) : 8);
        if (mr != cur) { cur = mr;
#pragma unroll
            for (int j = 0; j < 8; ++j) { const int o = j * 256 + lane * 4; const f32x4 gg = *(const f32x4*)(g + o);
                if (FINAL) { A[j] = gg; B[j] = (f32x4){0.f, 0.f, 0.f, 0.f}; }
                else { const float* mp = mod + (size_t)mr * NMOD + o; A[j] = gg * (*(const f32x4*)(mp + sc_off) + 1.0f); B[j] = *(const f32x4*)(mp + sh_off); } } }
        float ss = 0.f;
#pragma unroll
        for (int j = 0; j < 8; ++j) ss += (v[j][0] * v[j][0] + v[j][1] * v[j][1]) + (v[j][2] * v[j][2] + v[j][3] * v[j][3]);
        const float rstd = 1.0f / sqrtf(wave_sum(ss) * (1.0f / DM) + EPS);
#pragma unroll
        for (int j = 0; j < 8; ++j) { const int o = j * 256 + lane * 4;
            if (FINAL) *(f32x4*)((float*)dst + (size_t)row * DM + o) = v[j] * rstd * A[j];
            else { const f32x4 y = v[j] * rstd * A[j] + B[j]; u32x2 w; w.x = cvtpk(y[0], y[1]); w.y = cvtpk(y[2], y[3]); *(u32x2*)((bf16_t*)dst + (size_t)row * DM + o) = w; } }
        if (more) {
#pragma unroll
            for (int j = 0; j < 8; ++j) v[j] = vn[j]; }
    }
}

__device__ __forceinline__ s16x4 vtr(const LAS unsigned char* p) { return __builtin_bit_cast(s16x4, __builtin_amdgcn_ds_read_tr16_b64_v4i16((LAS v4i16_t*)p)); }
#define MFMA32(a, b, c) __builtin_amdgcn_mfma_f32_32x32x16_bf16((a), (b), (c), 0, 0, 0)

__device__ __forceinline__ void glds16(const void* gsrc, unsigned lds_dst) { unsigned keep;
    asm volatile("s_mov_b32 %0, m0\n\ts_mov_b32 m0, %2\n\ts_nop 0\n\tglobal_load_lds_dwordx4 %1, off\n\ts_mov_b32 m0, %0" : "=&s"(keep) : "v"(gsrc), "s"(lds_dst) : "memory"); }
template <bool ISV>
__device__ __forceinline__ void ret_issue(LAS unsigned char* dst, const bf16_t* T, int wid, int lane) {
    const int rsub = lane >> 5, pc = lane & 31;
    const unsigned d0 = (unsigned)(__UINTPTR_TYPE__)dst;
#pragma unroll
    for (int cc = 0; cc < 4; ++cc) {
        const int c = wid * 4 + cc, row = 2 * c + rsub;
        const int lc = ISV ? (pc ^ ((row & 3) << 2)) : (pc ^ (row & 15));
        glds16(T + (size_t)row * DM + lc * 8, (unsigned)__builtin_amdgcn_readfirstlane(d0 + c * 1024));
    }
}
struct RetC { const bf16_t *Kl0, *Vl0; float lf2, lb2, gi, gi8, gb, gb8; int iabs, qr0, r, h, hf, tq, vlane, myx, pbx, kend; };
template <bool PV, bool CTX>
__device__ __forceinline__ void ret_iter(LAS unsigned char* lds, const RetC& c, int kt, f32x16 (&O)[4], const bf16x8 (&qf)[16], int wid, int lane) {
    LAS unsigned char* xch = lds + LDS_XCH;
    asm volatile("s_waitcnt vmcnt(0) lgkmcnt(0)" ::: "memory");
    __builtin_amdgcn_s_barrier();
    asm volatile("" ::: "memory");
    if (kt + 1 < c.kend) { const int k1 = kt + 1; ret_issue<false>(lds + (k1 & 1) * 65536, c.Kl0 + (size_t)(k1 * 64) * DM, wid, lane); }
    if (kt < c.kend) ret_issue<true>(lds + 32768 + (kt & 1) * 65536, c.Vl0 + (size_t)(kt * 64) * DM, wid, lane);
    const LAS unsigned char* Kl = lds + (kt & 1) * 65536;
    int krow = 32 * c.hf + c.r; asm volatile("" : "+v"(krow));
    const LAS unsigned char* kb = Kl + krow * 512; const int cx = ((krow & 15) ^ c.h) << 4;
    f32x16 st;
#pragma unroll
    for (int i = 0; i < 16; ++i) st[i] = 0.f;
    bf16x8 kf[2][4];
#define RET_PIN asm volatile("" ::: "memory")
#define RET_SB __builtin_amdgcn_sched_barrier(0)
#define RET_KREAD(g) do { _Pragma("unroll") for (int j = 0; j < 4; ++j) kf[(g) & 1][j] = *(const LAS bf16x8*)(kb + ((32 * (4 * (g) + j)) ^ cx)); RET_PIN; } while (0)
#define RET_KMMA(g) do { _Pragma("unroll") for (int j = 0; j < 4; ++j) st = MFMA32(kf[(g) & 1][j], qf[4 * (g) + j], st); } while (0)
    RET_KREAD(0); RET_SB;
    RET_KREAD(1); RET_KMMA(0); RET_SB;
    RET_KREAD(2); RET_KMMA(1); RET_SB;
    RET_KREAD(3); RET_KMMA(2); RET_SB;
    if (PV) {
        const LAS unsigned char* Vl = lds + 32768 + ((kt + 1) & 1) * 65536;
        int vb = c.vlane; asm volatile("" : "+v"(vb));
        const LAS unsigned char* vbase = Vl + vb;
        const LAS unsigned char* pbase = xch + c.pbx;
        const int vo0 = ((0 ^ c.tq) & 3) << 6, vo1 = ((1 ^ c.tq) & 3) << 6, vo2 = ((2 ^ c.tq) & 3) << 6, vo3 = ((3 ^ c.tq) & 3) << 6;
        s16x4 vlo[2][4], vhi[2][4]; bf16x8 pf[2];
#define RET_VREAD(g) do { const LAS unsigned char* _p = vbase + ((g) * 16) * 512; pf[(g) & 1] = *(const LAS bf16x8*)(pbase + (g) * 1024); \
            vlo[(g) & 1][0] = vtr(_p + vo0); vhi[(g) & 1][0] = vtr(_p + vo0 + 4096); vlo[(g) & 1][1] = vtr(_p + vo1); vhi[(g) & 1][1] = vtr(_p + vo1 + 4096); \
            vlo[(g) & 1][2] = vtr(_p + vo2); vhi[(g) & 1][2] = vtr(_p + vo2 + 4096); vlo[(g) & 1][3] = vtr(_p + vo3); vhi[(g) & 1][3] = vtr(_p + vo3 + 4096); RET_PIN; } while (0)
#define RET_VMMA(g) do { _Pragma("unroll") for (int d = 0; d < 4; ++d) O[d] = MFMA32(pf[(g) & 1], __builtin_shufflevector(vlo[(g) & 1][d], vhi[(g) & 1][d], 0, 1, 2, 3, 4, 5, 6, 7), O[d]); } while (0)
        RET_VREAD(0); RET_KMMA(3); RET_SB;
        RET_VREAD(1); RET_VMMA(0); RET_SB;
        RET_VREAD(2); RET_VMMA(1); RET_SB;
        RET_VREAD(3); RET_VMMA(2); RET_SB;
        RET_VMMA(3); RET_SB;
#undef RET_VREAD
#undef RET_VMMA
    } else {
        RET_KMMA(3); RET_SB;
    }
#undef RET_KREAD
#undef RET_KMMA
#undef RET_SB
#undef RET_PIN
    {
        const int k0 = kt * 64 + 32 * c.hf;
        if (!CTX) {
            const int d0 = c.iabs - (k0 + 4 * c.h);
            if (k0 != c.qr0) {
                const bool fwd = c.qr0 > k0;
                const float m = fwd ? c.gi : c.gb, m8 = fwd ? c.gi8 : c.gb8;
                float w[4]; w[0] = __builtin_amdgcn_exp2f((float)d0 * (fwd ? c.lf2 : -c.lb2)); w[1] = w[0] * m; w[2] = w[1] * m; w[3] = w[2] * m;
#pragma unroll
                for (int q4 = 0; q4 < 4; ++q4) {
#pragma unroll
                    for (int e = 0; e < 4; ++e) { st[4 * q4 + e] *= w[e]; w[e] *= m8; } }
            } else {
#pragma unroll
                for (int i = 0; i < 16; ++i) { const int dist = d0 - ((i & 3) + 8 * (i >> 2)); const float fd = (float)dist; st[i] *= __builtin_amdgcn_exp2f(fd * (dist >= 0 ? c.lf2 : -c.lb2)); }
            }
        } else {
            const int l0 = (kt - 32) * 64 + 32 * c.hf + 4 * c.h;
            float wf[4], wb[4];
            wf[0] = __builtin_amdgcn_exp2f(c.lf2 * (float)(c.iabs + LCTX - l0)); wf[1] = wf[0] * c.gi; wf[2] = wf[1] * c.gi; wf[3] = wf[2] * c.gi;
            wb[0] = __builtin_amdgcn_exp2f(c.lb2 * (float)(SEQ + l0 - c.iabs)); wb[1] = wb[0] * c.gb; wb[2] = wb[1] * c.gb; wb[3] = wb[2] * c.gb;
#pragma unroll
            for (int q4 = 0; q4 < 4; ++q4) {
#pragma unroll
                for (int e = 0; e < 4; ++e) { st[4 * q4 + e] *= wf[e] + wb[e]; wf[e] *= c.gi8; wb[e] *= c.gb8; } }
        }
    }
    u32x4 p0, p1;
    p0.x = cvtpk(st[0], st[1]); p0.y = cvtpk(st[2], st[3]); p0.z = cvtpk(st[4], st[5]); p0.w = cvtpk(st[6], st[7]);
    p1.x = cvtpk(st[8], st[9]); p1.y = cvtpk(st[10], st[11]); p1.z = cvtpk(st[12], st[13]); p1.w = cvtpk(st[14], st[15]);
    asm volatile("s_waitcnt lgkmcnt(0)" ::: "memory");
    __builtin_amdgcn_s_barrier();
    asm volatile("" ::: "memory");
    *(LAS u32x4*)(xch + c.myx) = p0; *(LAS u32x4*)(xch + c.myx + 1024) = p1;
}

__device__ __forceinline__ void retention_unit(LAS unsigned char* lds, const Args& a, int b, int hh, int qb, int wid, int lane) {
    unsigned char* ws = a.ws;
    bf16_t* Qp = (bf16_t*)(ws + WS_Q); const bf16_t* Kp = (const bf16_t*)(ws + WS_K); const bf16_t* Vp = (const bf16_t*)(ws + WS_V);
    const bf16_t* Gp = (const bf16_t*)(ws + WS_G);
    asm volatile("" : "+v"(lane));
    const int r = lane & 31, h = lane >> 5, rg = wid >> 1, hf = wid & 1;
    const int ch = qb / (RCH / 128), kbeg = (RCH / 64) * ch;
    RetC c; c.kend = kbeg + RCH / 64;
    c.lf2 = -log1pf(expf(-a.dec_f[hh])) * 1.4426950408889634f; c.lb2 = -log1pf(expf(-a.dec_b[hh])) * 1.4426950408889634f;
    c.iabs = qb * 128 + rg * 32 + r; c.qr0 = qb * 128 + rg * 32; c.r = r; c.h = h; c.hf = hf;
    c.gi = exp2f(-c.lf2); { const float t2 = c.gi * c.gi, t4 = t2 * t2; c.gi8 = t4 * t4; } c.gb = exp2f(c.lb2); { const float t2 = c.gb * c.gb, t4 = t2 * t2; c.gb8 = t4 * t4; }
#define RET_UNI(x) x = __uint_as_float(__builtin_amdgcn_readfirstlane(__float_as_uint(x)))
    RET_UNI(c.lf2); RET_UNI(c.lb2); RET_UNI(c.gi); RET_UNI(c.gi8); RET_UNI(c.gb); RET_UNI(c.gb8);
#undef RET_UNI
    bf16x8 qf[16];
    { const bf16_t* qp = Qp + (size_t)(b * SEQ + c.iabs) * DM + hh * 256 + 8 * h;
#pragma unroll
      for (int s = 0; s < 16; ++s) qf[s] = *(const bf16x8*)(qp + 16 * s); }
    f32x16 O[4];
#pragma unroll
    for (int d = 0; d < 4; ++d)
#pragma unroll
        for (int i = 0; i < 16; ++i) O[d][i] = 0.f;
    c.Kl0 = Kp + (size_t)(b * SEQ) * DM + hh * 256; c.Vl0 = Vp + (size_t)(b * SEQ) * DM + hh * 256;
    const int tq = (lane & 15) >> 2, tp = lane & 3, g16 = (lane >> 4) & 1;
    c.tq = tq; c.vlane = (4 * h + tq) * 512 + (2 * g16 + (tp >> 1)) * 16 + (tp & 1) * 8 + hf * 256;
    c.myx = ((wid * 2) * 64 + lane) * 16; c.pbx = (((wid & ~1) * 2) * 64 + lane) * 16;
    ret_issue<false>(lds, c.Kl0 + (size_t)(kbeg * 64) * DM, wid, lane);
    ret_iter<false, false>(lds, c, kbeg, O, qf, wid, lane);
#pragma unroll 1
    for (int kt = kbeg + 1; kt <= kbeg + RCH / 64; ++kt) ret_iter<true, false>(lds, c, kt, O, qf, wid, lane);
    {
        const bf16_t* ST = (const bf16_t*)a.out + (size_t)MTOK * DM + (size_t)((b * 8 + hh) * 2 * NRCH) * 65536;
        const int g16 = (lane >> 4) & 1, tp = lane & 3, tq = c.tq;
        const unsigned l0 = (unsigned)(__UINTPTR_TYPE__)lds;
#pragma unroll 1
        for (int dir = 0; dir < 2; ++dir) {
            __syncthreads();
            const bf16_t* S = ST + (size_t)(dir * NRCH + ch) * 65536;
            { const int row0 = 32 * wid + (lane >> 5), pc = lane & 31;
              const bf16_t* sp = S + (size_t)row0 * 256; unsigned ld = l0 + wid * 16384;
#pragma unroll 1
              for (int cc = 0; cc < 16; ++cc) { const int lc = pc ^ (((2 * cc + (lane >> 5)) & 3) << 2);
                  glds16(sp + lc * 8, (unsigned)__builtin_amdgcn_readfirstlane(ld)); sp += 512; ld += 1024; } }
            asm volatile("s_waitcnt vmcnt(0)" ::: "memory");
            __syncthreads();
            const float aq = __builtin_amdgcn_exp2f(dir == 0 ? c.lf2 * (float)(c.iabs - RCH * ch + 1) : c.lb2 * (float)(RCH * (ch + 1) - c.iabs));
#pragma unroll
            for (int s = 0; s < 16; ++s) {
                const u32x4 qw = __builtin_bit_cast(u32x4, qf[s]); u32x4 pw;
                pw.x = cvtpk(bflo(qw.x) * aq, bfhi(qw.x) * aq); pw.y = cvtpk(bflo(qw.y) * aq, bfhi(qw.y) * aq);
                pw.z = cvtpk(bflo(qw.z) * aq, bfhi(qw.z) * aq); pw.w = cvtpk(bflo(qw.w) * aq, bfhi(qw.w) * aq);
                const bf16x8 af = __builtin_bit_cast(bf16x8, pw);
                const LAS unsigned char* vb = lds + (16 * s + 8 * h + tq) * 512 + (2 * g16 + (tp >> 1)) * 16 + (tp & 1) * 8;
#pragma unroll
                for (int d = 0; d < 4; ++d) { const int blk = 4 * hf + d;
                    const LAS unsigned char* vp = vb + (((blk ^ tq) & 3) << 6) + (blk >> 2) * 256;
                    const s16x4 lo = vtr(vp), hi = vtr(vp + 4 * 512);
                    O[d] = MFMA32(af, __builtin_shufflevector(lo, hi, 0, 1, 2, 3, 4, 5, 6, 7), O[d]); }
            }
        }
    }
    LAS float* xs = (LAS float*)(lds + LDS_XS);
    float rs[16];
#pragma unroll
    for (int i = 0; i < 16; ++i) { float s = 0.f;
#pragma unroll
        for (int d = 0; d < 4; ++d) s += O[d][i] * O[d][i];
        s += __shfl_xor(s, 1); s += __shfl_xor(s, 2); s += __shfl_xor(s, 4); s += __shfl_xor(s, 8); s += __shfl_xor(s, 16);
        rs[i] = s; if (r == 0) xs[wid * 32 + (i & 3) + 8 * (i >> 2) + 4 * h] = s; }
    __syncthreads();
#pragma unroll
    for (int i = 0; i < 16; ++i) { const float s = rs[i] + xs[(wid ^ 1) * 32 + (i & 3) + 8 * (i >> 2) + 4 * h]; rs[i] = 1.0f / sqrtf(s * (1.0f / 256.0f) + EPS); }
    const size_t obase = (size_t)(b * SEQ + qb * 128 + rg * 32 + 4 * h) * DM + hh * 256 + hf * 128 + r;
#pragma unroll
    for (int hh2 = 0; hh2 < 2; ++hh2) {
        bf16_t gv[8][4];
#pragma unroll
        for (int ii = 0; ii < 8; ++ii) { const int i = hh2 * 8 + ii; const size_t off = obase + (size_t)((i & 3) + 8 * (i >> 2)) * DM;
#pragma unroll
            for (int d = 0; d < 4; ++d) gv[ii][d] = Gp[off + 32 * d]; }
        asm volatile("" ::: "memory");
#pragma unroll
        for (int ii = 0; ii < 8; ++ii) { const int i = hh2 * 8 + ii; const size_t off = obase + (size_t)((i & 3) + 8 * (i >> 2)) * DM;
#pragma unroll
            for (int d = 0; d < 4; ++d) Qp[off + 32 * d] = (bf16_t)(cvtpk(O[d][i] * rs[i] * bf2f(gv[ii][d]), 0.f) & 0xffffu); }
        asm volatile("" ::: "memory");
    }
}

__device__ __forceinline__ void state_unit(LAS unsigned char* lds, const Args& a, int b, int hh, int dir, int eh, int wid, int lane) {
    unsigned char* ws = a.ws;
    asm volatile("" : "+v"(lane));
    const int r = lane & 31, h = lane >> 5, tq = (lane & 15) >> 2, tp = lane & 3, g16 = (lane >> 4) & 1;
    float lg2 = -log1pf(expf(-(dir ? a.dec_b[hh] : a.dec_f[hh]))) * 1.4426950408889634f;
    lg2 = __uint_as_float(__builtin_amdgcn_readfirstlane(__float_as_uint(lg2)));
    const float m = exp2f(dir ? lg2 : -lg2);
    const float gch = exp2f((float)RCH * lg2);
    const bf16_t* Kc = (const bf16_t*)(ws + WS_KC) + (size_t)(b * LCTX) * DM + hh * 256; const bf16_t* Vc = (const bf16_t*)(ws + WS_VC) + (size_t)(b * LCTX) * DM + hh * 256;
    const bf16_t* Kl = (const bf16_t*)(ws + WS_K) + (size_t)(b * SEQ) * DM + hh * 256; const bf16_t* Vl = (const bf16_t*)(ws + WS_V) + (size_t)(b * SEQ) * DM + hh * 256;
    bf16_t* ST = (bf16_t*)a.out + (size_t)MTOK * DM + (size_t)((b * 8 + hh) * 2 * NRCH) * 65536;
    constexpr int TPC = RCH / 64, NT = 4 + (NRCH - 1) * TPC;
#define ST_ROW(t_) ((t_) < 4 ? 0 : (dir ? (NRCH - 1 - ((t_) - 4) / TPC) : ((t_) - 4) / TPC) * RCH + (((t_) - 4) % TPC) * 64)
    f32x16 acc[4];
#pragma unroll
    for (int d = 0; d < 4; ++d)
#pragma unroll
        for (int i = 0; i < 16; ++i) acc[d][i] = 0.f;
    const int lanec = (2 * g16 + (tp >> 1)) * 16 + (tp & 1) * 8;
    ret_issue<true>(lds, Kc, wid, lane); ret_issue<true>(lds + 32768, Vc, wid, lane);
#pragma unroll 1
    for (int t = 0; t < NT; ++t) {
        asm volatile("s_waitcnt vmcnt(0) lgkmcnt(0)" ::: "memory");
        __builtin_amdgcn_s_barrier();
        asm volatile("" ::: "memory");
        if (t + 1 < NT) { const int t1 = t + 1; const bf16_t* kp = t1 < 4 ? Kc + (size_t)(t1 * 64) * DM : Kl + (size_t)ST_ROW(t1) * DM; const bf16_t* vp = t1 < 4 ? Vc + (size_t)(t1 * 64) * DM : Vl + (size_t)ST_ROW(t1) * DM;
            ret_issue<true>(lds + (t1 & 1) * 65536, kp, wid, lane); ret_issue<true>(lds + (t1 & 1) * 65536 + 32768, vp, wid, lane); }
        if (t >= 4 && (t - 4) % TPC == 0) {
            const int wi = (t - 4) / TPC; bf16_t* S = ST + (size_t)(dir ? NRCH + (NRCH - 1 - wi) : wi) * 65536;
#pragma unroll
            for (int d = 0; d < 4; ++d)
#pragma unroll
                for (int i = 0; i < 16; ++i) { S[(size_t)(32 * wid + (i & 3) + 8 * (i >> 2) + 4 * h) * 256 + 128 * eh + 32 * d + r] = (bf16_t)(cvtpk(acc[d][i], 0.f) & 0xffffu); acc[d][i] *= gch; }
        }
        const LAS unsigned char* Kt = lds + (t & 1) * 65536; const LAS unsigned char* Vt = Kt + 32768;
        const int p0 = (t < 4 ? 64 * t : 64 * ((t - 4) % TPC)) + 8 * h, last = t < 4 ? 255 : RCH - 1;
#pragma unroll
        for (int s = 0; s < 4; ++s) {
            const LAS unsigned char* kb = Kt + (16 * s + 8 * h + tq) * 512 + lanec + (((wid ^ tq) & 3) << 6) + (wid >> 2) * 256;
            const s16x4 klo = vtr(kb), khi = vtr(kb + 4 * 512);
            const int p = p0 + 16 * s;
            float w = __builtin_amdgcn_exp2f(lg2 * (float)(dir ? p : last - p));
            const u32x2 lw = __builtin_bit_cast(u32x2, klo), hw = __builtin_bit_cast(u32x2, khi);
            float kv[8] = {bflo(lw.x), bfhi(lw.x), bflo(lw.y), bfhi(lw.y), bflo(hw.x), bfhi(hw.x), bflo(hw.y), bfhi(hw.y)};
#pragma unroll
            for (int j = 0; j < 8; ++j) { kv[j] *= w; w *= m; }
            u32x4 pw; pw.x = cvtpk(kv[0], kv[1]); pw.y = cvtpk(kv[2], kv[3]); pw.z = cvtpk(kv[4], kv[5]); pw.w = cvtpk(kv[6], kv[7]);
            const bf16x8 af = __builtin_bit_cast(bf16x8, pw);
            const LAS unsigned char* vb = Vt + (16 * s + 8 * h + tq) * 512 + lanec;
#pragma unroll
            for (int d = 0; d < 4; ++d) { const int blk = 4 * eh + d;
                const LAS unsigned char* vp = vb + (((blk ^ tq) & 3) << 6) + (blk >> 2) * 256;
                const s16x4 lo = vtr(vp), hi = vtr(vp + 4 * 512);
                acc[d] = MFMA32(af, __builtin_shufflevector(lo, hi, 0, 1, 2, 3, 4, 5, 6, 7), acc[d]); }
        }
    }
    { bf16_t* S = ST + (size_t)(dir ? NRCH : NRCH - 1) * 65536;
#pragma unroll
      for (int d = 0; d < 4; ++d)
#pragma unroll
          for (int i = 0; i < 16; ++i) S[(size_t)(32 * wid + (i & 3) + 8 * (i >> 2) + 4 * h) * 256 + 128 * eh + 32 * d + r] = (bf16_t)(cvtpk(acc[d][i], 0.f) & 0xffffu); }
#undef ST_ROW
}

__device__ __forceinline__ void spatial_unit(LAS unsigned char* lds, const Args& a, int b, int n, int ghalf, int tid, int wid, int lane) {
    bf16_t* Up = (bf16_t*)a.out; const bf16_t* VSp = (const bf16_t*)a.out + (size_t)MTOK * DM;
    const bf16_t* Wb = (const bf16_t*)(a.ws + WS_SGW);
    asm volatile("" : "+v"(lane)); asm volatile("" : "+v"(tid));
    LAS f32x2* stats = (LAS f32x2*)(lds + LDS_STATS);
    const int tok0 = b * SEQ + n * 128;
#pragma unroll 1
    for (int t0 = wid * 16; t0 < wid * 16 + 16; t0 += 4) {
        u32x4 w[4][4];
#pragma unroll
        for (int tt = 0; tt < 4; ++tt)
#pragma unroll
            for (int j = 0; j < 4; ++j) w[tt][j] = *(const u32x4*)(VSp + (size_t)(tok0 + t0 + tt) * DM + j * 512 + lane * 8);
#pragma unroll
        for (int tt = 0; tt < 4; ++tt) { float s = 0.f, ss = 0.f;
#pragma unroll
            for (int j = 0; j < 4; ++j)
#pragma unroll
                for (int e = 0; e < 4; ++e) { const float x0 = bflo(w[tt][j][e]), x1 = bfhi(w[tt][j][e]); s += x0 + x1; ss += x0 * x0 + x1 * x1; }
            s = wave_sum(s); ss = wave_sum(ss);
            const float mean = s * (1.0f / DM); float var = ss * (1.0f / DM) - mean * mean; var = var > 0.f ? var : 0.f;
            if (lane == 0) stats[t0 + tt] = (f32x2){mean, 1.0f / sqrtf(var + EPS)}; }
    }
    __syncthreads();
    const int r = lane & 31, h = lane >> 5, ib = wid & 3, dbh = wid >> 2;
    const int tq = (lane & 15) >> 2, tp = lane & 3, g16 = (lane >> 4) & 1;
    for (int gi = 0; gi < 4; ++gi) {
        const int g = ghalf * 4 + gi;
        { const int lc = tid & 31, ch = g * 256 + lc * 8, row0 = tid >> 5;
          u32x4 w[8];
#pragma unroll
          for (int it = 0; it < 8; ++it) w[it] = *(const u32x4*)(VSp + (size_t)(tok0 + row0 + it * 16) * DM + ch);
          const f32x4 g0 = *(const f32x4*)(a.sg_ln_g + ch), g1 = *(const f32x4*)(a.sg_ln_g + ch + 4), b0 = *(const f32x4*)(a.sg_ln_b + ch), b1 = *(const f32x4*)(a.sg_ln_b + ch + 4);
#pragma unroll
          for (int it = 0; it < 8; ++it) { const int row = row0 + it * 16; const f32x2 st = stats[row];
            u32x4 o;
            o.x = cvtpk((bflo(w[it].x) - st.x) * st.y * g0[0] + b0[0], (bfhi(w[it].x) - st.x) * st.y * g0[1] + b0[1]);
            o.y = cvtpk((bflo(w[it].y) - st.x) * st.y * g0[2] + b0[2], (bfhi(w[it].y) - st.x) * st.y * g0[3] + b0[3]);
            o.z = cvtpk((bflo(w[it].z) - st.x) * st.y * g1[0] + b1[0], (bfhi(w[it].z) - st.x) * st.y * g1[1] + b1[1]);
            o.w = cvtpk((bflo(w[it].w) - st.x) * st.y * g1[2] + b1[2], (bfhi(w[it].w) - st.x) * st.y * g1[3] + b1[3]);
            *(LAS u32x4*)(lds + row * 512 + ((lc ^ ((row & 3) << 2)) << 4)) = o; } }
        __syncthreads();
        f32x16 acc[4];
#pragma unroll
        for (int d = 0; d < 4; ++d)
#pragma unroll
            for (int i = 0; i < 16; ++i) acc[d][i] = 0.f;
        const bf16_t* wrow = Wb + (size_t)g * 16384 + (size_t)(ib * 32 + r) * 128 + 8 * h;
        bf16x8 afr[8];
#pragma unroll
        for (int ks = 0; ks < 8; ++ks) afr[ks] = *(const bf16x8*)(wrow + 16 * ks);
#pragma unroll
        for (int ks = 0; ks < 8; ++ks) {
            const bf16x8 af = afr[ks];
            const LAS unsigned char* vb = lds + (16 * ks + 8 * h + tq) * 512 + (2 * g16 + (tp >> 1)) * 16 + (tp & 1) * 8;
#pragma unroll
            for (int d = 0; d < 4; ++d) { const int db = dbh * 4 + d;
                const LAS unsigned char* vp = vb + (((db ^ tq) & 3) << 6) + (db >> 2) * 256;
                const s16x4 lo = vtr(vp), hi = vtr(vp + 4 * 512);
                const bf16x8 bfr = __builtin_shufflevector(lo, hi, 0, 1, 2, 3, 4, 5, 6, 7);
                acc[d] = MFMA32(af, bfr, acc[d]); }
        }
#pragma unroll
        for (int hh2 = 0; hh2 < 2; ++hh2) {
            bf16_t uv[8][4]; float bias[8];
#pragma unroll
            for (int ii = 0; ii < 8; ++ii) { const int i = hh2 * 8 + ii, il = ib * 32 + (i & 3) + 8 * (i >> 2) + 4 * h; bias[ii] = a.sg_b[g * 128 + il];
                const size_t off = (size_t)(tok0 + il) * DM + g * 256 + dbh * 128 + r;
#pragma unroll
                for (int d = 0; d < 4; ++d) uv[ii][d] = Up[off + 32 * d]; }
            asm volatile("" ::: "memory");
#pragma unroll
            for (int ii = 0; ii < 8; ++ii) { const int i = hh2 * 8 + ii, il = ib * 32 + (i & 3) + 8 * (i >> 2) + 4 * h;
                const size_t off = (size_t)(tok0 + il) * DM + g * 256 + dbh * 128 + r;
#pragma unroll
                for (int d = 0; d < 4; ++d) Up[off + 32 * d] = (bf16_t)(cvtpk(bf2f(uv[ii][d]) * (acc[d][i] + bias[ii]), 0.f) & 0xffffu); }
            asm volatile("" ::: "memory");
        }
        __syncthreads();
    }
}

#define XB_TMO      128
#define XB_XCNT(j)  (256  + 64 * (j))
#define XB_XSUB(j)  (1280 + 64 * (j))
#define XB_XGEN(j)  (2304 + 64 * (j))
#define XB_TOP      3328
#define XB_TOPGEN   3392
#define XCD_BAR_WORDS 3456
#define XB_SPIN_CAP (1u << 22)
__device__ __forceinline__ unsigned xb_ld(unsigned* p)              { return __hip_atomic_load(p, __ATOMIC_RELAXED, __HIP_MEMORY_SCOPE_AGENT); }
__device__ __forceinline__ unsigned xb_add(unsigned* p, unsigned v) { return __hip_atomic_fetch_add(p, v, __ATOMIC_RELAXED, __HIP_MEMORY_SCOPE_AGENT); }
__device__ __forceinline__ unsigned xb_xcc_id() { return (unsigned)__builtin_amdgcn_s_getreg((3 << 11) | 20) & 0xFu; }
#define XB_SPIN(cond, bar) do { unsigned _sp = 0; while (cond) { __builtin_amdgcn_s_sleep(1); \
    if ((++_sp & 255u) == 0u) { if (xb_ld(&(bar)[XB_TMO])) break; if (_sp > XB_SPIN_CAP) { atomicAdd(&(bar)[XB_TMO], 1u); break; } } } } while (0)
struct XcdBarrier { unsigned* bar; unsigned x; volatile LAS unsigned* st; };
__device__ __forceinline__ XcdBarrier xcd_barrier_post(unsigned* bar, volatile LAS unsigned* st) {
    XcdBarrier b; b.bar = bar; b.x = xb_xcc_id(); b.st = st;
    if (threadIdx.x == 0) (void)xb_add(&bar[XB_XCNT(b.x)], 1u);
    return b;
}
__device__ __forceinline__ void xcd_barrier_complete(unsigned* bar, unsigned x, unsigned& nloc, unsigned& nx) {
    const unsigned G = gridDim.x * gridDim.y * gridDim.z;
    unsigned sum, cnt, mine, sp = 0u;
    for (;;) {
        sum = 0u; cnt = 0u; mine = 0u;
#pragma unroll
        for (unsigned j = 0; j < 16; ++j) { const unsigned c = xb_ld(&bar[XB_XCNT(j)]); sum += c; cnt += (c > 0u) ? 1u : 0u; mine = (j == x) ? c : mine; }
        if (sum == G) break;
        __builtin_amdgcn_s_sleep(1);
        if ((++sp & 255u) == 0u) { if (xb_ld(&bar[XB_TMO])) break; if (sp > XB_SPIN_CAP) { atomicAdd(&bar[XB_TMO], 1u); break; } }
    }
    nloc = mine > 0u ? mine : 1u; nx = cnt > 0u ? cnt : 1u;
}
__device__ __forceinline__ void xcd_barrier(const XcdBarrier& b) {
    asm volatile("s_waitcnt vmcnt(0)" ::: "memory");
    __syncthreads();
    if (threadIdx.x == 0) {
        unsigned* bar = b.bar;
        __builtin_amdgcn_s_waitcnt(0);
        unsigned nloc = b.st[0], nx = b.st[1];
        if (nloc == 0u) { xcd_barrier_complete(bar, b.x, nloc, nx); b.st[0] = nloc; b.st[1] = nx; }
        const unsigned old = xb_add(&bar[XB_XSUB(b.x)], 1u);
        const unsigned gen = old / nloc;
        if (old + 1u == (gen + 1u) * nloc) {
            __builtin_amdgcn_fence(__ATOMIC_RELEASE, "agent");
            asm volatile("s_waitcnt vmcnt(0)" ::: "memory");
            const unsigned og = xb_add(&bar[XB_TOP], 1u);
            const unsigned tg = og / nx;
            if (og + 1u == (tg + 1u) * nx) xb_add(&bar[XB_TOPGEN], 1u);
            else XB_SPIN(xb_ld(&bar[XB_TOPGEN]) == tg, bar);
            __builtin_amdgcn_fence(__ATOMIC_ACQUIRE, "agent");
            xb_add(&bar[XB_XGEN(b.x)], 1u);
            asm volatile("s_waitcnt vmcnt(0)" ::: "memory");
        } else {
            XB_SPIN(xb_ld(&bar[XB_XGEN(b.x)]) == gen, bar);
            __builtin_amdgcn_fence(__ATOMIC_ACQUIRE, "agent");
            asm volatile("s_waitcnt vmcnt(0)" ::: "memory");
        }
    }
    __syncthreads();
}

__global__ void __launch_bounds__(512, 2) fwd_megakernel(Args a) {
    extern __shared__ __attribute__((aligned(16))) unsigned char lds_raw[];
    LAS unsigned char* lds = (LAS unsigned char*)lds_raw;
    cg::grid_group grid = cg::this_grid();
    const int tid = threadIdx.x, wid = __builtin_amdgcn_readfirstlane(tid >> 6), lane = tid & 63;
    const int G = gridDim.x, bx = blockIdx.x;
    unsigned char* ws = a.ws;
    const float* MOD = (const float*)(ws + WS_MOD);
    const int gw = bx * 8 + wid, NGW = G * 8;

    if (tid < 4) ((LAS unsigned*)(lds + LDS_BARST))[tid] = 0u;
    __syncthreads();
    const XcdBarrier xbar = xcd_barrier_post((unsigned*)(ws + WS_BAR), (volatile LAS unsigned*)(lds + LDS_BARST));
#define GRID_BAR() xcd_barrier(xbar)
    if (a.dec_f[0] < -1e30f) grid.sync();
    p0_prologue(a, lds, tid, wid, lane, G);
    GRID_BAR();
    rows_phase<false>(a.x, a.ctx, MTOK, MTOK + MCTX, a.norm1_g, MOD, 0, DM, (void*)(ws + WS_H), gw, NGW, lane);
    GRID_BAR();
    {
        EpiIn E{(bf16_t*)(ws + WS_Q), (bf16_t*)(ws + WS_K), (bf16_t*)(ws + WS_V), (bf16_t*)(ws + WS_G), (bf16_t*)a.out, (bf16_t*)a.out + (size_t)MTOK * DM,
                (bf16_t*)(ws + WS_KC), (bf16_t*)(ws + WS_VC), (const f32x4*)(ws + WS_ROPE)};
        pg8::Gemm g{(const bf16_t*)(ws + WS_H), (const bf16_t*)(ws + WS_WIN), nullptr, nullptr, DM}; pg8::Order S; S.init(64, 48, 0, 128, G, bx);
        pg8::gemm_phase(lds, g, S, E);
        if (G == 256) { if (bx >= 128) convert_ffn(a, lds, (bx - 128) * 8 + wid, 128 * 8, wid, lane); }
        else convert_ffn(a, lds, gw, NGW, wid, lane);
    }
    GRID_BAR();
    for (int idx = bx; idx < 256; idx += G) { spatial_unit(lds, a, idx >> 5, (idx >> 1) & 15, idx & 1, tid, wid, lane); }
    GRID_BAR();
    for (int idx = bx; idx < 256; idx += G) { state_unit(lds, a, idx >> 5, (idx >> 2) & 7, (idx >> 1) & 1, idx & 1, wid, lane); __syncthreads(); }
    GRID_BAR();
    for (int i = 0; ; ++i) {
        int b, hh, qb;
        if (G == 256) { if (i >= 4) break; const int xcd = bx & 7, j = i * 32 + (bx >> 3); hh = xcd; b = j >> 4; qb = j & 15; }
        else { const int idx = i * G + bx; if (idx >= 1024) break; b = idx >> 7; hh = (idx >> 4) & 7; qb = idx & 15; }
        retention_unit(lds, a, b, hh, qb, wid, lane);
        __syncthreads();
    }
    GRID_BAR();
    {
        EpiIn E{(bf16_t*)(ws + WS_Q), (bf16_t*)(ws + WS_K), (bf16_t*)(ws + WS_V), (bf16_t*)(ws + WS_G), (bf16_t*)a.out, (bf16_t*)a.out + (size_t)MTOK * DM,
                (bf16_t*)(ws + WS_KC), (bf16_t*)(ws + WS_VC), (const f32x4*)(ws + WS_ROPE)};
        pg8::Gemm g{(const bf16_t*)(ws + WS_H), (const bf16_t*)(ws + WS_WIN), nullptr, nullptr, DM}; pg8::Order S; S.init(64, 16, 48, 0, G, bx);
        pg8::gemm_phase(lds, g, S, E);
    }
    GRID_BAR();
    {
        EpiDual E{(const bf16_t*)(ws + WS_K), (const bf16_t*)(ws + WS_V), (bf16_t*)(ws + WS_G)};
        pg8::Gemm g{(const bf16_t*)(ws + WS_Q), (const bf16_t*)(ws + WS_W3), (const bf16_t*)a.out, (const bf16_t*)(ws + WS_W3 + 8 * MiB), DM}; pg8::Order S; S.init(64, 8, 0, 0, G, bx, 1);
        pg8::gemm_phase(lds, g, S, E);
    }
    GRID_BAR();
    {
        EpiRes E{a.x, MOD + 2 * DM, a.out};
        pg8::Gemm g{(const bf16_t*)(ws + WS_G), (const bf16_t*)(ws + WS_W3 + 16 * MiB), nullptr, nullptr, DM}; pg8::Order S; S.init(64, 8, 0, 0, G, bx);
        pg8::gemm_phase(lds, g, S, E);
    }
    GRID_BAR();
    rows_phase<false>(a.out, a.out, MTOK, MTOK, a.norm2_g, MOD, 3 * DM, 4 * DM, (void*)(ws + WS_Q), gw, NGW, lane);
    GRID_BAR();
    {
        EpiSwiglu E{(bf16_t*)(ws + WS_HID)};
        pg8::Gemm g{(const bf16_t*)(ws + WS_Q), (const bf16_t*)(ws + WS_WF1), nullptr, nullptr, DM}; pg8::Order S; S.init(64, 44, 0, 0, G, bx);
        pg8::gemm_phase(lds, g, S, E);
    }
    GRID_BAR();
    {
        EpiRes E{a.out, MOD + 5 * DM, a.out};
        pg8::Gemm g{(const bf16_t*)(ws + WS_HID), (const bf16_t*)(ws + WS_WF2), nullptr, nullptr, FF}; pg8::Order S; S.init(64, 8, 0, 0, G, bx);
        pg8::gemm_phase(lds, g, S, E);
    }
    GRID_BAR();
    rows_phase<true>(a.out, a.out, MTOK, MTOK, a.final_g, MOD, 0, 0, (void*)a.out, gw, NGW, lane);
}

extern "C" void kernel_launch(void* const* d_in, const int* in_sizes, int n_in, void* d_out, int out_size, void* d_ws, size_t ws_size, hipStream_t stream) {
    static int grid_blocks = 0;
    if (grid_blocks == 0) {
        if (n_in != 21 || out_size != MTOK * DM || ws_size < WS_END) { fprintf(stderr, "kernel_launch: unexpected problem (n_in %d, out %d, ws %zu)\n", n_in, out_size, ws_size); grid_blocks = -1; return; }
        int dev = 0, cus = 0, per_cu = 0;
        hipGetDevice(&dev);
        hipDeviceGetAttribute(&cus, hipDeviceAttributeMultiprocessorCount, dev);
        if (hipFuncSetAttribute((const void*)fwd_megakernel, hipFuncAttributeMaxDynamicSharedMemorySize, LDS_BYTES) != hipSuccess) { fprintf(stderr, "kernel_launch: hipFuncSetAttribute failed\n"); grid_blocks = -1; return; }
        if (hipOccupancyMaxActiveBlocksPerMultiprocessor(&per_cu, (const void*)fwd_megakernel, 512, LDS_BYTES) != hipSuccess || per_cu < 1) { fprintf(stderr, "kernel_launch: occupancy query gave %d\n", per_cu); per_cu = 1; }
        (void)hipGetLastError();
        grid_blocks = cus * (per_cu > 1 ? 1 : per_cu);
        if (grid_blocks < 1) grid_blocks = 256;
    }
    if (grid_blocks < 0) return;
    if (hipMemsetAsync((char*)d_ws + WS_BAR, 0, XCD_BAR_WORDS * 4, stream) != hipSuccess) { fprintf(stderr, "kernel_launch: memset of the barrier words failed\n"); return; }
    Args a{};
    const float** pp = (const float**)&a;
    for (int i = 0; i < 21; ++i) pp[i] = (const float*)d_in[i];
    a.out = (float*)d_out; a.ws = (unsigned char*)d_ws;
    void* args[] = {&a};
    hipError_t e = hipLaunchCooperativeKernel((const void*)fwd_megakernel, dim3(grid_blocks), dim3(512), args, LDS_BYTES, stream);
    if (e != hipSuccess) fprintf(stderr, "cooperative launch failed: %s (grid %d)\n", hipGetErrorString(e), grid_blocks);
}
```

```cpp
#include <hip/hip_runtime.h>
#include <hip/hip_cooperative_groups.h>
#include <cstdio>
#include <cstdint>
namespace cg = cooperative_groups;

#define LAS __attribute__((address_space(3)))
typedef unsigned short bf16_t;
typedef short bf16x8 __attribute__((ext_vector_type(8)));
typedef short s16x4 __attribute__((ext_vector_type(4)));
typedef short v4i16_t __attribute__((ext_vector_type(4)));
typedef float f32x2 __attribute__((ext_vector_type(2)));
typedef float f32x4 __attribute__((ext_vector_type(4)));
typedef float f32x16 __attribute__((ext_vector_type(16)));
typedef unsigned u32x2 __attribute__((ext_vector_type(2)));
typedef unsigned u32x4 __attribute__((ext_vector_type(4)));
typedef __bf16 bf16x2_t __attribute__((ext_vector_type(2)));

constexpr int DM = 2048, NB = 8, SEQ = 2048, MTOK = NB * SEQ, LCTX = 256, MCTX = NB * LCTX, NH = 8, DIN = 16384, FF = 5632, NMOD = 12288;
constexpr float EPS = 1e-6f;
constexpr size_t MiB = 1u << 20;
constexpr size_t WS_MOD = 0, WS_ROPE = 512 * 1024, WS_SGW = 576 * 1024;
constexpr size_t WS_WF1 = 1 * MiB, WS_WF2 = 45 * MiB, WS_W3 = 67 * MiB, WS_Q = 91 * MiB, WS_WIN = 155 * MiB, WS_H = 219 * MiB, WS_K = 291 * MiB, WS_V = 355 * MiB,
                 WS_KC = 419 * MiB, WS_VC = 427 * MiB, WS_G = 435 * MiB, WS_END = 499 * MiB;
constexpr int RCH = 512, NRCH = SEQ / RCH;
constexpr size_t WS_T = WS_WIN, WS_HID = WS_WIN;
constexpr int LDS_BYTES = 153600;
constexpr int LDS_XCH = 131072, LDS_XS = 147456, LDS_STATS = 148480, LDS_BARST = 149504;
constexpr size_t WS_BAR = 896 * 1024;

__device__ __forceinline__ unsigned cvtpk(float lo, float hi) { f32x2 v = {lo, hi}; bf16x2_t b = __builtin_convertvector(v, bf16x2_t); return __builtin_bit_cast(unsigned, b); }
__device__ __forceinline__ float bflo(unsigned w) { return __uint_as_float(w << 16); }
__device__ __forceinline__ float bfhi(unsigned w) { return __uint_as_float(w & 0xffff0000u); }
__device__ __forceinline__ float bf2f(bf16_t b) { return __uint_as_float(((unsigned)b) << 16); }
__device__ __forceinline__ float fast_sigmoid(float x) { return __builtin_amdgcn_rcpf(1.0f + __builtin_amdgcn_exp2f(-1.4426950408889634f * x)); }
__device__ __forceinline__ float fast_silu(float x) { return x * fast_sigmoid(x); }
__device__ __forceinline__ float fast_gelu(float x) { const float z = 0.7978845608028654f * (x + 0.044715f * x * x * x); return x * fast_sigmoid(2.0f * z); }
__device__ __forceinline__ float wave_sum(float v) {
#pragma unroll
    for (int o = 1; o < 64; o <<= 1) v += __shfl_xor(v, o);
    return v;
}

namespace pg8 {
constexpr int BM = 256, BK = 64, HALF = 128, HTB = HALF * BK * 2, STAGE_BYTES = 8 * HTB, NXCD = 8, WGM = 8;
__host__ __device__ __forceinline__ int lds_byte(int r, int c) { const int st = (r >> 4) * 2 + (c >> 5), rr = r & 15, cc = c & 31, ob = rr * 64 + cc * 2; return st * 1024 + (ob ^ (((ob >> 9) & 1) << 5)); }
__host__ __device__ __forceinline__ void stage_rc(int b, int& R, int& C) { const int st = b / 1024, sb = b % 1024, swz = sb ^ (((sb >> 9) & 1) << 5); R = (st >> 1) * 16 + swz / 64; C = (st & 1) * 32 + (swz % 64) / 2; }
__host__ __device__ __forceinline__ int perm32(int rho) { const int n = rho >> 4, i = rho & 15; return 8 * (i >> 2) + 4 * n + (i & 3); }

struct Unit { int pm, pn, which; };
struct Gemm { const bf16_t* A; const bf16_t* Bt; const bf16_t* A2; const bf16_t* Bt2; int K; };

struct Order {
    int nM, nN, pn0, nwg, G, c, nextra, dual;
    __device__ void init(int nM_, int nN_, int pn0_, int nextra_, int G_, int c_, int dual_ = 0) { nM = nM_; nN = nN_; pn0 = pn0_; nwg = nM * nN; nextra = nextra_; G = G_; c = c_; dual = dual_; }
    __device__ bool next(int i, Unit& u) const {
        u.which = dual ? (i & 1) : 0; if (dual) i >>= 1;
        long L = (long)i * G + c;
        if (L < nwg) {
            int wgid = (int)L; { const int q = nwg / NXCD, r = nwg % NXCD, xcd = wgid % NXCD, off = wgid / NXCD; wgid = (xcd < r ? xcd * (q + 1) : r * (q + 1) + (xcd - r) * q) + off; }
            const int nig = WGM * nN, gid = wgid / nig, fm = gid * WGM, gsz = (nM - fm) < WGM ? (nM - fm) : WGM;
            u.pm = fm + ((wgid % nig) % gsz); u.pn = pn0 + (wgid % nig) / gsz; return true;
        }
        L -= nwg;
        if (L < nextra) { u.pm = 64 + (int)(L & 7); u.pn = 8 + (int)(L >> 3); return true; }
        return false;
    }
};

template <class Epi>
__device__ __forceinline__ void gemm_phase(LAS unsigned char* lds, const Gemm g, const Order& S, const Epi& E) {
    int tid_ = threadIdx.x; asm volatile("" : "+v"(tid_));
    const int tid = tid_, wid = __builtin_amdgcn_readfirstlane(tid >> 6), lane = tid & 63, wr = wid >> 2, wc = wid & 3, fr = lane & 15, fq = lane >> 4;
    const int K = g.K, nt = K / BK;
    unsigned voffA[2], voffB[2];
#pragma unroll
    for (int i = 0; i < 2; ++i) { int R, C; stage_rc(tid * 16 + i * 8192, R, C); const int Rb = (R & ~31) + perm32(R & 31);
        voffA[i] = (unsigned)(R * K + C) * 2u; voffB[i] = (unsigned)(Rb * K + C) * 2u; }
    const size_t kstep = (size_t)(BK * 2);
    const size_t hstep = (size_t)HALF * K * 2;
    const size_t tstep = 2 * hstep;
    const unsigned ldsw = (unsigned)wid * 1024u;
    const int aoff = lds_byte(wr * 64 + fr, fq * 8), boff = lds_byte(wc * 32 + fr, fq * 8);
#define PG8_SA(b, h) (((b) * 2 + (h)) * HTB)
#define PG8_SB(b, h) ((4 + (b) * 2 + (h)) * HTB)
#define PG8_STAGE(bufoff, gbase, voff) do { _Pragma("unroll") for (int _i = 0; _i < 2; ++_i) \
        __builtin_amdgcn_global_load_lds((const unsigned*)((const char*)(gbase) + (voff)[_i]), (LAS unsigned*)(lds + (bufoff) + ldsw + _i * 8192), 16, 0, 0); } while (0)
#define PG8_LDA(dst, b, h) do { _Pragma("unroll") for (int m = 0; m < 4; ++m) _Pragma("unroll") for (int k = 0; k < 2; ++k) dst[m][k] = *(const LAS bf16x8*)(lds + PG8_SA(b, h) + aoff + m * 2048 + k * 1024); } while (0)
#define PG8_LDB(dst, b, h) do { _Pragma("unroll") for (int n = 0; n < 2; ++n) _Pragma("unroll") for (int k = 0; k < 2; ++k) dst[n][k] = *(const LAS bf16x8*)(lds + PG8_SB(b, h) + boff + n * 2048 + k * 1024); } while (0)
#define PG8_MMA(ai, bj, At, Bt) do { __builtin_amdgcn_s_setprio(1); _Pragma("unroll") for (int m = 0; m < 4; ++m) _Pragma("unroll") for (int n = 0; n < 2; ++n) _Pragma("unroll") for (int k = 0; k < 2; ++k) \
        acc[ai][bj][m][n] = __builtin_amdgcn_mfma_f32_16x16x32_bf16(Bt[n][k], At[m][k], acc[ai][bj][m][n], 0, 0, 0); __builtin_amdgcn_s_setprio(0); } while (0)
#define PG8_WAIT_V(n) asm volatile("s_waitcnt vmcnt(" #n ")" ::: "memory")
#define PG8_WAIT_L(n) asm volatile("s_waitcnt lgkmcnt(" #n ")" ::: "memory")
#define PG8_BAR __builtin_amdgcn_s_barrier()
#define PG8_SCHED __builtin_amdgcn_sched_barrier(0)
    Unit cur, nxt; int ui = 0;
    if (!S.next(0, cur)) return;
    f32x4 acc[2][2][4][2];
#pragma unroll
    for (int a = 0; a < 2; ++a)
#pragma unroll
        for (int b = 0; b < 2; ++b)
#pragma unroll
            for (int m = 0; m < 4; ++m)
#pragma unroll
                for (int n = 0; n < 2; ++n) acc[a][b][m][n] = (f32x4){0.f, 0.f, 0.f, 0.f};
    bf16x8 At[4][2], B0[2][2], B1[2][2];
    const char* cA = (const char*)(cur.which ? g.A2 : g.A) + (size_t)cur.pm * tstep; const char* cB = (const char*)(cur.which ? g.Bt2 : g.Bt) + (size_t)cur.pn * tstep;
    PG8_STAGE(PG8_SB(0, 0), cB, voffB); PG8_STAGE(PG8_SB(0, 1), cB + hstep, voffB); PG8_STAGE(PG8_SA(0, 0), cA, voffA); PG8_STAGE(PG8_SA(0, 1), cA + hstep, voffA);
    if (wr == 1) PG8_BAR;
    PG8_WAIT_V(2); PG8_BAR;
    PG8_STAGE(PG8_SB(1, 0), cB + kstep, voffB); PG8_STAGE(PG8_SA(1, 0), cA + kstep, voffA); PG8_STAGE(PG8_SB(1, 1), cB + hstep + kstep, voffB);
    PG8_WAIT_V(6); PG8_BAR;
    for (;;) {
        const bool has_next = S.next(ui + 1, nxt);
        const char* nA = has_next ? (const char*)(nxt.which ? g.A2 : g.A) + (size_t)nxt.pm * tstep : cA; const char* nB = has_next ? (const char*)(nxt.which ? g.Bt2 : g.Bt) + (size_t)nxt.pn * tstep : cB;
        for (int t = 0; t < nt; t += 2) {
            const bool last = (t == nt - 2);
            const char* a1 = cA + (size_t)(t + 1) * kstep;
            const char* a2 = last ? nA : cA + (size_t)(t + 2) * kstep; const char* b2 = last ? nB : cB + (size_t)(t + 2) * kstep;
            const char* a3 = a2 + kstep; const char* b3 = b2 + kstep;
            PG8_LDB(B0, 0, 0); PG8_LDB(B1, 0, 1); PG8_SCHED; PG8_LDA(At, 0, 0); PG8_STAGE(PG8_SA(1, 1), a1 + hstep, voffA);
            PG8_WAIT_V(8); PG8_WAIT_L(0); PG8_BAR; PG8_MMA(0, 0, At, B0); PG8_MMA(0, 1, At, B1); PG8_BAR; PG8_SCHED;
            PG8_LDA(At, 0, 1); PG8_STAGE(PG8_SB(0, 0), b2, voffB); PG8_STAGE(PG8_SB(0, 1), b2 + hstep, voffB); PG8_STAGE(PG8_SA(0, 0), a2, voffA);
            PG8_WAIT_V(8); PG8_WAIT_L(0); PG8_BAR; PG8_MMA(1, 0, At, B0); PG8_MMA(1, 1, At, B1); PG8_BAR; PG8_SCHED;
            PG8_LDB(B0, 1, 0); PG8_LDB(B1, 1, 1); PG8_SCHED; PG8_LDA(At, 1, 0); PG8_STAGE(PG8_SA(0, 1), a2 + hstep, voffA);
            PG8_WAIT_V(8); PG8_WAIT_L(0); PG8_BAR; PG8_MMA(0, 0, At, B0); PG8_MMA(0, 1, At, B1); PG8_BAR; PG8_SCHED;
            PG8_LDA(At, 1, 1); PG8_STAGE(PG8_SB(1, 0), b3, voffB); PG8_STAGE(PG8_SB(1, 1), b3 + hstep, voffB); PG8_STAGE(PG8_SA(1, 0), a3, voffA);
            PG8_WAIT_V(8); PG8_WAIT_L(0); PG8_BAR; PG8_MMA(1, 0, At, B0); PG8_MMA(1, 1, At, B1); PG8_BAR; PG8_SCHED;
        }
        if (wr == 0) PG8_BAR;
        const bool keep = E(acc, cur, wr, wc, fr, fq);
        if (!has_next) break;
        if (!keep)
#pragma unroll
        for (int a = 0; a < 2; ++a)
#pragma unroll
            for (int b = 0; b < 2; ++b)
#pragma unroll
                for (int m = 0; m < 4; ++m)
#pragma unroll
                    for (int n = 0; n < 2; ++n) acc[a][b][m][n] = (f32x4){0.f, 0.f, 0.f, 0.f};
        cur = nxt; cA = nA; cB = nB; ++ui;
        if (wr == 1) PG8_BAR;
    }
    PG8_WAIT_V(0);
    PG8_BAR;
#undef PG8_SA
#undef PG8_SB
#undef PG8_STAGE
#undef PG8_LDA
#undef PG8_LDB
#undef PG8_MMA
#undef PG8_WAIT_V
#undef PG8_WAIT_L
#undef PG8_BAR
#undef PG8_SCHED
}
}
using pg8::Unit;

#define EPI_ARGS f32x4 (&acc)[2][2][4][2], const Unit& u, int wr, int wc, int fr, int fq
#define EPI_FOR_ROWS _Pragma("unroll") for (int ai = 0; ai < 2; ++ai) _Pragma("unroll") for (int m = 0; m < 4; ++m)
#define EPI_FOR_BJ _Pragma("unroll") for (int bj = 0; bj < 2; ++bj)

struct EpiIn {
    bf16_t *Q, *K, *V, *G, *U, *VS, *KC, *VC; const f32x4* rope;
    __device__ __forceinline__ bool operator()(EPI_ARGS) const {
        const int region = u.pn >> 3, hcol = (u.pn & 7) * 256;
        const bool isctx = u.pm >= 64;
        bf16_t* base; int mode; float sc = 1.0f;
        switch (region) {
            case 0: base = Q; mode = 0; break;
            case 1: base = isctx ? KC : K; mode = isctx ? 1 : 0; sc = 0.0625f; break;
            case 2: base = isctx ? VC : V; mode = 1; break;
            case 3: base = G; mode = 2; break;
            case 4: base = U; mode = 3; break;
            case 5: base = VS; mode = 3; break;
            case 6: base = K; mode = 4; break;
            default: base = V; mode = 4; break;
        }
        const int prow = isctx ? (u.pm - 64) * 256 : u.pm * 256;
        const int col0 = hcol + wc * 32 + fq * 8;
        if (mode == 0) {
            const int lbase = (u.pm & 7) * 256, tcol = wc * 8 + fq * 2;
            f32x4 tr[2][2], tc[4][2];
#pragma unroll
            for (int ai = 0; ai < 2; ++ai) { const int pos = (lbase + ai * 128 + wr * 64) >> 6; tr[ai][0] = rope[pos * 32 + tcol]; tr[ai][1] = rope[pos * 32 + tcol + 1]; }
#pragma unroll
            for (int m = 0; m < 4; ++m) { const int pos = m * 16 + fr; tc[m][0] = rope[pos * 32 + tcol]; tc[m][1] = rope[pos * 32 + tcol + 1]; }
            EPI_FOR_ROWS {
                const int rl = ai * 128 + wr * 64 + m * 16 + fr;
                bf16_t* rowp = base + (size_t)(prow + rl) * DM + col0;
                EPI_FOR_BJ {
                    const f32x4 t0 = bj == 0 ? tr[ai][0] : tc[m][0], t1 = bj == 0 ? tr[ai][1] : tc[m][1];
                    const f32x4 v0 = acc[ai][bj][m][0] * sc, v1 = acc[ai][bj][m][1] * sc;
                    u32x4 w;
                    w.x = cvtpk(v0[0] * t0[0] - v0[1] * t0[1], v0[1] * t0[0] + v0[0] * t0[1]);
                    w.y = cvtpk(v0[2] * t0[2] - v0[3] * t0[3], v0[3] * t0[2] + v0[2] * t0[3]);
                    w.z = cvtpk(v1[0] * t1[0] - v1[1] * t1[1], v1[1] * t1[0] + v1[0] * t1[1]);
                    w.w = cvtpk(v1[2] * t1[2] - v1[3] * t1[3], v1[3] * t1[2] + v1[2] * t1[3]);
                    *(u32x4*)(rowp + bj * 128) = w;
                }
            }
        } else {
            EPI_FOR_ROWS {
                const int rl = ai * 128 + wr * 64 + m * 16 + fr;
                bf16_t* rowp = base + (size_t)(prow + rl) * DM + col0;
                EPI_FOR_BJ {
                    f32x4 v0 = acc[ai][bj][m][0], v1 = acc[ai][bj][m][1];
                    if (mode == 1) { v0 = v0 * sc; v1 = v1 * sc; }
                    else if (mode == 2) {
#pragma unroll
                        for (int e = 0; e < 4; ++e) { v0[e] = fast_silu(v0[e]); v1[e] = fast_silu(v1[e]); } }
                    else if (mode == 3) {
#pragma unroll
                        for (int e = 0; e < 4; ++e) { v0[e] = fast_gelu(v0[e]); v1[e] = fast_gelu(v1[e]); } }
                    else {
#pragma unroll
                        for (int e = 0; e < 4; ++e) { v0[e] = fast_sigmoid(v0[e]); v1[e] = fast_sigmoid(v1[e]); } }
                    u32x4 w; w.x = cvtpk(v0[0], v0[1]); w.y = cvtpk(v0[2], v0[3]); w.z = cvtpk(v1[0], v1[1]); w.w = cvtpk(v1[2], v1[3]);
                    *(u32x4*)(rowp + bj * 128) = w;
                }
            }
        }
        return false;
    }
};
struct EpiDual {
    const bf16_t* GR; const bf16_t* GS; bf16_t* MG;
    __device__ __forceinline__ bool operator()(EPI_ARGS) const {
        const int col0 = u.pn * 256 + wc * 32 + fq * 8;
        const size_t off0 = (size_t)(u.pm * 256 + wr * 64 + fr) * DM + col0;
        if (u.which == 0) {
#pragma unroll
            for (int ai = 0; ai < 2; ++ai) {
                u32x4 rw[4][2], sw[4][2];
#pragma unroll
                for (int m = 0; m < 4; ++m)
#pragma unroll
                    for (int bj = 0; bj < 2; ++bj) { const size_t off = off0 + (size_t)(ai * 128 + m * 16) * DM + bj * 128; rw[m][bj] = *(const u32x4*)(GR + off); sw[m][bj] = *(const u32x4*)(GS + off); }
                asm volatile("" ::: "memory");
#pragma unroll
                for (int m = 0; m < 4; ++m)
#pragma unroll
                    for (int bj = 0; bj < 2; ++bj)
#pragma unroll
                        for (int e = 0; e < 4; ++e) {
                            const float r0 = bflo(rw[m][bj][e]) * __builtin_amdgcn_rcpf(fmaxf(bflo(sw[m][bj][e]), 1e-30f)), r1 = bfhi(rw[m][bj][e]) * __builtin_amdgcn_rcpf(fmaxf(bfhi(sw[m][bj][e]), 1e-30f));
                            acc[ai][bj][m][e >> 1][(e & 1) * 2] *= r0; acc[ai][bj][m][e >> 1][(e & 1) * 2 + 1] *= r1; }
            }
            return true;
        }
#pragma unroll
        for (int ai = 0; ai < 2; ++ai) {
            u32x4 gw[4][2];
#pragma unroll
            for (int m = 0; m < 4; ++m)
#pragma unroll
                for (int bj = 0; bj < 2; ++bj) gw[m][bj] = *(const u32x4*)(GS + off0 + (size_t)(ai * 128 + m * 16) * DM + bj * 128);
            asm volatile("" ::: "memory");
#pragma unroll
            for (int m = 0; m < 4; ++m)
#pragma unroll
                for (int bj = 0; bj < 2; ++bj) {
                    const f32x4 v0 = acc[ai][bj][m][0], v1 = acc[ai][bj][m][1]; const u32x4 g = gw[m][bj];
                    u32x4 w; w.x = cvtpk(v0[0] * bflo(g.x), v0[1] * bfhi(g.x)); w.y = cvtpk(v0[2] * bflo(g.y), v0[3] * bfhi(g.y));
                    w.z = cvtpk(v1[0] * bflo(g.z), v1[1] * bfhi(g.z)); w.w = cvtpk(v1[2] * bflo(g.w), v1[3] * bfhi(g.w));
                    *(u32x4*)(MG + off0 + (size_t)(ai * 128 + m * 16) * DM + bj * 128) = w;
                }
            asm volatile("" ::: "memory");
        }
        return false;
    }
};
struct EpiRes {
    const float* res; const float* gate; float* out;
    __device__ __forceinline__ bool operator()(EPI_ARGS) const {
        const int col0 = u.pn * 256 + wc * 32 + fq * 8;
        const float* gp = gate + (size_t)(u.pm >> 3) * NMOD + col0;
        const size_t off0 = (size_t)(u.pm * 256 + wr * 64 + fr) * DM + col0;
        f32x4 g0[2], g1[2];
        EPI_FOR_BJ { g0[bj] = *(const f32x4*)(gp + bj * 128); g1[bj] = *(const f32x4*)(gp + bj * 128 + 4); }
#pragma unroll
        for (int ai = 0; ai < 2; ++ai) {
            f32x4 r0[4][2], r1[4][2];
#pragma unroll
            for (int m = 0; m < 4; ++m)
#pragma unroll
                for (int bj = 0; bj < 2; ++bj) { const float* p = res + off0 + (size_t)(ai * 128 + m * 16) * DM + bj * 128; r0[m][bj] = *(const f32x4*)p; r1[m][bj] = *(const f32x4*)(p + 4); }
            asm volatile("" ::: "memory");
#pragma unroll
            for (int m = 0; m < 4; ++m)
#pragma unroll
                for (int bj = 0; bj < 2; ++bj) { float* p = out + off0 + (size_t)(ai * 128 + m * 16) * DM + bj * 128;
                    *(f32x4*)p = r0[m][bj] + g0[bj] * acc[ai][bj][m][0]; *(f32x4*)(p + 4) = r1[m][bj] + g1[bj] * acc[ai][bj][m][1]; }
            asm volatile("" ::: "memory");
        }
        return false;
    }
};
struct EpiSwiglu {
    bf16_t* HID;
    __device__ __forceinline__ bool operator()(EPI_ARGS) const {
        const int col0 = u.pn * 128 + wc * 16 + fq * 4;
        EPI_FOR_ROWS {
            bf16_t* rowp = HID + (size_t)(u.pm * 256 + ai * 128 + wr * 64 + m * 16 + fr) * FF + col0;
            EPI_FOR_BJ {
                const f32x4 a = acc[ai][bj][m][0], b = acc[ai][bj][m][1];
                u32x2 w; w.x = cvtpk(fast_silu(a[0]) * b[0], fast_silu(a[1]) * b[1]); w.y = cvtpk(fast_silu(a[2]) * b[2], fast_silu(a[3]) * b[3]);
                *(u32x2*)(rowp + bj * 64) = w;
            }
        }
        return false;
    }
};

struct Args {
    const float *x, *c, *ctx, *c_ctx, *w_mod, *b_mod, *norm1_g, *w_in, *dec_f, *dec_b, *sg_ln_g, *sg_ln_b, *sg_w, *sg_b, *w_ret_o, *w_sg_o, *w_out, *norm2_g, *w_ffn_in, *w_ffn_out, *final_g;
    float* out; unsigned char* ws;
};

__device__ __forceinline__ int src_col(int kind, int n) {
    if (kind == 1) { if (n >= 4096) return n; const int cp = n & 255, half = cp >> 7, within = cp & 127; return (n & ~255) + half * 128 + (within & 1) * 64 + (within >> 1); }
    if (kind == 2) { const int grp = n >> 3, w = n & 7; return w < 4 ? grp * 4 + w : FF + grp * 4 + (w - 4); }
    return n;
}
__device__ __forceinline__ void transpose_item(const float* W, int K, int N, bf16_t* WT, int kind, LAS float* scr, int item, int lane) {
    const int nblk = N >> 6, kb = item / nblk, nb = item - kb * nblk, k0 = kb * 64, n0 = nb * 64;
    const float* src = W + (size_t)k0 * N + src_col(kind, n0 + lane);
#pragma unroll 8
    for (int i = 0; i < 64; ++i) scr[i * 65 + lane] = src[(size_t)i * N];
    asm volatile("s_waitcnt lgkmcnt(0)" ::: "memory");
    const int c = lane & 7;
#pragma unroll
    for (int j = 0; j < 8; ++j) { const int n = (lane >> 3) + 8 * j; const LAS float* s = scr + (8 * c) * 65 + n;
        u32x4 o; o.x = cvtpk(s[0 * 65], s[1 * 65]); o.y = cvtpk(s[2 * 65], s[3 * 65]); o.z = cvtpk(s[4 * 65], s[5 * 65]); o.w = cvtpk(s[6 * 65], s[7 * 65]);
        *(u32x4*)(WT + (size_t)(n0 + n) * K + k0 + 8 * c) = o; }
    asm volatile("s_waitcnt lgkmcnt(0)" ::: "memory");
}

__device__ __forceinline__ void p0_prologue(const Args& a, LAS unsigned char* lds, int tid, int wid, int lane, int G) {
    unsigned char* ws = a.ws;
    if ((int)blockIdx.x < 192) {
        LAS float* sl = (LAS float*)lds;
        LAS float* part = (LAS float*)(lds + 73728);
        for (int i = tid; i < 9 * DM; i += 512) { const float v = i < 8 * DM ? a.c[i] : a.c_ctx[i - 8 * DM]; sl[i] = fast_silu(v); }
        __syncthreads();
        const int n = blockIdx.x * 64 + lane;
        float accv[9];
#pragma unroll
        for (int r = 0; r < 9; ++r) accv[r] = 0.f;
        const float* wp = a.w_mod + (size_t)(wid * 256) * NMOD + n;
#pragma unroll 16
        for (int k = 0; k < 256; ++k) { const float wv = wp[(size_t)k * NMOD];
#pragma unroll
            for (int r = 0; r < 9; ++r) accv[r] += sl[r * DM + wid * 256 + k] * wv; }
#pragma unroll
        for (int r = 0; r < 9; ++r) part[(wid * 9 + r) * 64 + lane] = accv[r];
        __syncthreads();
        for (int i = tid; i < 9 * 64; i += 512) { const int r = i >> 6, cc = i & 63; float s = 0.f;
#pragma unroll
            for (int w = 0; w < 8; ++w) s += part[(w * 9 + r) * 64 + cc];
            ((float*)(ws + WS_MOD))[(size_t)r * NMOD + blockIdx.x * 64 + cc] = s + a.b_mod[blockIdx.x * 64 + cc]; }
        __syncthreads();
    } else if ((int)blockIdx.x == G - 1) {
        f32x2* tab = (f32x2*)(ws + WS_ROPE);
        for (int i = tid; i < 64 * 64; i += 512) { const int pos = i >> 6, f = i & 63; const float freq = exp2f(-(float)f * (13.287712379549449f / 64.0f)); const float ang = (float)pos * freq;
            tab[i] = (f32x2){cosf(ang), sinf(ang)}; }
    } else if ((int)blockIdx.x == G - 2) {
        bf16_t* sw = (bf16_t*)(ws + WS_SGW);
        for (int i = tid; i < 8 * 128 * 128 / 2; i += 512) ((unsigned*)sw)[i] = cvtpk(a.sg_w[2 * i], a.sg_w[2 * i + 1]);
    }
    LAS float* scr = (LAS float*)(lds + wid * 16640);
    const int gw = blockIdx.x * 8 + wid, NGW = G * 8;
    constexpr int I_IN = 32 * 256, I_SQ = 32 * 32, NITEMS = I_IN + 3 * I_SQ;
    const int nfree = G > 192 ? G - 192 : 0, E = nfree * 8 * 4 < NITEMS ? nfree * 8 * 4 : NITEMS;
    const bool isfree = (int)blockIdx.x >= 192;
    for (int it = isfree ? ((int)blockIdx.x - 192) * 8 + wid : E + gw; it < NITEMS; ) {
        int r = it;
        it = (it < E) ? ((it + nfree * 8 < E) ? it + nfree * 8 : E + gw) : it + NGW;
        if (r < I_IN) { transpose_item(a.w_in, DM, DIN, (bf16_t*)(ws + WS_WIN), 1, scr, r, lane); continue; } r -= I_IN;
        if (r < I_SQ) { transpose_item(a.w_ret_o, DM, DM, (bf16_t*)(ws + WS_W3), 0, scr, r, lane); continue; } r -= I_SQ;
        if (r < I_SQ) { transpose_item(a.w_sg_o, DM, DM, (bf16_t*)(ws + WS_W3 + 8 * MiB), 0, scr, r, lane); continue; } r -= I_SQ;
        transpose_item(a.w_out, DM, DM, (bf16_t*)(ws + WS_W3 + 16 * MiB), 0, scr, r, lane);
    }
}
__device__ __forceinline__ void convert_ffn(const Args& a, LAS unsigned char* lds, int cw, int ncw, int wid, int lane) {
    LAS float* scr = (LAS float*)(lds + wid * 16640);
    constexpr int I_F1 = 32 * 176, I_F2 = 88 * 32;
    for (int it = cw; it < I_F1 + I_F2; it += ncw) {
        if (it < I_F1) transpose_item(a.w_ffn_in, DM, 2 * FF, (bf16_t*)(a.ws + WS_WF1), 2, scr, it, lane);
        else transpose_item(a.w_ffn_out, FF, DM, (bf16_t*)(a.ws + WS_WF2), 0, scr, it - I_F1, lane);
    }
}

template <bool FINAL>
__device__ __forceinline__ void rows_phase(const float* srcL, const float* srcC, int nL, int nTot, const float* g, const float* mod, int sh_off, int sc_off, void* dst, int gw, int NGW, int lane) {
    asm volatile("" : "+v"(lane));
    const int per = (nTot + NGW - 1) / NGW; const int r0 = gw * per; int r1 = r0 + per; if (r1 > nTot) r1 = nTot;
    if (r0 >= r1) return;
    f32x4 v[8], A[8], B[8]; int cur = -1;
    { const float* p = (r0 < nL ? srcL + (size_t)r0 * DM : srcC + (size_t)(r0 - nL) * DM) + lane * 4;
#pragma unroll
      for (int j = 0; j < 8; ++j) v[j] = *(const f32x4*)(p + j * 256); }
#pragma unroll 1
    for (int row = r0; row < r1; ++row) {
        f32x4 vn[8];
        const bool more = row + 1 < r1;
        if (more) { const int rn = row + 1; const float* p = (rn < nL ? srcL + (size_t)rn * DM : srcC + (size_t)(rn - nL) * DM) + lane * 4;
#pragma unroll
            for (int j = 0; j < 8; ++j) vn[j] = *(const f32x4*)(p + j * 256); }
        const int mr = FINAL ? 0 : (row < nL ? (row >> 11) : 8);
        if (mr != cur) { cur = mr;
#pragma unroll
            for (int j = 0; j < 8; ++j) { const int o = j * 256 + lane * 4; const f32x4 gg = *(const f32x4*)(g + o);
                if (FINAL) { A[j] = gg; B[j] = (f32x4){0.f, 0.f, 0.f, 0.f}; }
                else { const float* mp = mod + (size_t)mr * NMOD + o; A[j] = gg * (*(const f32x4*)(mp + sc_off) + 1.0f); B[j] = *(const f32x4*)(mp + sh_off); } } }
        float ss = 0.f;
#pragma unroll
        for (int j = 0; j < 8; ++j) ss += (v[j][0] * v[j][0] + v[j][1] * v[j][1]) + (v[j][2] * v[j][2] + v[j][3] * v[j][3]);
        const float rstd = 1.0f / sqrtf(wave_sum(ss) * (1.0f / DM) + EPS);
#pragma unroll
        for (int j = 0; j < 8; ++j) { const int o = j * 256 + lane * 4;
            if (FINAL) *(f32x4*)((float*)dst + (size_t)row * DM + o) = v[j] * rstd * A[j];
            else { const f32x4 y = v[j] * rstd * A[j] + B[j]; u32x2 w; w.x = cvtpk(y[0], y[1]); w.y = cvtpk(y[2], y[3]); *(u32x2*)((bf16_t*)dst + (size_t)row * DM + o) = w; } }
        if (more) {
#pragma unroll
            for (int j = 0; j < 8; ++j) v[j] = vn[j]; }
    }
}

__device__ __forceinline__ s16x4 vtr(const LAS unsigned char* p) { return __builtin_bit_cast(s16x4, __builtin_amdgcn_ds_read_tr16_b64_v4i16((LAS v4i16_t*)p)); }
#define MFMA32(a, b, c) __builtin_amdgcn_mfma_f32_32x32x16_bf16((a), (b), (c), 0, 0, 0)

__device__ __forceinline__ void glds16(const void* gsrc, unsigned lds_dst) { unsigned keep;
    asm volatile("s_mov_b32 %0, m0\n\ts_mov_b32 m0, %2\n\ts_nop 0\n\tglobal_load_lds_dwordx4 %1, off\n\ts_mov_b32 m0, %0" : "=&s"(keep) : "v"(gsrc), "s"(lds_dst) : "memory"); }
template <bool ISV>
__device__ __forceinline__ void ret_issue(LAS unsigned char* dst, const bf16_t* T, int wid, int lane) {
    const int rsub = lane >> 5, pc = lane & 31;
    const unsigned d0 = (unsigned)(__UINTPTR_TYPE__)dst;
#pragma unroll
    for (int cc = 0; cc < 4; ++cc) {
        const int c = wid * 4 + cc, row = 2 * c + rsub;
        const int lc = ISV ? (pc ^ ((row & 3) << 2)) : (pc ^ (row & 15));
        glds16(T + (size_t)row * DM + lc * 8, (unsigned)__builtin_amdgcn_readfirstlane(d0 + c * 1024));
    }
}
struct RetC { const bf16_t *Kl0, *Vl0; float lf2, lb2, gi, gi8, gb, gb8; int iabs, qr0, r, h, hf, tq, vlane, myx, pbx, kend; };
template <bool PV, bool CTX>
__device__ __forceinline__ void ret_iter(LAS unsigned char* lds, const RetC& c, int kt, f32x16 (&O)[4], const bf16x8 (&qf)[16], int wid, int lane) {
    LAS unsigned char* xch = lds + LDS_XCH;
    asm volatile("s_waitcnt vmcnt(0) lgkmcnt(0)" ::: "memory");
    __builtin_amdgcn_s_barrier();
    asm volatile("" ::: "memory");
    if (kt + 1 < c.kend) { const int k1 = kt + 1; ret_issue<false>(lds + (k1 & 1) * 65536, c.Kl0 + (size_t)(k1 * 64) * DM, wid, lane); }
    if (kt < c.kend) ret_issue<true>(lds + 32768 + (kt & 1) * 65536, c.Vl0 + (size_t)(kt * 64) * DM, wid, lane);
    const LAS unsigned char* Kl = lds + (kt & 1) * 65536;
    int krow = 32 * c.hf + c.r; asm volatile("" : "+v"(krow));
    const LAS unsigned char* kb = Kl + krow * 512; const int cx = ((krow & 15) ^ c.h) << 4;
    f32x16 st;
#pragma unroll
    for (int i = 0; i < 16; ++i) st[i] = 0.f;
    bf16x8 kf[2][4];
#define RET_PIN asm volatile("" ::: "memory")
#define RET_SB __builtin_amdgcn_sched_barrier(0)
#define RET_KREAD(g) do { _Pragma("unroll") for (int j = 0; j < 4; ++j) kf[(g) & 1][j] = *(const LAS bf16x8*)(kb + ((32 * (4 * (g) + j)) ^ cx)); RET_PIN; } while (0)
#define RET_KMMA(g) do { _Pragma("unroll") for (int j = 0; j < 4; ++j) st = MFMA32(kf[(g) & 1][j], qf[4 * (g) + j], st); } while (0)
    RET_KREAD(0); RET_SB;
    RET_KREAD(1); RET_KMMA(0); RET_SB;
    RET_KREAD(2); RET_KMMA(1); RET_SB;
    RET_KREAD(3); RET_KMMA(2); RET_SB;
    if (PV) {
        const LAS unsigned char* Vl = lds + 32768 + ((kt + 1) & 1) * 65536;
        int vb = c.vlane; asm volatile("" : "+v"(vb));
        const LAS unsigned char* vbase = Vl + vb;
        const LAS unsigned char* pbase = xch + c.pbx;
        const int vo0 = ((0 ^ c.tq) & 3) << 6, vo1 = ((1 ^ c.tq) & 3) << 6, vo2 = ((2 ^ c.tq) & 3) << 6, vo3 = ((3 ^ c.tq) & 3) << 6;
        s16x4 vlo[2][4], vhi[2][4]; bf16x8 pf[2];
#define RET_VREAD(g) do { const LAS unsigned char* _p = vbase + ((g) * 16) * 512; pf[(g) & 1] = *(const LAS bf16x8*)(pbase + (g) * 1024); \
            vlo[(g) & 1][0] = vtr(_p + vo0); vhi[(g) & 1][0] = vtr(_p + vo0 + 4096); vlo[(g) & 1][1] = vtr(_p + vo1); vhi[(g) & 1][1] = vtr(_p + vo1 + 4096); \
            vlo[(g) & 1][2] = vtr(_p + vo2); vhi[(g) & 1][2] = vtr(_p + vo2 + 4096); vlo[(g) & 1][3] = vtr(_p + vo3); vhi[(g) & 1][3] = vtr(_p + vo3 + 4096); RET_PIN; } while (0)
#define RET_VMMA(g) do { _Pragma("unroll") for (int d = 0; d < 4; ++d) O[d] = MFMA32(pf[(g) & 1], __builtin_shufflevector(vlo[(g) & 1][d], vhi[(g) & 1][d], 0, 1, 2, 3, 4, 5, 6, 7), O[d]); } while (0)
        RET_VREAD(0); RET_KMMA(3); RET_SB;
        RET_VREAD(1); RET_VMMA(0); RET_SB;
        RET_VREAD(2); RET_VMMA(1); RET_SB;
        RET_VREAD(3); RET_VMMA(2); RET_SB;
        RET_VMMA(3); RET_SB;
#undef RET_VREAD
#undef RET_VMMA
    } else {
        RET_KMMA(3); RET_SB;
    }
#undef RET_KREAD
#undef RET_KMMA
#undef RET_SB
#undef RET_PIN
    {
        const int k0 = kt * 64 + 32 * c.hf;
        if (!CTX) {
            const int d0 = c.iabs - (k0 + 4 * c.h);
            if (k0 != c.qr0) {
                const bool fwd = c.qr0 > k0;
                const float m = fwd ? c.gi : c.gb, m8 = fwd ? c.gi8 : c.gb8;
                float w[4]; w[0] = __builtin_amdgcn_exp2f((float)d0 * (fwd ? c.lf2 : -c.lb2)); w[1] = w[0] * m; w[2] = w[1] * m; w[3] = w[2] * m;
#pragma unroll
                for (int q4 = 0; q4 < 4; ++q4) {
#pragma unroll
                    for (int e = 0; e < 4; ++e) { st[4 * q4 + e] *= w[e]; w[e] *= m8; } }
            } else {
#pragma unroll
                for (int i = 0; i < 16; ++i) { const int dist = d0 - ((i & 3) + 8 * (i >> 2)); const float fd = (float)dist; st[i] *= __builtin_amdgcn_exp2f(fd * (dist >= 0 ? c.lf2 : -c.lb2)); }
            }
        } else {
            const int l0 = (kt - 32) * 64 + 32 * c.hf + 4 * c.h;
            float wf[4], wb[4];
            wf[0] = __builtin_amdgcn_exp2f(c.lf2 * (float)(c.iabs + LCTX - l0)); wf[1] = wf[0] * c.gi; wf[2] = wf[1] * c.gi; wf[3] = wf[2] * c.gi;
            wb[0] = __builtin_amdgcn_exp2f(c.lb2 * (float)(SEQ + l0 - c.iabs)); wb[1] = wb[0] * c.gb; wb[2] = wb[1] * c.gb; wb[3] = wb[2] * c.gb;
#pragma unroll
            for (int q4 = 0; q4 < 4; ++q4) {
#pragma unroll
                for (int e = 0; e < 4; ++e) { st[4 * q4 + e] *= wf[e] + wb[e]; wf[e] *= c.gi8; wb[e] *= c.gb8; } }
        }
    }
    u32x4 p0, p1;
    p0.x = cvtpk(st[0], st[1]); p0.y = cvtpk(st[2], st[3]); p0.z = cvtpk(st[4], st[5]); p0.w = cvtpk(st[6], st[7]);
    p1.x = cvtpk(st[8], st[9]); p1.y = cvtpk(st[10], st[11]); p1.z = cvtpk(st[12], st[13]); p1.w = cvtpk(st[14], st[15]);
    asm volatile("s_waitcnt lgkmcnt(0)" ::: "memory");
    __builtin_amdgcn_s_barrier();
    asm volatile("" ::: "memory");
    *(LAS u32x4*)(xch + c.myx) = p0; *(LAS u32x4*)(xch + c.myx + 1024) = p1;
}

__device__ __forceinline__ void retention_unit(LAS unsigned char* lds, const Args& a, int b, int hh, int qb, int wid, int lane) {
    unsigned char* ws = a.ws;
    bf16_t* Qp = (bf16_t*)(ws + WS_Q); const bf16_t* Kp = (const bf16_t*)(ws + WS_K); const bf16_t* Vp = (const bf16_t*)(ws + WS_V);
    const bf16_t* Gp = (const bf16_t*)(ws + WS_G);
    asm volatile("" : "+v"(lane));
    const int r = lane & 31, h = lane >> 5, rg = wid >> 1, hf = wid & 1;
    const int ch = qb / (RCH / 128), kbeg = (RCH / 64) * ch;
    RetC c; c.kend = kbeg + RCH / 64;
    c.lf2 = -log1pf(expf(-a.dec_f[hh])) * 1.4426950408889634f; c.lb2 = -log1pf(expf(-a.dec_b[hh])) * 1.4426950408889634f;
    c.iabs = qb * 128 + rg * 32 + r; c.qr0 = qb * 128 + rg * 32; c.r = r; c.h = h; c.hf = hf;
    c.gi = exp2f(-c.lf2); { const float t2 = c.gi * c.gi, t4 = t2 * t2; c.gi8 = t4 * t4; } c.gb = exp2f(c.lb2); { const float t2 = c.gb * c.gb, t4 = t2 * t2; c.gb8 = t4 * t4; }
#define RET_UNI(x) x = __uint_as_float(__builtin_amdgcn_readfirstlane(__float_as_uint(x)))
    RET_UNI(c.lf2); RET_UNI(c.lb2); RET_UNI(c.gi); RET_UNI(c.gi8); RET_UNI(c.gb); RET_UNI(c.gb8);
#undef RET_UNI
    bf16x8 qf[16];
    { const bf16_t* qp = Qp + (size_t)(b * SEQ + c.iabs) * DM + hh * 256 + 8 * h;
#pragma unroll
      for (int s = 0; s < 16; ++s) qf[s] = *(const bf16x8*)(qp + 16 * s); }
    f32x16 O[4];
#pragma unroll
    for (int d = 0; d < 4; ++d)
#pragma unroll
        for (int i = 0; i < 16; ++i) O[d][i] = 0.f;
    c.Kl0 = Kp + (size_t)(b * SEQ) * DM + hh * 256; c.Vl0 = Vp + (size_t)(b * SEQ) * DM + hh * 256;
    const int tq = (lane & 15) >> 2, tp = lane & 3, g16 = (lane >> 4) & 1;
    c.tq = tq; c.vlane = (4 * h + tq) * 512 + (2 * g16 + (tp >> 1)) * 16 + (tp & 1) * 8 + hf * 256;
    c.myx = ((wid * 2) * 64 + lane) * 16; c.pbx = (((wid & ~1) * 2) * 64 + lane) * 16;
    ret_issue<false>(lds, c.Kl0 + (size_t)(kbeg * 64) * DM, wid, lane);
    ret_iter<false, false>(lds, c, kbeg, O, qf, wid, lane);
#pragma unroll 1
    for (int kt = kbeg + 1; kt <= kbeg + RCH / 64; ++kt) ret_iter<true, false>(lds, c, kt, O, qf, wid, lane);
    {
        const bf16_t* ST = (const bf16_t*)a.out + (size_t)MTOK * DM + (size_t)((b * 8 + hh) * 2 * NRCH) * 65536;
        const int g16 = (lane >> 4) & 1, tp = lane & 3, tq = c.tq;
        const unsigned l0 = (unsigned)(__UINTPTR_TYPE__)lds;
        const bf16_t* SF = ST + (size_t)ch * 65536; const bf16_t* SB = ST + (size_t)(NRCH + ch) * 65536;
        const float aqf = __builtin_amdgcn_exp2f(c.lf2 * (float)(c.iabs - RCH * ch + 1)), aqb = __builtin_amdgcn_exp2f(c.lb2 * (float)(RCH * (ch + 1) - c.iabs));
#define ST_ISSUE(S, half) do { const int row0 = 128 * (half) + 16 * wid + (lane >> 5), pc = lane & 31; const bf16_t* sp = (S) + (size_t)row0 * 256; unsigned ld = l0 + (half) * 65536 + wid * 8192; \
            _Pragma("unroll 1") for (int cc = 0; cc < 8; ++cc) { const int lc = pc ^ (((2 * cc + (lane >> 5)) & 3) << 2); glds16(sp + lc * 8, (unsigned)__builtin_amdgcn_readfirstlane(ld)); sp += 512; ld += 1024; } } while (0)
#define ST_WAIT(n) do { asm volatile("s_waitcnt vmcnt(" #n ")" ::: "memory"); __syncthreads(); } while (0)
#define ST_COMPUTE(aq, half) do { _Pragma("unroll") for (int s = 8 * (half); s < 8 * (half) + 8; ++s) { \
            const u32x4 qw = __builtin_bit_cast(u32x4, qf[s]); u32x4 pw; \
            pw.x = cvtpk(bflo(qw.x) * (aq), bfhi(qw.x) * (aq)); pw.y = cvtpk(bflo(qw.y) * (aq), bfhi(qw.y) * (aq)); \
            pw.z = cvtpk(bflo(qw.z) * (aq), bfhi(qw.z) * (aq)); pw.w = cvtpk(bflo(qw.w) * (aq), bfhi(qw.w) * (aq)); \
            const bf16x8 af = __builtin_bit_cast(bf16x8, pw); \
            const LAS unsigned char* vb = lds + (16 * s + 8 * h + tq) * 512 + (2 * g16 + (tp >> 1)) * 16 + (tp & 1) * 8; \
            _Pragma("unroll") for (int d = 0; d < 4; ++d) { const int blk = 4 * hf + d; \
                const LAS unsigned char* vp = vb + (((blk ^ tq) & 3) << 6) + (blk >> 2) * 256; \
                const s16x4 lo = vtr(vp), hi = vtr(vp + 4 * 512); \
                O[d] = MFMA32(af, __builtin_shufflevector(lo, hi, 0, 1, 2, 3, 4, 5, 6, 7), O[d]); } } } while (0)
        __syncthreads();
        ST_ISSUE(SF, 0); ST_ISSUE(SF, 1);
#pragma unroll 1
        for (int dir = 0; dir < 2; ++dir) {
            const float aq = dir ? aqb : aqf;
            ST_WAIT(8); ST_COMPUTE(aq, 0);
            __syncthreads(); if (dir == 0) ST_ISSUE(SB, 0);
            if (dir == 0) ST_WAIT(8); else ST_WAIT(0);
            ST_COMPUTE(aq, 1);
            __syncthreads(); if (dir == 0) ST_ISSUE(SB, 1);
        }
#undef ST_ISSUE
#undef ST_WAIT
#undef ST_COMPUTE
    }
    LAS float* xs = (LAS float*)(lds + LDS_XS);
    float rs[16];
#pragma unroll
    for (int i = 0; i < 16; ++i) { float s = 0.f;
#pragma unroll
        for (int d = 0; d < 4; ++d) s += O[d][i] * O[d][i];
        s += __shfl_xor(s, 1); s += __shfl_xor(s, 2); s += __shfl_xor(s, 4); s += __shfl_xor(s, 8); s += __shfl_xor(s, 16);
        rs[i] = s; if (r == 0) xs[wid * 32 + (i & 3) + 8 * (i >> 2) + 4 * h] = s; }
    __syncthreads();
#pragma unroll
    for (int i = 0; i < 16; ++i) { const float s = rs[i] + xs[(wid ^ 1) * 32 + (i & 3) + 8 * (i >> 2) + 4 * h]; rs[i] = 1.0f / sqrtf(s * (1.0f / 256.0f) + EPS); }
    const size_t obase = (size_t)(b * SEQ + qb * 128 + rg * 32 + 4 * h) * DM + hh * 256 + hf * 128 + r;
#pragma unroll
    for (int hh2 = 0; hh2 < 2; ++hh2) {
        bf16_t gv[8][4];
#pragma unroll
        for (int ii = 0; ii < 8; ++ii) { const int i = hh2 * 8 + ii; const size_t off = obase + (size_t)((i & 3) + 8 * (i >> 2)) * DM;
#pragma unroll
            for (int d = 0; d < 4; ++d) gv[ii][d] = Gp[off + 32 * d]; }
        asm volatile("" ::: "memory");
#pragma unroll
        for (int ii = 0; ii < 8; ++ii) { const int i = hh2 * 8 + ii; const size_t off = obase + (size_t)((i & 3) + 8 * (i >> 2)) * DM;
#pragma unroll
            for (int d = 0; d < 4; ++d) Qp[off + 32 * d] = (bf16_t)(cvtpk(O[d][i] * rs[i] * bf2f(gv[ii][d]), 0.f) & 0xffffu); }
        asm volatile("" ::: "memory");
    }
}

__device__ __forceinline__ void state_unit(LAS unsigned char* lds, const Args& a, int b, int hh, int dir, int eh, int wid, int lane) {
    unsigned char* ws = a.ws;
    asm volatile("" : "+v"(lane));
    const int r = lane & 31, h = lane >> 5, tq = (lane & 15) >> 2, tp = lane & 3, g16 = (lane >> 4) & 1;
    float lg2 = -log1pf(expf(-(dir ? a.dec_b[hh] : a.dec_f[hh]))) * 1.4426950408889634f;
    lg2 = __uint_as_float(__builtin_amdgcn_readfirstlane(__float_as_uint(lg2)));
    const float m = exp2f(dir ? lg2 : -lg2);
    const float gch = exp2f((float)RCH * lg2);
    const bf16_t* Kc = (const bf16_t*)(ws + WS_KC) + (size_t)(b * LCTX) * DM + hh * 256; const bf16_t* Vc = (const bf16_t*)(ws + WS_VC) + (size_t)(b * LCTX) * DM + hh * 256;
    const bf16_t* Kl = (const bf16_t*)(ws + WS_K) + (size_t)(b * SEQ) * DM + hh * 256; const bf16_t* Vl = (const bf16_t*)(ws + WS_V) + (size_t)(b * SEQ) * DM + hh * 256;
    bf16_t* ST = (bf16_t*)a.out + (size_t)MTOK * DM + (size_t)((b * 8 + hh) * 2 * NRCH) * 65536;
    constexpr int TPC = RCH / 64, NT = 4 + (NRCH - 1) * TPC;
#define ST_ROW(t_) ((t_) < 4 ? 0 : (dir ? (NRCH - 1 - ((t_) - 4) / TPC) : ((t_) - 4) / TPC) * RCH + (((t_) - 4) % TPC) * 64)
    f32x16 acc[4];
#pragma unroll
    for (int d = 0; d < 4; ++d)
#pragma unroll
        for (int i = 0; i < 16; ++i) acc[d][i] = 0.f;
    const int lanec = (2 * g16 + (tp >> 1)) * 16 + (tp & 1) * 8;
    ret_issue<true>(lds, Kc, wid, lane); ret_issue<true>(lds + 32768, Vc, wid, lane);
#pragma unroll 1
    for (int t = 0; t < NT; ++t) {
        asm volatile("s_waitcnt vmcnt(0) lgkmcnt(0)" ::: "memory");
        __builtin_amdgcn_s_barrier();
        asm volatile("" ::: "memory");
        if (t + 1 < NT) { const int t1 = t + 1; const bf16_t* kp = t1 < 4 ? Kc + (size_t)(t1 * 64) * DM : Kl + (size_t)ST_ROW(t1) * DM; const bf16_t* vp = t1 < 4 ? Vc + (size_t)(t1 * 64) * DM : Vl + (size_t)ST_ROW(t1) * DM;
            ret_issue<true>(lds + (t1 & 1) * 65536, kp, wid, lane); ret_issue<true>(lds + (t1 & 1) * 65536 + 32768, vp, wid, lane); }
        if (t >= 4 && (t - 4) % TPC == 0) {
            const int wi = (t - 4) / TPC; bf16_t* S = ST + (size_t)(dir ? NRCH + (NRCH - 1 - wi) : wi) * 65536;
#pragma unroll
            for (int d = 0; d < 4; ++d)
#pragma unroll
                for (int i = 0; i < 16; ++i) { S[(size_t)(32 * wid + (i & 3) + 8 * (i >> 2) + 4 * h) * 256 + 128 * eh + 32 * d + r] = (bf16_t)(cvtpk(acc[d][i], 0.f) & 0xffffu); acc[d][i] *= gch; }
        }
        const LAS unsigned char* Kt = lds + (t & 1) * 65536; const LAS unsigned char* Vt = Kt + 32768;
        const int p0 = (t < 4 ? 64 * t : 64 * ((t - 4) % TPC)) + 8 * h, last = t < 4 ? 255 : RCH - 1;
#pragma unroll
        for (int s = 0; s < 4; ++s) {
            const LAS unsigned char* kb = Kt + (16 * s + 8 * h + tq) * 512 + lanec + (((wid ^ tq) & 3) << 6) + (wid >> 2) * 256;
            const s16x4 klo = vtr(kb), khi = vtr(kb + 4 * 512);
            const int p = p0 + 16 * s;
            float w = __builtin_amdgcn_exp2f(lg2 * (float)(dir ? p : last - p));
            const u32x2 lw = __builtin_bit_cast(u32x2, klo), hw = __builtin_bit_cast(u32x2, khi);
            float kv[8] = {bflo(lw.x), bfhi(lw.x), bflo(lw.y), bfhi(lw.y), bflo(hw.x), bfhi(hw.x), bflo(hw.y), bfhi(hw.y)};
#pragma unroll
            for (int j = 0; j < 8; ++j) { kv[j] *= w; w *= m; }
            u32x4 pw; pw.x = cvtpk(kv[0], kv[1]); pw.y = cvtpk(kv[2], kv[3]); pw.z = cvtpk(kv[4], kv[5]); pw.w = cvtpk(kv[6], kv[7]);
            const bf16x8 af = __builtin_bit_cast(bf16x8, pw);
            const LAS unsigned char* vb = Vt + (16 * s + 8 * h + tq) * 512 + lanec;
#pragma unroll
            for (int d = 0; d < 4; ++d) { const int blk = 4 * eh + d;
                const LAS unsigned char* vp = vb + (((blk ^ tq) & 3) << 6) + (blk >> 2) * 256;
                const s16x4 lo = vtr(vp), hi = vtr(vp + 4 * 512);
                acc[d] = MFMA32(af, __builtin_shufflevector(lo, hi, 0, 1, 2, 3, 4, 5, 6, 7), acc[d]); }
        }
    }
    { bf16_t* S = ST + (size_t)(dir ? NRCH : NRCH - 1) * 65536;
#pragma unroll
      for (int d = 0; d < 4; ++d)
#pragma unroll
          for (int i = 0; i < 16; ++i) S[(size_t)(32 * wid + (i & 3) + 8 * (i >> 2) + 4 * h) * 256 + 128 * eh + 32 * d + r] = (bf16_t)(cvtpk(acc[d][i], 0.f) & 0xffffu); }
#undef ST_ROW
}

__device__ __forceinline__ void spatial_unit(LAS unsigned char* lds, const Args& a, int b, int n, int ghalf, int tid, int wid, int lane) {
    bf16_t* Up = (bf16_t*)a.out; const bf16_t* VSp = (const bf16_t*)a.out + (size_t)MTOK * DM;
    const bf16_t* Wb = (const bf16_t*)(a.ws + WS_SGW);
    asm volatile("" : "+v"(lane)); asm volatile("" : "+v"(tid));
    LAS f32x2* stats = (LAS f32x2*)(lds + LDS_STATS);
    const int tok0 = b * SEQ + n * 128;
#pragma unroll 1
    for (int t0 = wid * 16; t0 < wid * 16 + 16; t0 += 4) {
        u32x4 w[4][4];
#pragma unroll
        for (int tt = 0; tt < 4; ++tt)
#pragma unroll
            for (int j = 0; j < 4; ++j) w[tt][j] = *(const u32x4*)(VSp + (size_t)(tok0 + t0 + tt) * DM + j * 512 + lane * 8);
#pragma unroll
        for (int tt = 0; tt < 4; ++tt) { float s = 0.f, ss = 0.f;
#pragma unroll
            for (int j = 0; j < 4; ++j)
#pragma unroll
                for (int e = 0; e < 4; ++e) { const float x0 = bflo(w[tt][j][e]), x1 = bfhi(w[tt][j][e]); s += x0 + x1; ss += x0 * x0 + x1 * x1; }
            s = wave_sum(s); ss = wave_sum(ss);
            const float mean = s * (1.0f / DM); float var = ss * (1.0f / DM) - mean * mean; var = var > 0.f ? var : 0.f;
            if (lane == 0) stats[t0 + tt] = (f32x2){mean, 1.0f / sqrtf(var + EPS)}; }
    }
    __syncthreads();
    const int r = lane & 31, h = lane >> 5, ib = wid & 3, dbh = wid >> 2;
    const int tq = (lane & 15) >> 2, tp = lane & 3, g16 = (lane >> 4) & 1;
    for (int gi = 0; gi < 4; ++gi) {
        const int g = ghalf * 4 + gi;
        { const int lc = tid & 31, ch = g * 256 + lc * 8, row0 = tid >> 5;
          u32x4 w[8];
#pragma unroll
          for (int it = 0; it < 8; ++it) w[it] = *(const u32x4*)(VSp + (size_t)(tok0 + row0 + it * 16) * DM + ch);
          const f32x4 g0 = *(const f32x4*)(a.sg_ln_g + ch), g1 = *(const f32x4*)(a.sg_ln_g + ch + 4), b0 = *(const f32x4*)(a.sg_ln_b + ch), b1 = *(const f32x4*)(a.sg_ln_b + ch + 4);
#pragma unroll
          for (int it = 0; it < 8; ++it) { const int row = row0 + it * 16; const f32x2 st = stats[row];
            u32x4 o;
            o.x = cvtpk((bflo(w[it].x) - st.x) * st.y * g0[0] + b0[0], (bfhi(w[it].x) - st.x) * st.y * g0[1] + b0[1]);
            o.y = cvtpk((bflo(w[it].y) - st.x) * st.y * g0[2] + b0[2], (bfhi(w[it].y) - st.x) * st.y * g0[3] + b0[3]);
            o.z = cvtpk((bflo(w[it].z) - st.x) * st.y * g1[0] + b1[0], (bfhi(w[it].z) - st.x) * st.y * g1[1] + b1[1]);
            o.w = cvtpk((bflo(w[it].w) - st.x) * st.y * g1[2] + b1[2], (bfhi(w[it].w) - st.x) * st.y * g1[3] + b1[3]);
            *(LAS u32x4*)(lds + row * 512 + ((lc ^ ((row & 3) << 2)) << 4)) = o; } }
        __syncthreads();
        f32x16 acc[4];
#pragma unroll
        for (int d = 0; d < 4; ++d)
#pragma unroll
            for (int i = 0; i < 16; ++i) acc[d][i] = 0.f;
        const bf16_t* wrow = Wb + (size_t)g * 16384 + (size_t)(ib * 32 + r) * 128 + 8 * h;
        bf16x8 afr[8];
#pragma unroll
        for (int ks = 0; ks < 8; ++ks) afr[ks] = *(const bf16x8*)(wrow + 16 * ks);
#pragma unroll
        for (int ks = 0; ks < 8; ++ks) {
            const bf16x8 af = afr[ks];
            const LAS unsigned char* vb = lds + (16 * ks + 8 * h + tq) * 512 + (2 * g16 + (tp >> 1)) * 16 + (tp & 1) * 8;
#pragma unroll
            for (int d = 0; d < 4; ++d) { const int db = dbh * 4 + d;
                const LAS unsigned char* vp = vb + (((db ^ tq) & 3) << 6) + (db >> 2) * 256;
                const s16x4 lo = vtr(vp), hi = vtr(vp + 4 * 512);
                const bf16x8 bfr = __builtin_shufflevector(lo, hi, 0, 1, 2, 3, 4, 5, 6, 7);
                acc[d] = MFMA32(af, bfr, acc[d]); }
        }
#pragma unroll
        for (int hh2 = 0; hh2 < 2; ++hh2) {
            bf16_t uv[8][4]; float bias[8];
#pragma unroll
            for (int ii = 0; ii < 8; ++ii) { const int i = hh2 * 8 + ii, il = ib * 32 + (i & 3) + 8 * (i >> 2) + 4 * h; bias[ii] = a.sg_b[g * 128 + il];
                const size_t off = (size_t)(tok0 + il) * DM + g * 256 + dbh * 128 + r;
#pragma unroll
                for (int d = 0; d < 4; ++d) uv[ii][d] = Up[off + 32 * d]; }
            asm volatile("" ::: "memory");
#pragma unroll
            for (int ii = 0; ii < 8; ++ii) { const int i = hh2 * 8 + ii, il = ib * 32 + (i & 3) + 8 * (i >> 2) + 4 * h;
                const size_t off = (size_t)(tok0 + il) * DM + g * 256 + dbh * 128 + r;
#pragma unroll
                for (int d = 0; d < 4; ++d) Up[off + 32 * d] = (bf16_t)(cvtpk(bf2f(uv[ii][d]) * (acc[d][i] + bias[ii]), 0.f) & 0xffffu); }
            asm volatile("" ::: "memory");
        }
        __syncthreads();
    }
}

#define XB_TMO      128
#define XB_XCNT(j)  (256  + 64 * (j))
#define XB_XSUB(j)  (1280 + 64 * (j))
#define XB_XGEN(j)  (2304 + 64 * (j))
#define XB_TOP      3328
#define XB_TOPGEN   3392
#define XCD_BAR_WORDS 3456
#define XB_SPIN_CAP (1u << 22)
__device__ __forceinline__ unsigned xb_ld(unsigned* p)              { return __hip_atomic_load(p, __ATOMIC_RELAXED, __HIP_MEMORY_SCOPE_AGENT); }
__device__ __forceinline__ unsigned xb_add(unsigned* p, unsigned v) { return __hip_atomic_fetch_add(p, v, __ATOMIC_RELAXED, __HIP_MEMORY_SCOPE_AGENT); }
__device__ __forceinline__ unsigned xb_xcc_id() { return (unsigned)__builtin_amdgcn_s_getreg((3 << 11) | 20) & 0xFu; }
#define XB_SPIN(cond, bar) do { unsigned _sp = 0; while (cond) { __builtin_amdgcn_s_sleep(1); \
    if ((++_sp & 255u) == 0u) { if (xb_ld(&(bar)[XB_TMO])) break; if (_sp > XB_SPIN_CAP) { atomicAdd(&(bar)[XB_TMO], 1u); break; } } } } while (0)
struct XcdBarrier { unsigned* bar; unsigned x; volatile LAS unsigned* st; };
__device__ __forceinline__ XcdBarrier xcd_barrier_post(unsigned* bar, volatile LAS unsigned* st) {
    XcdBarrier b; b.bar = bar; b.x = xb_xcc_id(); b.st = st;
    if (threadIdx.x == 0) (void)xb_add(&bar[XB_XCNT(b.x)], 1u);
    return b;
}
__device__ __forceinline__ void xcd_barrier_complete(unsigned* bar, unsigned x, unsigned& nloc, unsigned& nx) {
    const unsigned G = gridDim.x * gridDim.y * gridDim.z;
    unsigned sum, cnt, mine, sp = 0u;
    for (;;) {
        sum = 0u; cnt = 0u; mine = 0u;
#pragma unroll
        for (unsigned j = 0; j < 16; ++j) { const unsigned c = xb_ld(&bar[XB_XCNT(j)]); sum += c; cnt += (c > 0u) ? 1u : 0u; mine = (j == x) ? c : mine; }
        if (sum == G) break;
        __builtin_amdgcn_s_sleep(1);
        if ((++sp & 255u) == 0u) { if (xb_ld(&bar[XB_TMO])) break; if (sp > XB_SPIN_CAP) { atomicAdd(&bar[XB_TMO], 1u); break; } }
    }
    nloc = mine > 0u ? mine : 1u; nx = cnt > 0u ? cnt : 1u;
}
__device__ __forceinline__ void xcd_barrier(const XcdBarrier& b) {
    asm volatile("s_waitcnt vmcnt(0)" ::: "memory");
    __syncthreads();
    if (threadIdx.x == 0) {
        unsigned* bar = b.bar;
        __builtin_amdgcn_s_waitcnt(0);
        unsigned nloc = b.st[0], nx = b.st[1];
        if (nloc == 0u) { xcd_barrier_complete(bar, b.x, nloc, nx); b.st[0] = nloc; b.st[1] = nx; }
        const unsigned old = xb_add(&bar[XB_XSUB(b.x)], 1u);
        const unsigned gen = old / nloc;
        if (old + 1u == (gen + 1u) * nloc) {
            __builtin_amdgcn_fence(__ATOMIC_RELEASE, "agent");
            asm volatile("s_waitcnt vmcnt(0)" ::: "memory");
            const unsigned og = xb_add(&bar[XB_TOP], 1u);
            const unsigned tg = og / nx;
            if (og + 1u == (tg + 1u) * nx) xb_add(&bar[XB_TOPGEN], 1u);
            else XB_SPIN(xb_ld(&bar[XB_TOPGEN]) == tg, bar);
            __builtin_amdgcn_fence(__ATOMIC_ACQUIRE, "agent");
            xb_add(&bar[XB_XGEN(b.x)], 1u);
            asm volatile("s_waitcnt vmcnt(0)" ::: "memory");
        } else {
            XB_SPIN(xb_ld(&bar[XB_XGEN(b.x)]) == gen, bar);
            __builtin_amdgcn_fence(__ATOMIC_ACQUIRE, "agent");
            asm volatile("s_waitcnt vmcnt(0)" ::: "memory");
        }
    }
    __syncthreads();
}

__global__ void __launch_bounds__(512, 2) fwd_megakernel(Args a) {
    extern __shared__ __attribute__((aligned(16))) unsigned char lds_raw[];
    LAS unsigned char* lds = (LAS unsigned char*)lds_raw;
    cg::grid_group grid = cg::this_grid();
    const int tid = threadIdx.x, wid = __builtin_amdgcn_readfirstlane(tid >> 6), lane = tid & 63;
    const int G = gridDim.x, bx = blockIdx.x;
    unsigned char* ws = a.ws;
    const float* MOD = (const float*)(ws + WS_MOD);
    const int gw = bx * 8 + wid, NGW = G * 8;

    if (tid < 4) ((LAS unsigned*)(lds + LDS_BARST))[tid] = 0u;
    __syncthreads();
    const XcdBarrier xbar = xcd_barrier_post((unsigned*)(ws + WS_BAR), (volatile LAS unsigned*)(lds + LDS_BARST));
#define GRID_BAR() xcd_barrier(xbar)
    if (a.dec_f[0] < -1e30f) grid.sync();
    p0_prologue(a, lds, tid, wid, lane, G);
    GRID_BAR();
    rows_phase<false>(a.x, a.ctx, MTOK, MTOK + MCTX, a.norm1_g, MOD, 0, DM, (void*)(ws + WS_H), gw, NGW, lane);
    GRID_BAR();
    {
        EpiIn E{(bf16_t*)(ws + WS_Q), (bf16_t*)(ws + WS_K), (bf16_t*)(ws + WS_V), (bf16_t*)(ws + WS_G), (bf16_t*)a.out, (bf16_t*)a.out + (size_t)MTOK * DM,
                (bf16_t*)(ws + WS_KC), (bf16_t*)(ws + WS_VC), (const f32x4*)(ws + WS_ROPE)};
        pg8::Gemm g{(const bf16_t*)(ws + WS_H), (const bf16_t*)(ws + WS_WIN), nullptr, nullptr, DM}; pg8::Order S; S.init(64, 48, 0, 128, G, bx);
        pg8::gemm_phase(lds, g, S, E);
        if (G == 256) { if (bx >= 128) convert_ffn(a, lds, (bx - 128) * 8 + wid, 128 * 8, wid, lane); }
        else convert_ffn(a, lds, gw, NGW, wid, lane);
    }
    GRID_BAR();
    for (int idx = bx; idx < 256; idx += G) { spatial_unit(lds, a, idx >> 5, (idx >> 1) & 15, idx & 1, tid, wid, lane); }
    GRID_BAR();
    for (int idx = bx; idx < 256; idx += G) { state_unit(lds, a, idx >> 5, (idx >> 2) & 7, (idx >> 1) & 1, idx & 1, wid, lane); __syncthreads(); }
    GRID_BAR();
    for (int i = 0; ; ++i) {
        int b, hh, qb;
        if (G == 256) { if (i >= 4) break; const int xcd = bx & 7, j = i * 32 + (bx >> 3); hh = xcd; b = j >> 4; qb = j & 15; }
        else { const int idx = i * G + bx; if (idx >= 1024) break; b = idx >> 7; hh = (idx >> 4) & 7; qb = idx & 15; }
        retention_unit(lds, a, b, hh, qb, wid, lane);
        __syncthreads();
    }
    GRID_BAR();
    {
        EpiIn E{(bf16_t*)(ws + WS_Q), (bf16_t*)(ws + WS_K), (bf16_t*)(ws + WS_V), (bf16_t*)(ws + WS_G), (bf16_t*)a.out, (bf16_t*)a.out + (size_t)MTOK * DM,
                (bf16_t*)(ws + WS_KC), (bf16_t*)(ws + WS_VC), (const f32x4*)(ws + WS_ROPE)};
        pg8::Gemm g{(const bf16_t*)(ws + WS_H), (const bf16_t*)(ws + WS_WIN), nullptr, nullptr, DM}; pg8::Order S; S.init(64, 16, 48, 0, G, bx);
        pg8::gemm_phase(lds, g, S, E);
    }
    GRID_BAR();
    {
        EpiDual E{(const bf16_t*)(ws + WS_K), (const bf16_t*)(ws + WS_V), (bf16_t*)(ws + WS_G)};
        pg8::Gemm g{(const bf16_t*)(ws + WS_Q), (const bf16_t*)(ws + WS_W3), (const bf16_t*)a.out, (const bf16_t*)(ws + WS_W3 + 8 * MiB), DM}; pg8::Order S; S.init(64, 8, 0, 0, G, bx, 1);
        pg8::gemm_phase(lds, g, S, E);
    }
    GRID_BAR();
    {
        EpiRes E{a.x, MOD + 2 * DM, a.out};
        pg8::Gemm g{(const bf16_t*)(ws + WS_G), (const bf16_t*)(ws + WS_W3 + 16 * MiB), nullptr, nullptr, DM}; pg8::Order S; S.init(64, 8, 0, 0, G, bx);
        pg8::gemm_phase(lds, g, S, E);
    }
    GRID_BAR();
    rows_phase<false>(a.out, a.out, MTOK, MTOK, a.norm2_g, MOD, 3 * DM, 4 * DM, (void*)(ws + WS_Q), gw, NGW, lane);
    GRID_BAR();
    {
        EpiSwiglu E{(bf16_t*)(ws + WS_HID)};
        pg8::Gemm g{(const bf16_t*)(ws + WS_Q), (const bf16_t*)(ws + WS_WF1), nullptr, nullptr, DM}; pg8::Order S; S.init(64, 44, 0, 0, G, bx);
        pg8::gemm_phase(lds, g, S, E);
    }
    GRID_BAR();
    {
        EpiRes E{a.out, MOD + 5 * DM, a.out};
        pg8::Gemm g{(const bf16_t*)(ws + WS_HID), (const bf16_t*)(ws + WS_WF2), nullptr, nullptr, FF}; pg8::Order S; S.init(64, 8, 0, 0, G, bx);
        pg8::gemm_phase(lds, g, S, E);
    }
    GRID_BAR();
    rows_phase<true>(a.out, a.out, MTOK, MTOK, a.final_g, MOD, 0, 0, (void*)a.out, gw, NGW, lane);
}

extern "C" void kernel_launch(void* const* d_in, const int* in_sizes, int n_in, void* d_out, int out_size, void* d_ws, size_t ws_size, hipStream_t stream) {
    static int grid_blocks = 0;
    if (grid_blocks == 0) {
        if (n_in != 21 || out_size != MTOK * DM || ws_size < WS_END) { fprintf(stderr, "kernel_launch: unexpected problem (n_in %d, out %d, ws %zu)\n", n_in, out_size, ws_size); grid_blocks = -1; return; }
        int dev = 0, cus = 0, per_cu = 0;
        hipGetDevice(&dev);
        hipDeviceGetAttribute(&cus, hipDeviceAttributeMultiprocessorCount, dev);
        if (hipFuncSetAttribute((const void*)fwd_megakernel, hipFuncAttributeMaxDynamicSharedMemorySize, LDS_BYTES) != hipSuccess) { fprintf(stderr, "kernel_launch: hipFuncSetAttribute failed\n"); grid_blocks = -1; return; }
        if (hipOccupancyMaxActiveBlocksPerMultiprocessor(&per_cu, (const void*)fwd_megakernel, 512, LDS_BYTES) != hipSuccess || per_cu < 1) { fprintf(stderr, "kernel_launch: occupancy query gave %d\n", per_cu); per_cu = 1; }
        (void)hipGetLastError();
        grid_blocks = cus * (per_cu > 1 ? 1 : per_cu);
        if (grid_blocks < 1) grid_blocks = 256;
    }
    if (grid_blocks < 0) return;
    if (hipMemsetAsync((char*)d_ws + WS_BAR, 0, XCD_BAR_WORDS * 4, stream) != hipSuccess) { fprintf(stderr, "kernel_launch: memset of the barrier words failed\n"); return; }
    Args a{};
    const float** pp = (const float**)&a;
    for (int i = 0; i < 21; ++i) pp[i] = (const float*)d_in[i];
    a.out = (float*)d_out; a.ws = (unsigned char*)d_ws;
    void* args[] = {&a};
    hipError_t e = hipLaunchCooperativeKernel((const void*)fwd_megakernel, dim3(grid_blocks), dim3(512), args, LDS_BYTES, stream);
    if (e != hipSuccess) fprintf(stderr, "cooperative launch failed: %s (grid %d)\n", hipGetErrorString(e), grid_blocks);
}
```

```cpp
#include <hip/hip_runtime.h>
#include <hip/hip_cooperative_groups.h>
#include <cstdio>
#include <cstdint>
namespace cg = cooperative_groups;

#define LAS __attribute__((address_space(3)))
typedef unsigned short bf16_t;
typedef short bf16x8 __attribute__((ext_vector_type(8)));
typedef short s16x4 __attribute__((ext_vector_type(4)));
typedef short v4i16_t __attribute__((ext_vector_type(4)));
typedef float f32x2 __attribute__((ext_vector_type(2)));
typedef float f32x4 __attribute__((ext_vector_type(4)));
typedef float f32x16 __attribute__((ext_vector_type(16)));
typedef unsigned u32x2 __attribute__((ext_vector_type(2)));
typedef unsigned u32x4 __attribute__((ext_vector_type(4)));
typedef __bf16 bf16x2_t __attribute__((ext_vector_type(2)));

constexpr int DM = 2048, NB = 8, SEQ = 2048, MTOK = NB * SEQ, LCTX = 256, MCTX = NB * LCTX, NH = 8, DIN = 16384, FF = 5632, NMOD = 12288;
constexpr float EPS = 1e-6f;
constexpr size_t MiB = 1u << 20;
constexpr size_t WS_MOD = 0, WS_ROPE = 512 * 1024, WS_SGW = 576 * 1024;
constexpr size_t WS_WF1 = 1 * MiB, WS_WF2 = 45 * MiB, WS_W3 = 67 * MiB, WS_Q = 91 * MiB, WS_WIN = 155 * MiB, WS_H = 219 * MiB, WS_K = 291 * MiB, WS_V = 355 * MiB,
                 WS_KC = 419 * MiB, WS_VC = 427 * MiB, WS_G = 435 * MiB, WS_END = 499 * MiB;
constexpr int RCH = 512, NRCH = SEQ / RCH;
constexpr size_t WS_T = WS_WIN, WS_HID = WS_WIN;
constexpr int LDS_BYTES = 153600;
constexpr int LDS_XCH = 131072, LDS_XS = 147456, LDS_STATS = 148480, LDS_BARST = 149504;
constexpr size_t WS_BAR = 896 * 1024;

__device__ __forceinline__ unsigned cvtpk(float lo, float hi) { f32x2 v = {lo, hi}; bf16x2_t b = __builtin_convertvector(v, bf16x2_t); return __builtin_bit_cast(unsigned, b); }
__device__ __forceinline__ float bflo(unsigned w) { return __uint_as_float(w << 16); }
__device__ __forceinline__ float bfhi(unsigned w) { return __uint_as_float(w & 0xffff0000u); }
__device__ __forceinline__ float bf2f(bf16_t b) { return __uint_as_float(((unsigned)b) << 16); }
__device__ __forceinline__ float fast_sigmoid(float x) { return __builtin_amdgcn_rcpf(1.0f + __builtin_amdgcn_exp2f(-1.4426950408889634f * x)); }
__device__ __forceinline__ float fast_silu(float x) { return x * fast_sigmoid(x); }
__device__ __forceinline__ float fast_gelu(float x) { const float z = 0.7978845608028654f * (x + 0.044715f * x * x * x); return x * fast_sigmoid(2.0f * z); }
__device__ __forceinline__ float wave_sum(float v) {
#pragma unroll
    for (int o = 1; o < 64; o <<= 1) v += __shfl_xor(v, o);
    return v;
}

namespace pg8 {
constexpr int BM = 256, BK = 64, HALF = 128, HTB = HALF * BK * 2, STAGE_BYTES = 8 * HTB, NXCD = 8, WGM = 4;
__host__ __device__ __forceinline__ int lds_byte(int r, int c) { const int st = (r >> 4) * 2 + (c >> 5), rr = r & 15, cc = c & 31, ob = rr * 64 + cc * 2; return st * 1024 + (ob ^ (((ob >> 9) & 1) << 5)); }
__host__ __device__ __forceinline__ void stage_rc(int b, int& R, int& C) { const int st = b / 1024, sb = b % 1024, swz = sb ^ (((sb >> 9) & 1) << 5); R = (st >> 1) * 16 + swz / 64; C = (st & 1) * 32 + (swz % 64) / 2; }
__host__ __device__ __forceinline__ int perm32(int rho) { const int n = rho >> 4, i = rho & 15; return 8 * (i >> 2) + 4 * n + (i & 3); }

struct Unit { int pm, pn, which; };
struct Gemm { const bf16_t* A; const bf16_t* Bt; const bf16_t* A2; const bf16_t* Bt2; int K; };

struct Order {
    int nM, nN, pn0, nwg, G, c, nextra, dual;
    __device__ void init(int nM_, int nN_, int pn0_, int nextra_, int G_, int c_, int dual_ = 0) { nM = nM_; nN = nN_; pn0 = pn0_; nwg = nM * nN; nextra = nextra_; G = G_; c = c_; dual = dual_; }
    __device__ bool next(int i, Unit& u) const {
        u.which = dual ? (i & 1) : 0; if (dual) i >>= 1;
        long L = (long)i * G + c;
        if (L < nwg) {
            int wgid = (int)L; { const int q = nwg / NXCD, r = nwg % NXCD, xcd = wgid % NXCD, off = wgid / NXCD; wgid = (xcd < r ? xcd * (q + 1) : r * (q + 1) + (xcd - r) * q) + off; }
            const int nig = WGM * nN, gid = wgid / nig, fm = gid * WGM, gsz = (nM - fm) < WGM ? (nM - fm) : WGM;
            u.pm = fm + ((wgid % nig) % gsz); u.pn = pn0 + (wgid % nig) / gsz; return true;
        }
        L -= nwg;
        if (L < nextra) { u.pm = 64 + (int)(L & 7); u.pn = 8 + (int)(L >> 3); return true; }
        return false;
    }
};

template <class Epi>
__device__ __forceinline__ void gemm_phase(LAS unsigned char* lds, const Gemm g, const Order& S, const Epi& E) {
    int tid_ = threadIdx.x; asm volatile("" : "+v"(tid_));
    const int tid = tid_, wid = __builtin_amdgcn_readfirstlane(tid >> 6), lane = tid & 63, wr = wid >> 2, wc = wid & 3, fr = lane & 15, fq = lane >> 4;
    const int K = g.K, nt = K / BK;
    unsigned voffA[2], voffB[2];
#pragma unroll
    for (int i = 0; i < 2; ++i) { int R, C; stage_rc(tid * 16 + i * 8192, R, C); const int Rb = (R & ~31) + perm32(R & 31);
        voffA[i] = (unsigned)(R * K + C) * 2u; voffB[i] = (unsigned)(Rb * K + C) * 2u; }
    const size_t kstep = (size_t)(BK * 2);
    const size_t hstep = (size_t)HALF * K * 2;
    const size_t tstep = 2 * hstep;
    const unsigned ldsw = (unsigned)wid * 1024u;
    const int aoff = lds_byte(wr * 64 + fr, fq * 8), boff = lds_byte(wc * 32 + fr, fq * 8);
#define PG8_SA(b, h) (((b) * 2 + (h)) * HTB)
#define PG8_SB(b, h) ((4 + (b) * 2 + (h)) * HTB)
#define PG8_STAGE(bufoff, gbase, voff) do { _Pragma("unroll") for (int _i = 0; _i < 2; ++_i) \
        __builtin_amdgcn_global_load_lds((const unsigned*)((const char*)(gbase) + (voff)[_i]), (LAS unsigned*)(lds + (bufoff) + ldsw + _i * 8192), 16, 0, 0); } while (0)
#define PG8_LDA(dst, b, h) do { _Pragma("unroll") for (int m = 0; m < 4; ++m) _Pragma("unroll") for (int k = 0; k < 2; ++k) dst[m][k] = *(const LAS bf16x8*)(lds + PG8_SA(b, h) + aoff + m * 2048 + k * 1024); } while (0)
#define PG8_LDB(dst, b, h) do { _Pragma("unroll") for (int n = 0; n < 2; ++n) _Pragma("unroll") for (int k = 0; k < 2; ++k) dst[n][k] = *(const LAS bf16x8*)(lds + PG8_SB(b, h) + boff + n * 2048 + k * 1024); } while (0)
#define PG8_MMA(ai, bj, At, Bt) do { __builtin_amdgcn_s_setprio(1); _Pragma("unroll") for (int m = 0; m < 4; ++m) _Pragma("unroll") for (int n = 0; n < 2; ++n) _Pragma("unroll") for (int k = 0; k < 2; ++k) \
        acc[ai][bj][m][n] = __builtin_amdgcn_mfma_f32_16x16x32_bf16(Bt[n][k], At[m][k], acc[ai][bj][m][n], 0, 0, 0); __builtin_amdgcn_s_setprio(0); } while (0)
#define PG8_WAIT_V(n) asm volatile("s_waitcnt vmcnt(" #n ")" ::: "memory")
#define PG8_WAIT_L(n) asm volatile("s_waitcnt lgkmcnt(" #n ")" ::: "memory")
#define PG8_BAR __builtin_amdgcn_s_barrier()
#define PG8_SCHED __builtin_amdgcn_sched_barrier(0)
    Unit cur, nxt; int ui = 0;
    if (!S.next(0, cur)) return;
    f32x4 acc[2][2][4][2];
#pragma unroll
    for (int a = 0; a < 2; ++a)
#pragma unroll
        for (int b = 0; b < 2; ++b)
#pragma unroll
            for (int m = 0; m < 4; ++m)
#pragma unroll
                for (int n = 0; n < 2; ++n) acc[a][b][m][n] = (f32x4){0.f, 0.f, 0.f, 0.f};
    bf16x8 At[4][2], B0[2][2], B1[2][2];
    const char* cA = (const char*)(cur.which ? g.A2 : g.A) + (size_t)cur.pm * tstep; const char* cB = (const char*)(cur.which ? g.Bt2 : g.Bt) + (size_t)cur.pn * tstep;
    PG8_STAGE(PG8_SB(0, 0), cB, voffB); PG8_STAGE(PG8_SB(0, 1), cB + hstep, voffB); PG8_STAGE(PG8_SA(0, 0), cA, voffA); PG8_STAGE(PG8_SA(0, 1), cA + hstep, voffA);
    if (wr == 1) PG8_BAR;
    PG8_WAIT_V(2); PG8_BAR;
    PG8_STAGE(PG8_SB(1, 0), cB + kstep, voffB); PG8_STAGE(PG8_SA(1, 0), cA + kstep, voffA); PG8_STAGE(PG8_SB(1, 1), cB + hstep + kstep, voffB);
    PG8_WAIT_V(6); PG8_BAR;
    for (;;) {
        const bool has_next = S.next(ui + 1, nxt);
        const char* nA = has_next ? (const char*)(nxt.which ? g.A2 : g.A) + (size_t)nxt.pm * tstep : cA; const char* nB = has_next ? (const char*)(nxt.which ? g.Bt2 : g.Bt) + (size_t)nxt.pn * tstep : cB;
        for (int t = 0; t < nt; t += 2) {
            const bool last = (t == nt - 2);
            const char* a1 = cA + (size_t)(t + 1) * kstep;
            const char* a2 = last ? nA : cA + (size_t)(t + 2) * kstep; const char* b2 = last ? nB : cB + (size_t)(t + 2) * kstep;
            const char* a3 = a2 + kstep; const char* b3 = b2 + kstep;
            PG8_LDB(B0, 0, 0); PG8_LDB(B1, 0, 1); PG8_SCHED; PG8_LDA(At, 0, 0); PG8_STAGE(PG8_SA(1, 1), a1 + hstep, voffA);
            PG8_WAIT_V(8); PG8_WAIT_L(0); PG8_BAR; PG8_MMA(0, 0, At, B0); PG8_MMA(0, 1, At, B1); PG8_BAR; PG8_SCHED;
            PG8_LDA(At, 0, 1); PG8_STAGE(PG8_SB(0, 0), b2, voffB); PG8_STAGE(PG8_SB(0, 1), b2 + hstep, voffB); PG8_STAGE(PG8_SA(0, 0), a2, voffA);
            PG8_WAIT_V(8); PG8_WAIT_L(0); PG8_BAR; PG8_MMA(1, 0, At, B0); PG8_MMA(1, 1, At, B1); PG8_BAR; PG8_SCHED;
            PG8_LDB(B0, 1, 0); PG8_LDB(B1, 1, 1); PG8_SCHED; PG8_LDA(At, 1, 0); PG8_STAGE(PG8_SA(0, 1), a2 + hstep, voffA);
            PG8_WAIT_V(8); PG8_WAIT_L(0); PG8_BAR; PG8_MMA(0, 0, At, B0); PG8_MMA(0, 1, At, B1); PG8_BAR; PG8_SCHED;
            PG8_LDA(At, 1, 1); PG8_STAGE(PG8_SB(1, 0), b3, voffB); PG8_STAGE(PG8_SB(1, 1), b3 + hstep, voffB); PG8_STAGE(PG8_SA(1, 0), a3, voffA);
            PG8_WAIT_V(8); PG8_WAIT_L(0); PG8_BAR; PG8_MMA(1, 0, At, B0); PG8_MMA(1, 1, At, B1); PG8_BAR; PG8_SCHED;
        }
        if (wr == 0) PG8_BAR;
        const bool keep = E(acc, cur, wr, wc, fr, fq);
        if (!has_next) break;
        if (!keep)
#pragma unroll
        for (int a = 0; a < 2; ++a)
#pragma unroll
            for (int b = 0; b < 2; ++b)
#pragma unroll
                for (int m = 0; m < 4; ++m)
#pragma unroll
                    for (int n = 0; n < 2; ++n) acc[a][b][m][n] = (f32x4){0.f, 0.f, 0.f, 0.f};
        cur = nxt; cA = nA; cB = nB; ++ui;
        if (wr == 1) PG8_BAR;
    }
    PG8_WAIT_V(0);
    PG8_BAR;
#undef PG8_SA
#undef PG8_SB
#undef PG8_STAGE
#undef PG8_LDA
#undef PG8_LDB
#undef PG8_MMA
#undef PG8_WAIT_V
#undef PG8_WAIT_L
#undef PG8_BAR
#undef PG8_SCHED
}
}
using pg8::Unit;

#define EPI_ARGS f32x4 (&acc)[2][2][4][2], const Unit& u, int wr, int wc, int fr, int fq
#define EPI_FOR_ROWS _Pragma("unroll") for (int ai = 0; ai < 2; ++ai) _Pragma("unroll") for (int m = 0; m < 4; ++m)
#define EPI_FOR_BJ _Pragma("unroll") for (int bj = 0; bj < 2; ++bj)

struct EpiIn {
    bf16_t *Q, *K, *V, *G, *U, *VS, *KC, *VC; const f32x4* rope;
    __device__ __forceinline__ bool operator()(EPI_ARGS) const {
        const int region = u.pn >> 3, hcol = (u.pn & 7) * 256;
        const bool isctx = u.pm >= 64;
        bf16_t* base; int mode; float sc = 1.0f;
        switch (region) {
            case 0: base = Q; mode = 0; break;
            case 1: base = isctx ? KC : K; mode = isctx ? 1 : 0; sc = 0.0625f; break;
            case 2: base = isctx ? VC : V; mode = 1; break;
            case 3: base = G; mode = 2; break;
            case 4: base = U; mode = 3; break;
            case 5: base = VS; mode = 3; break;
            case 6: base = K; mode = 4; break;
            default: base = V; mode = 4; break;
        }
        const int prow = isctx ? (u.pm - 64) * 256 : u.pm * 256;
        const int col0 = hcol + wc * 32 + fq * 8;
        if (mode == 0) {
            const int lbase = (u.pm & 7) * 256, tcol = wc * 8 + fq * 2;
            f32x4 tr[2][2], tc[4][2];
#pragma unroll
            for (int ai = 0; ai < 2; ++ai) { const int pos = (lbase + ai * 128 + wr * 64) >> 6; tr[ai][0] = rope[pos * 32 + tcol]; tr[ai][1] = rope[pos * 32 + tcol + 1]; }
#pragma unroll
            for (int m = 0; m < 4; ++m) { const int pos = m * 16 + fr; tc[m][0] = rope[pos * 32 + tcol]; tc[m][1] = rope[pos * 32 + tcol + 1]; }
            EPI_FOR_ROWS {
                const int rl = ai * 128 + wr * 64 + m * 16 + fr;
                bf16_t* rowp = base + (size_t)(prow + rl) * DM + col0;
                EPI_FOR_BJ {
                    const f32x4 t0 = bj == 0 ? tr[ai][0] : tc[m][0], t1 = bj == 0 ? tr[ai][1] : tc[m][1];
                    const f32x4 v0 = acc[ai][bj][m][0] * sc, v1 = acc[ai][bj][m][1] * sc;
                    u32x4 w;
                    w.x = cvtpk(v0[0] * t0[0] - v0[1] * t0[1], v0[1] * t0[0] + v0[0] * t0[1]);
                    w.y = cvtpk(v0[2] * t0[2] - v0[3] * t0[3], v0[3] * t0[2] + v0[2] * t0[3]);
                    w.z = cvtpk(v1[0] * t1[0] - v1[1] * t1[1], v1[1] * t1[0] + v1[0] * t1[1]);
                    w.w = cvtpk(v1[2] * t1[2] - v1[3] * t1[3], v1[3] * t1[2] + v1[2] * t1[3]);
                    *(u32x4*)(rowp + bj * 128) = w;
                }
            }
        } else {
            EPI_FOR_ROWS {
                const int rl = ai * 128 + wr * 64 + m * 16 + fr;
                bf16_t* rowp = base + (size_t)(prow + rl) * DM + col0;
                EPI_FOR_BJ {
                    f32x4 v0 = acc[ai][bj][m][0], v1 = acc[ai][bj][m][1];
                    if (mode == 1) { v0 = v0 * sc; v1 = v1 * sc; }
                    else if (mode == 2) {
#pragma unroll
                        for (int e = 0; e < 4; ++e) { v0[e] = fast_silu(v0[e]); v1[e] = fast_silu(v1[e]); } }
                    else if (mode == 3) {
#pragma unroll
                        for (int e = 0; e < 4; ++e) { v0[e] = fast_gelu(v0[e]); v1[e] = fast_gelu(v1[e]); } }
                    else {
#pragma unroll
                        for (int e = 0; e < 4; ++e) { v0[e] = fast_sigmoid(v0[e]); v1[e] = fast_sigmoid(v1[e]); } }
                    u32x4 w; w.x = cvtpk(v0[0], v0[1]); w.y = cvtpk(v0[2], v0[3]); w.z = cvtpk(v1[0], v1[1]); w.w = cvtpk(v1[2], v1[3]);
                    *(u32x4*)(rowp + bj * 128) = w;
                }
            }
        }
        return false;
    }
};
struct EpiDual {
    const bf16_t* GR; const bf16_t* GS; bf16_t* MG;
    __device__ __forceinline__ bool operator()(EPI_ARGS) const {
        const int col0 = u.pn * 256 + wc * 32 + fq * 8;
        const size_t off0 = (size_t)(u.pm * 256 + wr * 64 + fr) * DM + col0;
        if (u.which == 0) {
#pragma unroll
            for (int ai = 0; ai < 2; ++ai) {
                u32x4 rw[4][2], sw[4][2];
#pragma unroll
                for (int m = 0; m < 4; ++m)
#pragma unroll
                    for (int bj = 0; bj < 2; ++bj) { const size_t off = off0 + (size_t)(ai * 128 + m * 16) * DM + bj * 128; rw[m][bj] = *(const u32x4*)(GR + off); sw[m][bj] = *(const u32x4*)(GS + off); }
                asm volatile("" ::: "memory");
#pragma unroll
                for (int m = 0; m < 4; ++m)
#pragma unroll
                    for (int bj = 0; bj < 2; ++bj)
#pragma unroll
                        for (int e = 0; e < 4; ++e) {
                            const float r0 = bflo(rw[m][bj][e]) * __builtin_amdgcn_rcpf(fmaxf(bflo(sw[m][bj][e]), 1e-30f)), r1 = bfhi(rw[m][bj][e]) * __builtin_amdgcn_rcpf(fmaxf(bfhi(sw[m][bj][e]), 1e-30f));
                            acc[ai][bj][m][e >> 1][(e & 1) * 2] *= r0; acc[ai][bj][m][e >> 1][(e & 1) * 2 + 1] *= r1; }
            }
            return true;
        }
#pragma unroll
        for (int ai = 0; ai < 2; ++ai) {
            u32x4 gw[4][2];
#pragma unroll
            for (int m = 0; m < 4; ++m)
#pragma unroll
                for (int bj = 0; bj < 2; ++bj) gw[m][bj] = *(const u32x4*)(GS + off0 + (size_t)(ai * 128 + m * 16) * DM + bj * 128);
            asm volatile("" ::: "memory");
#pragma unroll
            for (int m = 0; m < 4; ++m)
#pragma unroll
                for (int bj = 0; bj < 2; ++bj) {
                    const f32x4 v0 = acc[ai][bj][m][0], v1 = acc[ai][bj][m][1]; const u32x4 g = gw[m][bj];
                    u32x4 w; w.x = cvtpk(v0[0] * bflo(g.x), v0[1] * bfhi(g.x)); w.y = cvtpk(v0[2] * bflo(g.y), v0[3] * bfhi(g.y));
                    w.z = cvtpk(v1[0] * bflo(g.z), v1[1] * bfhi(g.z)); w.w = cvtpk(v1[2] * bflo(g.w), v1[3] * bfhi(g.w));
                    *(u32x4*)(MG + off0 + (size_t)(ai * 128 + m * 16) * DM + bj * 128) = w;
                }
            asm volatile("" ::: "memory");
        }
        return false;
    }
};
struct EpiRes {
    const float* res; const float* gate; float* out;
    __device__ __forceinline__ bool operator()(EPI_ARGS) const {
        const int col0 = u.pn * 256 + wc * 32 + fq * 8;
        const float* gp = gate + (size_t)(u.pm >> 3) * NMOD + col0;
        const size_t off0 = (size_t)(u.pm * 256 + wr * 64 + fr) * DM + col0;
        f32x4 g0[2], g1[2];
        EPI_FOR_BJ { g0[bj] = *(const f32x4*)(gp + bj * 128); g1[bj] = *(const f32x4*)(gp + bj * 128 + 4); }
#pragma unroll
        for (int ai = 0; ai < 2; ++ai) {
            f32x4 r0[4][2], r1[4][2];
#pragma unroll
            for (int m = 0; m < 4; ++m)
#pragma unroll
                for (int bj = 0; bj < 2; ++bj) { const float* p = res + off0 + (size_t)(ai * 128 + m * 16) * DM + bj * 128; r0[m][bj] = *(const f32x4*)p; r1[m][bj] = *(const f32x4*)(p + 4); }
            asm volatile("" ::: "memory");
#pragma unroll
            for (int m = 0; m < 4; ++m)
#pragma unroll
                for (int bj = 0; bj < 2; ++bj) { float* p = out + off0 + (size_t)(ai * 128 + m * 16) * DM + bj * 128;
                    *(f32x4*)p = r0[m][bj] + g0[bj] * acc[ai][bj][m][0]; *(f32x4*)(p + 4) = r1[m][bj] + g1[bj] * acc[ai][bj][m][1]; }
            asm volatile("" ::: "memory");
        }
        return false;
    }
};
struct EpiSwiglu {
    bf16_t* HID;
    __device__ __forceinline__ bool operator()(EPI_ARGS) const {
        const int col0 = u.pn * 128 + wc * 16 + fq * 4;
        EPI_FOR_ROWS {
            bf16_t* rowp = HID + (size_t)(u.pm * 256 + ai * 128 + wr * 64 + m * 16 + fr) * FF + col0;
            EPI_FOR_BJ {
                const f32x4 a = acc[ai][bj][m][0], b = acc[ai][bj][m][1];
                u32x2 w; w.x = cvtpk(fast_silu(a[0]) * b[0], fast_silu(a[1]) * b[1]); w.y = cvtpk(fast_silu(a[2]) * b[2], fast_silu(a[3]) * b[3]);
                *(u32x2*)(rowp + bj * 64) = w;
            }
        }
        return false;
    }
};

struct Args {
    const float *x, *c, *ctx, *c_ctx, *w_mod, *b_mod, *norm1_g, *w_in, *dec_f, *dec_b, *sg_ln_g, *sg_ln_b, *sg_w, *sg_b, *w_ret_o, *w_sg_o, *w_out, *norm2_g, *w_ffn_in, *w_ffn_out, *final_g;
    float* out; unsigned char* ws;
};

__device__ __forceinline__ int src_col(int kind, int n) {
    if (kind == 1) { if (n >= 4096) return n; const int cp = n & 255, half = cp >> 7, within = cp & 127; return (n & ~255) + half * 128 + (within & 1) * 64 + (within >> 1); }
    if (kind == 2) { const int grp = n >> 3, w = n & 7; return w < 4 ? grp * 4 + w : FF + grp * 4 + (w - 4); }
    return n;
}
__device__ __forceinline__ void transpose_item(const float* W, int K, int N, bf16_t* WT, int kind, LAS float* scr, int item, int lane) {
    const int nblk = N >> 6, kb = item / nblk, nb = item - kb * nblk, k0 = kb * 64, n0 = nb * 64;
    const float* src = W + (size_t)k0 * N + src_col(kind, n0 + lane);
#pragma unroll 8
    for (int i = 0; i < 64; ++i) scr[i * 65 + lane] = src[(size_t)i * N];
    asm volatile("s_waitcnt lgkmcnt(0)" ::: "memory");
    const int c = lane & 7;
#pragma unroll
    for (int j = 0; j < 8; ++j) { const int n = (lane >> 3) + 8 * j; const LAS float* s = scr + (8 * c) * 65 + n;
        u32x4 o; o.x = cvtpk(s[0 * 65], s[1 * 65]); o.y = cvtpk(s[2 * 65], s[3 * 65]); o.z = cvtpk(s[4 * 65], s[5 * 65]); o.w = cvtpk(s[6 * 65], s[7 * 65]);
        *(u32x4*)(WT + (size_t)(n0 + n) * K + k0 + 8 * c) = o; }
    asm volatile("s_waitcnt lgkmcnt(0)" ::: "memory");
}

__device__ __forceinline__ void p0_prologue(const Args& a, LAS unsigned char* lds, int tid, int wid, int lane, int G) {
    unsigned char* ws = a.ws;
    if ((int)blockIdx.x < 192) {
        LAS float* sl = (LAS float*)lds;
        LAS float* part = (LAS float*)(lds + 73728);
        for (int i = tid; i < 9 * DM; i += 512) { const float v = i < 8 * DM ? a.c[i] : a.c_ctx[i - 8 * DM]; sl[i] = fast_silu(v); }
        __syncthreads();
        const int n = blockIdx.x * 64 + lane;
        float accv[9];
#pragma unroll
        for (int r = 0; r < 9; ++r) accv[r] = 0.f;
        const float* wp = a.w_mod + (size_t)(wid * 256) * NMOD + n;
#pragma unroll 16
        for (int k = 0; k < 256; ++k) { const float wv = wp[(size_t)k * NMOD];
#pragma unroll
            for (int r = 0; r < 9; ++r) accv[r] += sl[r * DM + wid * 256 + k] * wv; }
#pragma unroll
        for (int r = 0; r < 9; ++r) part[(wid * 9 + r) * 64 + lane] = accv[r];
        __syncthreads();
        for (int i = tid; i < 9 * 64; i += 512) { const int r = i >> 6, cc = i & 63; float s = 0.f;
#pragma unroll
            for (int w = 0; w < 8; ++w) s += part[(w * 9 + r) * 64 + cc];
            ((float*)(ws + WS_MOD))[(size_t)r * NMOD + blockIdx.x * 64 + cc] = s + a.b_mod[blockIdx.x * 64 + cc]; }
        __syncthreads();
    } else if ((int)blockIdx.x == G - 1) {
        f32x2* tab = (f32x2*)(ws + WS_ROPE);
        for (int i = tid; i < 64 * 64; i += 512) { const int pos = i >> 6, f = i & 63; const float freq = exp2f(-(float)f * (13.287712379549449f / 64.0f)); const float ang = (float)pos * freq;
            tab[i] = (f32x2){cosf(ang), sinf(ang)}; }
    } else if ((int)blockIdx.x == G - 2) {
        bf16_t* sw = (bf16_t*)(ws + WS_SGW);
        for (int i = tid; i < 8 * 128 * 128 / 2; i += 512) ((unsigned*)sw)[i] = cvtpk(a.sg_w[2 * i], a.sg_w[2 * i + 1]);
    }
    LAS float* scr = (LAS float*)(lds + wid * 16640);
    const int gw = blockIdx.x * 8 + wid, NGW = G * 8;
    constexpr int I_IN = 32 * 256, I_SQ = 32 * 32, NITEMS = I_IN + 3 * I_SQ;
    const int nfree = G > 192 ? G - 192 : 0, E = nfree * 8 * 4 < NITEMS ? nfree * 8 * 4 : NITEMS;
    const bool isfree = (int)blockIdx.x >= 192;
    for (int it = isfree ? ((int)blockIdx.x - 192) * 8 + wid : E + gw; it < NITEMS; ) {
        int r = it;
        it = (it < E) ? ((it + nfree * 8 < E) ? it + nfree * 8 : E + gw) : it + NGW;
        if (r < I_IN) { transpose_item(a.w_in, DM, DIN, (bf16_t*)(ws + WS_WIN), 1, scr, r, lane); continue; } r -= I_IN;
        if (r < I_SQ) { transpose_item(a.w_ret_o, DM, DM, (bf16_t*)(ws + WS_W3), 0, scr, r, lane); continue; } r -= I_SQ;
        if (r < I_SQ) { transpose_item(a.w_sg_o, DM, DM, (bf16_t*)(ws + WS_W3 + 8 * MiB), 0, scr, r, lane); continue; } r -= I_SQ;
        transpose_item(a.w_out, DM, DM, (bf16_t*)(ws + WS_W3 + 16 * MiB), 0, scr, r, lane);
    }
}
__device__ __forceinline__ void convert_ffn(const Args& a, LAS unsigned char* lds, int cw, int ncw, int wid, int lane) {
    LAS float* scr = (LAS float*)(lds + wid * 16640);
    constexpr int I_F1 = 32 * 176, I_F2 = 88 * 32;
    for (int it = cw; it < I_F1 + I_F2; it += ncw) {
        if (it < I_F1) transpose_item(a.w_ffn_in, DM, 2 * FF, (bf16_t*)(a.ws + WS_WF1), 2, scr, it, lane);
        else transpose_item(a.w_ffn_out, FF, DM, (bf16_t*)(a.ws + WS_WF2), 0, scr, it - I_F1, lane);
    }
}

template <bool FINAL>
__device__ __forceinline__ void rows_phase(const float* srcL, const float* srcC, int nL, int nTot, const float* g, const float* mod, int sh_off, int sc_off, void* dst, int gw, int NGW, int lane) {
    asm volatile("" : "+v"(lane));
    const int per = (nTot + NGW - 1) / NGW; const int r0 = gw * per; int r1 = r0 + per; if (r1 > nTot) r1 = nTot;
    if (r0 >= r1) return;
    f32x4 v[8], A[8], B[8]; int cur = -1;
    { const float* p = (r0 < nL ? srcL + (size_t)r0 * DM : srcC + (size_t)(r0 - nL) * DM) + lane * 4;
#pragma unroll
      for (int j = 0; j < 8; ++j) v[j] = *(const f32x4*)(p + j * 256); }
#pragma unroll 1
    for (int row = r0; row < r1; ++row) {
        f32x4 vn[8];
        const bool more = row + 1 < r1;
        if (more) { const int rn = row + 1; const float* p = (rn < nL ? srcL + (size_t)rn * DM : srcC + (size_t)(rn - nL) * DM) + lane * 4;
#pragma unroll
            for (int j = 0; j < 8; ++j) vn[j] = *(const f32x4*)(p + j * 256); }
        const int mr = FINAL ? 0 : (row < nL ? (row >> 11) : 8);
        if (mr != cur) { cur = mr;
#pragma unroll
            for (int j = 0; j < 8; ++j) { const int o = j * 256 + lane * 4; const f32x4 gg = *(const f32x4*)(g + o);
                if (FINAL) { A[j] = gg; B[j] = (f32x4){0.f, 0.f, 0.f, 0.f}; }
                else { const float* mp = mod + (size_t)mr * NMOD + o; A[j] = gg * (*(const f32x4*)(mp + sc_off) + 1.0f); B[j] = *(const f32x4*)(mp + sh_off); } } }
        float ss = 0.f;
#pragma unroll
        for (int j = 0; j < 8; ++j) ss += (v[j][0] * v[j][0] + v[j][1] * v[j][1]) + (v[j][2] * v[j][2] + v[j][3] * v[j][3]);
        const float rstd = 1.0f / sqrtf(wave_sum(ss) * (1.0f / DM) + EPS);
#pragma unroll
        for (int j = 0; j < 8; ++j) { const int o = j * 256 + lane * 4;
            if (FINAL) *(f32x4*)((float*)dst + (size_t)row * DM + o) = v[j] * rstd * A[j];
            else { const f32x4 y = v[j] * rstd * A[j] + B[j]; u32x2 w; w.x = cvtpk(y[0], y[1]); w.y = cvtpk(y[2], y[3]); *(u32x2*)((bf16_t*)dst + (size_t)row * DM + o) = w; } }
        if (more) {
#pragma unroll
            for (int j = 0; j < 8; ++j) v[j] = vn[j]; }
    }
}

__device__ __forceinline__ s16x4 vtr(const LAS unsigned char* p) { return __builtin_bit_cast(s16x4, __builtin_amdgcn_ds_read_tr16_b64_v4i16((LAS v4i16_t*)p)); }
#define MFMA32(a, b, c) __builtin_amdgcn_mfma_f32_32x32x16_bf16((a), (b), (c), 0, 0, 0)

__device__ __forceinline__ void glds16(const void* gsrc, unsigned lds_dst) { unsigned keep;
    asm volatile("s_mov_b32 %0, m0\n\ts_mov_b32 m0, %2\n\ts_nop 0\n\tglobal_load_lds_dwordx4 %1, off\n\ts_mov_b32 m0, %0" : "=&s"(keep) : "v"(gsrc), "s"(lds_dst) : "memory"); }
template <bool ISV>
__device__ __forceinline__ void ret_issue(LAS unsigned char* dst, const bf16_t* T, int wid, int lane) {
    const int rsub = lane >> 5, pc = lane & 31;
    const unsigned d0 = (unsigned)(__UINTPTR_TYPE__)dst;
#pragma unroll
    for (int cc = 0; cc < 4; ++cc) {
        const int c = wid * 4 + cc, row = 2 * c + rsub;
        const int lc = ISV ? (pc ^ ((row & 3) << 2)) : (pc ^ (row & 15));
        glds16(T + (size_t)row * DM + lc * 8, (unsigned)__builtin_amdgcn_readfirstlane(d0 + c * 1024));
    }
}
struct RetC { const bf16_t *Kl0, *Vl0; float lf2, lb2, gi, gi8, gb, gb8; int iabs, qr0, r, h, hf, tq, vlane, myx, pbx, kend; };
template <bool PV, bool CTX>
__device__ __forceinline__ void ret_iter(LAS unsigned char* lds, const RetC& c, int kt, f32x16 (&O)[4], const bf16x8 (&qf)[16], int wid, int lane) {
    LAS unsigned char* xch = lds + LDS_XCH;
    asm volatile("s_waitcnt vmcnt(0) lgkmcnt(0)" ::: "memory");
    __builtin_amdgcn_s_barrier();
    asm volatile("" ::: "memory");
    if (kt + 1 < c.kend) { const int k1 = kt + 1; ret_issue<false>(lds + (k1 & 1) * 65536, c.Kl0 + (size_t)(k1 * 64) * DM, wid, lane); }
    if (kt < c.kend) ret_issue<true>(lds + 32768 + (kt & 1) * 65536, c.Vl0 + (size_t)(kt * 64) * DM, wid, lane);
    const LAS unsigned char* Kl = lds + (kt & 1) * 65536;
    int krow = 32 * c.hf + c.r; asm volatile("" : "+v"(krow));
    const LAS unsigned char* kb = Kl + krow * 512; const int cx = ((krow & 15) ^ c.h) << 4;
    f32x16 st;
#pragma unroll
    for (int i = 0; i < 16; ++i) st[i] = 0.f;
    bf16x8 kf[2][4];
#define RET_PIN asm volatile("" ::: "memory")
#define RET_SB __builtin_amdgcn_sched_barrier(0)
#define RET_KREAD(g) do { _Pragma("unroll") for (int j = 0; j < 4; ++j) kf[(g) & 1][j] = *(const LAS bf16x8*)(kb + ((32 * (4 * (g) + j)) ^ cx)); RET_PIN; } while (0)
#define RET_KMMA(g) do { _Pragma("unroll") for (int j = 0; j < 4; ++j) st = MFMA32(kf[(g) & 1][j], qf[4 * (g) + j], st); } while (0)
    RET_KREAD(0); RET_SB;
    RET_KREAD(1); RET_KMMA(0); RET_SB;
    RET_KREAD(2); RET_KMMA(1); RET_SB;
    RET_KREAD(3); RET_KMMA(2); RET_SB;
    if (PV) {
        const LAS unsigned char* Vl = lds + 32768 + ((kt + 1) & 1) * 65536;
        int vb = c.vlane; asm volatile("" : "+v"(vb));
        const LAS unsigned char* vbase = Vl + vb;
        const LAS unsigned char* pbase = xch + c.pbx;
        const int vo0 = ((0 ^ c.tq) & 3) << 6, vo1 = ((1 ^ c.tq) & 3) << 6, vo2 = ((2 ^ c.tq) & 3) << 6, vo3 = ((3 ^ c.tq) & 3) << 6;
        s16x4 vlo[2][4], vhi[2][4]; bf16x8 pf[2];
#define RET_VREAD(g) do { const LAS unsigned char* _p = vbase + ((g) * 16) * 512; pf[(g) & 1] = *(const LAS bf16x8*)(pbase + (g) * 1024); \
            vlo[(g) & 1][0] = vtr(_p + vo0); vhi[(g) & 1][0] = vtr(_p + vo0 + 4096); vlo[(g) & 1][1] = vtr(_p + vo1); vhi[(g) & 1][1] = vtr(_p + vo1 + 4096); \
            vlo[(g) & 1][2] = vtr(_p + vo2); vhi[(g) & 1][2] = vtr(_p + vo2 + 4096); vlo[(g) & 1][3] = vtr(_p + vo3); vhi[(g) & 1][3] = vtr(_p + vo3 + 4096); RET_PIN; } while (0)
#define RET_VMMA(g) do { _Pragma("unroll") for (int d = 0; d < 4; ++d) O[d] = MFMA32(pf[(g) & 1], __builtin_shufflevector(vlo[(g) & 1][d], vhi[(g) & 1][d], 0, 1, 2, 3, 4, 5, 6, 7), O[d]); } while (0)
        RET_VREAD(0); RET_KMMA(3); RET_SB;
        RET_VREAD(1); RET_VMMA(0); RET_SB;
        RET_VREAD(2); RET_VMMA(1); RET_SB;
        RET_VREAD(3); RET_VMMA(2); RET_SB;
        RET_VMMA(3); RET_SB;
#undef RET_VREAD
#undef RET_VMMA
    } else {
        RET_KMMA(3); RET_SB;
    }
#undef RET_KREAD
#undef RET_KMMA
#undef RET_SB
#undef RET_PIN
    {
        const int k0 = kt * 64 + 32 * c.hf;
        if (!CTX) {
            const int d0 = c.iabs - (k0 + 4 * c.h);
            if (k0 != c.qr0) {
                const bool fwd = c.qr0 > k0;
                const float m = fwd ? c.gi : c.gb, m8 = fwd ? c.gi8 : c.gb8;
                float w[4]; w[0] = __builtin_amdgcn_exp2f((float)d0 * (fwd ? c.lf2 : -c.lb2)); w[1] = w[0] * m; w[2] = w[1] * m; w[3] = w[2] * m;
#pragma unroll
                for (int q4 = 0; q4 < 4; ++q4) {
#pragma unroll
                    for (int e = 0; e < 4; ++e) { st[4 * q4 + e] *= w[e]; w[e] *= m8; } }
            } else {
#pragma unroll
                for (int i = 0; i < 16; ++i) { const int dist = d0 - ((i & 3) + 8 * (i >> 2)); const float fd = (float)dist; st[i] *= __builtin_amdgcn_exp2f(fd * (dist >= 0 ? c.lf2 : -c.lb2)); }
            }
        } else {
            const int l0 = (kt - 32) * 64 + 32 * c.hf + 4 * c.h;
            float wf[4], wb[4];
            wf[0] = __builtin_amdgcn_exp2f(c.lf2 * (float)(c.iabs + LCTX - l0)); wf[1] = wf[0] * c.gi; wf[2] = wf[1] * c.gi; wf[3] = wf[2] * c.gi;
            wb[0] = __builtin_amdgcn_exp2f(c.lb2 * (float)(SEQ + l0 - c.iabs)); wb[1] = wb[0] * c.gb; wb[2] = wb[1] * c.gb; wb[3] = wb[2] * c.gb;
#pragma unroll
            for (int q4 = 0; q4 < 4; ++q4) {
#pragma unroll
                for (int e = 0; e < 4; ++e) { st[4 * q4 + e] *= wf[e] + wb[e]; wf[e] *= c.gi8; wb[e] *= c.gb8; } }
        }
    }
    u32x4 p0, p1;
    p0.x = cvtpk(st[0], st[1]); p0.y = cvtpk(st[2], st[3]); p0.z = cvtpk(st[4], st[5]); p0.w = cvtpk(st[6], st[7]);
    p1.x = cvtpk(st[8], st[9]); p1.y = cvtpk(st[10], st[11]); p1.z = cvtpk(st[12], st[13]); p1.w = cvtpk(st[14], st[15]);
    asm volatile("s_waitcnt lgkmcnt(0)" ::: "memory");
    __builtin_amdgcn_s_barrier();
    asm volatile("" ::: "memory");
    *(LAS u32x4*)(xch + c.myx) = p0; *(LAS u32x4*)(xch + c.myx + 1024) = p1;
}

__device__ __forceinline__ void retention_unit(LAS unsigned char* lds, const Args& a, int b, int hh, int qb, int wid, int lane) {
    unsigned char* ws = a.ws;
    bf16_t* Qp = (bf16_t*)(ws + WS_Q); const bf16_t* Kp = (const bf16_t*)(ws + WS_K); const bf16_t* Vp = (const bf16_t*)(ws + WS_V);
    const bf16_t* Gp = (const bf16_t*)(ws + WS_G);
    asm volatile("" : "+v"(lane));
    const int r = lane & 31, h = lane >> 5, rg = wid >> 1, hf = wid & 1;
    const int ch = qb / (RCH / 128), kbeg = (RCH / 64) * ch;
    RetC c; c.kend = kbeg + RCH / 64;
    c.lf2 = -log1pf(expf(-a.dec_f[hh])) * 1.4426950408889634f; c.lb2 = -log1pf(expf(-a.dec_b[hh])) * 1.4426950408889634f;
    c.iabs = qb * 128 + rg * 32 + r; c.qr0 = qb * 128 + rg * 32; c.r = r; c.h = h; c.hf = hf;
    c.gi = exp2f(-c.lf2); { const float t2 = c.gi * c.gi, t4 = t2 * t2; c.gi8 = t4 * t4; } c.gb = exp2f(c.lb2); { const float t2 = c.gb * c.gb, t4 = t2 * t2; c.gb8 = t4 * t4; }
#define RET_UNI(x) x = __uint_as_float(__builtin_amdgcn_readfirstlane(__float_as_uint(x)))
    RET_UNI(c.lf2); RET_UNI(c.lb2); RET_UNI(c.gi); RET_UNI(c.gi8); RET_UNI(c.gb); RET_UNI(c.gb8);
#undef RET_UNI
    bf16x8 qf[16];
    { const bf16_t* qp = Qp + (size_t)(b * SEQ + c.iabs) * DM + hh * 256 + 8 * h;
#pragma unroll
      for (int s = 0; s < 16; ++s) qf[s] = *(const bf16x8*)(qp + 16 * s); }
    f32x16 O[4];
#pragma unroll
    for (int d = 0; d < 4; ++d)
#pragma unroll
        for (int i = 0; i < 16; ++i) O[d][i] = 0.f;
    c.Kl0 = Kp + (size_t)(b * SEQ) * DM + hh * 256; c.Vl0 = Vp + (size_t)(b * SEQ) * DM + hh * 256;
    const int tq = (lane & 15) >> 2, tp = lane & 3, g16 = (lane >> 4) & 1;
    c.tq = tq; c.vlane = (4 * h + tq) * 512 + (2 * g16 + (tp >> 1)) * 16 + (tp & 1) * 8 + hf * 256;
    c.myx = ((wid * 2) * 64 + lane) * 16; c.pbx = (((wid & ~1) * 2) * 64 + lane) * 16;
    ret_issue<false>(lds, c.Kl0 + (size_t)(kbeg * 64) * DM, wid, lane);
    ret_iter<false, false>(lds, c, kbeg, O, qf, wid, lane);
#pragma unroll 1
    for (int kt = kbeg + 1; kt <= kbeg + RCH / 64; ++kt) ret_iter<true, false>(lds, c, kt, O, qf, wid, lane);
    {
        const bf16_t* ST = (const bf16_t*)a.out + (size_t)MTOK * DM + (size_t)((b * 8 + hh) * 2 * NRCH) * 65536;
        const int g16 = (lane >> 4) & 1, tp = lane & 3, tq = c.tq;
        const unsigned l0 = (unsigned)(__UINTPTR_TYPE__)lds;
        const bf16_t* SF = ST + (size_t)ch * 65536; const bf16_t* SB = ST + (size_t)(NRCH + ch) * 65536;
        const float aqf = __builtin_amdgcn_exp2f(c.lf2 * (float)(c.iabs - RCH * ch + 1)), aqb = __builtin_amdgcn_exp2f(c.lb2 * (float)(RCH * (ch + 1) - c.iabs));
#define ST_ISSUE(S, half) do { const int row0 = 128 * (half) + 16 * wid + (lane >> 5), pc = lane & 31; const bf16_t* sp = (S) + (size_t)row0 * 256; unsigned ld = l0 + (half) * 65536 + wid * 8192; \
            _Pragma("unroll 1") for (int cc = 0; cc < 8; ++cc) { const int lc = pc ^ (((2 * cc + (lane >> 5)) & 3) << 2); glds16(sp + lc * 8, (unsigned)__builtin_amdgcn_readfirstlane(ld)); sp += 512; ld += 1024; } } while (0)
#define ST_WAIT(n) do { asm volatile("s_waitcnt vmcnt(" #n ")" ::: "memory"); __syncthreads(); } while (0)
#define ST_COMPUTE(aq, half) do { _Pragma("unroll") for (int s = 8 * (half); s < 8 * (half) + 8; ++s) { \
            const u32x4 qw = __builtin_bit_cast(u32x4, qf[s]); u32x4 pw; \
            pw.x = cvtpk(bflo(qw.x) * (aq), bfhi(qw.x) * (aq)); pw.y = cvtpk(bflo(qw.y) * (aq), bfhi(qw.y) * (aq)); \
            pw.z = cvtpk(bflo(qw.z) * (aq), bfhi(qw.z) * (aq)); pw.w = cvtpk(bflo(qw.w) * (aq), bfhi(qw.w) * (aq)); \
            const bf16x8 af = __builtin_bit_cast(bf16x8, pw); \
            const LAS unsigned char* vb = lds + (16 * s + 8 * h + tq) * 512 + (2 * g16 + (tp >> 1)) * 16 + (tp & 1) * 8; \
            _Pragma("unroll") for (int d = 0; d < 4; ++d) { const int blk = 4 * hf + d; \
                const LAS unsigned char* vp = vb + (((blk ^ tq) & 3) << 6) + (blk >> 2) * 256; \
                const s16x4 lo = vtr(vp), hi = vtr(vp + 4 * 512); \
                O[d] = MFMA32(af, __builtin_shufflevector(lo, hi, 0, 1, 2, 3, 4, 5, 6, 7), O[d]); } } } while (0)
        __syncthreads();
        ST_ISSUE(SF, 0); ST_ISSUE(SF, 1);
#pragma unroll 1
        for (int dir = 0; dir < 2; ++dir) {
            const float aq = dir ? aqb : aqf;
            ST_WAIT(8); ST_COMPUTE(aq, 0);
            __syncthreads(); if (dir == 0) ST_ISSUE(SB, 0);
            if (dir == 0) ST_WAIT(8); else ST_WAIT(0);
            ST_COMPUTE(aq, 1);
            __syncthreads(); if (dir == 0) ST_ISSUE(SB, 1);
        }
#undef ST_ISSUE
#undef ST_WAIT
#undef ST_COMPUTE
    }
    LAS float* xs = (LAS float*)(lds + LDS_XS);
    float rs[16];
#pragma unroll
    for (int i = 0; i < 16; ++i) { float s = 0.f;
#pragma unroll
        for (int d = 0; d < 4; ++d) s += O[d][i] * O[d][i];
        s += __shfl_xor(s, 1); s += __shfl_xor(s, 2); s += __shfl_xor(s, 4); s += __shfl_xor(s, 8); s += __shfl_xor(s, 16);
        rs[i] = s; if (r == 0) xs[wid * 32 + (i & 3) + 8 * (i >> 2) + 4 * h] = s; }
    __syncthreads();
#pragma unroll
    for (int i = 0; i < 16; ++i) { const float s = rs[i] + xs[(wid ^ 1) * 32 + (i & 3) + 8 * (i >> 2) + 4 * h]; rs[i] = 1.0f / sqrtf(s * (1.0f / 256.0f) + EPS); }
    const size_t obase = (size_t)(b * SEQ + qb * 128 + rg * 32 + 4 * h) * DM + hh * 256 + hf * 128 + r;
#pragma unroll
    for (int hh2 = 0; hh2 < 2; ++hh2) {
        bf16_t gv[8][4];
#pragma unroll
        for (int ii = 0; ii < 8; ++ii) { const int i = hh2 * 8 + ii; const size_t off = obase + (size_t)((i & 3) + 8 * (i >> 2)) * DM;
#pragma unroll
            for (int d = 0; d < 4; ++d) gv[ii][d] = Gp[off + 32 * d]; }
        asm volatile("" ::: "memory");
#pragma unroll
        for (int ii = 0; ii < 8; ++ii) { const int i = hh2 * 8 + ii; const size_t off = obase + (size_t)((i & 3) + 8 * (i >> 2)) * DM;
#pragma unroll
            for (int d = 0; d < 4; ++d) Qp[off + 32 * d] = (bf16_t)(cvtpk(O[d][i] * rs[i] * bf2f(gv[ii][d]), 0.f) & 0xffffu); }
        asm volatile("" ::: "memory");
    }
}

__device__ __forceinline__ void state_unit(LAS unsigned char* lds, const Args& a, int b, int hh, int dir, int eh, int wid, int lane) {
    unsigned char* ws = a.ws;
    asm volatile("" : "+v"(lane));
    const int r = lane & 31, h = lane >> 5, tq = (lane & 15) >> 2, tp = lane & 3, g16 = (lane >> 4) & 1;
    float lg2 = -log1pf(expf(-(dir ? a.dec_b[hh] : a.dec_f[hh]))) * 1.4426950408889634f;
    lg2 = __uint_as_float(__builtin_amdgcn_readfirstlane(__float_as_uint(lg2)));
    const float m = exp2f(dir ? lg2 : -lg2);
    const float gch = exp2f((float)RCH * lg2);
    const bf16_t* Kc = (const bf16_t*)(ws + WS_KC) + (size_t)(b * LCTX) * DM + hh * 256; const bf16_t* Vc = (const bf16_t*)(ws + WS_VC) + (size_t)(b * LCTX) * DM + hh * 256;
    const bf16_t* Kl = (const bf16_t*)(ws + WS_K) + (size_t)(b * SEQ) * DM + hh * 256; const bf16_t* Vl = (const bf16_t*)(ws + WS_V) + (size_t)(b * SEQ) * DM + hh * 256;
    bf16_t* ST = (bf16_t*)a.out + (size_t)MTOK * DM + (size_t)((b * 8 + hh) * 2 * NRCH) * 65536;
    constexpr int TPC = RCH / 64, NT = 4 + (NRCH - 1) * TPC;
#define ST_ROW(t_) ((t_) < 4 ? 0 : (dir ? (NRCH - 1 - ((t_) - 4) / TPC) : ((t_) - 4) / TPC) * RCH + (((t_) - 4) % TPC) * 64)
    f32x16 acc[4];
#pragma unroll
    for (int d = 0; d < 4; ++d)
#pragma unroll
        for (int i = 0; i < 16; ++i) acc[d][i] = 0.f;
    const int lanec = (2 * g16 + (tp >> 1)) * 16 + (tp & 1) * 8;
    ret_issue<true>(lds, Kc, wid, lane); ret_issue<true>(lds + 32768, Vc, wid, lane);
#pragma unroll 1
    for (int t = 0; t < NT; ++t) {
        asm volatile("s_waitcnt vmcnt(0) lgkmcnt(0)" ::: "memory");
        __builtin_amdgcn_s_barrier();
        asm volatile("" ::: "memory");
        if (t + 1 < NT) { const int t1 = t + 1; const bf16_t* kp = t1 < 4 ? Kc + (size_t)(t1 * 64) * DM : Kl + (size_t)ST_ROW(t1) * DM; const bf16_t* vp = t1 < 4 ? Vc + (size_t)(t1 * 64) * DM : Vl + (size_t)ST_ROW(t1) * DM;
            ret_issue<true>(lds + (t1 & 1) * 65536, kp, wid, lane); ret_issue<true>(lds + (t1 & 1) * 65536 + 32768, vp, wid, lane); }
        if (t >= 4 && (t - 4) % TPC == 0) {
            const int wi = (t - 4) / TPC; bf16_t* S = ST + (size_t)(dir ? NRCH + (NRCH - 1 - wi) : wi) * 65536;
#pragma unroll
            for (int d = 0; d < 4; ++d)
#pragma unroll
                for (int i = 0; i < 16; ++i) { S[(size_t)(32 * wid + (i & 3) + 8 * (i >> 2) + 4 * h) * 256 + 128 * eh + 32 * d + r] = (bf16_t)(cvtpk(acc[d][i], 0.f) & 0xffffu); acc[d][i] *= gch; }
        }
        const LAS unsigned char* Kt = lds + (t & 1) * 65536; const LAS unsigned char* Vt = Kt + 32768;
        const int p0 = (t < 4 ? 64 * t : 64 * ((t - 4) % TPC)) + 8 * h, last = t < 4 ? 255 : RCH - 1;
#pragma unroll
        for (int s = 0; s < 4; ++s) {
            const LAS unsigned char* kb = Kt + (16 * s + 8 * h + tq) * 512 + lanec + (((wid ^ tq) & 3) << 6) + (wid >> 2) * 256;
            const s16x4 klo = vtr(kb), khi = vtr(kb + 4 * 512);
            const int p = p0 + 16 * s;
            float w = __builtin_amdgcn_exp2f(lg2 * (float)(dir ? p : last - p));
            const u32x2 lw = __builtin_bit_cast(u32x2, klo), hw = __builtin_bit_cast(u32x2, khi);
            float kv[8] = {bflo(lw.x), bfhi(lw.x), bflo(lw.y), bfhi(lw.y), bflo(hw.x), bfhi(hw.x), bflo(hw.y), bfhi(hw.y)};
#pragma unroll
            for (int j = 0; j < 8; ++j) { kv[j] *= w; w *= m; }
            u32x4 pw; pw.x = cvtpk(kv[0], kv[1]); pw.y = cvtpk(kv[2], kv[3]); pw.z = cvtpk(kv[4], kv[5]); pw.w = cvtpk(kv[6], kv[7]);
            const bf16x8 af = __builtin_bit_cast(bf16x8, pw);
            const LAS unsigned char* vb = Vt + (16 * s + 8 * h + tq) * 512 + lanec;
#pragma unroll
            for (int d = 0; d < 4; ++d) { const int blk = 4 * eh + d;
                const LAS unsigned char* vp = vb + (((blk ^ tq) & 3) << 6) + (blk >> 2) * 256;
                const s16x4 lo = vtr(vp), hi = vtr(vp + 4 * 512);
                acc[d] = MFMA32(af, __builtin_shufflevector(lo, hi, 0, 1, 2, 3, 4, 5, 6, 7), acc[d]); }
        }
    }
    { bf16_t* S = ST + (size_t)(dir ? NRCH : NRCH - 1) * 65536;
#pragma unroll
      for (int d = 0; d < 4; ++d)
#pragma unroll
          for (int i = 0; i < 16; ++i) S[(size_t)(32 * wid + (i & 3) + 8 * (i >> 2) + 4 * h) * 256 + 128 * eh + 32 * d + r] = (bf16_t)(cvtpk(acc[d][i], 0.f) & 0xffffu); }
#undef ST_ROW
}

__device__ __forceinline__ void spatial_unit(LAS unsigned char* lds, const Args& a, int b, int n, int ghalf, int tid, int wid, int lane) {
    bf16_t* Up = (bf16_t*)a.out; const bf16_t* VSp = (const bf16_t*)a.out + (size_t)MTOK * DM;
    const bf16_t* Wb = (const bf16_t*)(a.ws + WS_SGW);
    asm volatile("" : "+v"(lane)); asm volatile("" : "+v"(tid));
    LAS f32x2* stats = (LAS f32x2*)(lds + LDS_STATS);
    const int tok0 = b * SEQ + n * 128;
#pragma unroll 1
    for (int t0 = wid * 16; t0 < wid * 16 + 16; t0 += 4) {
        u32x4 w[4][4];
#pragma unroll
        for (int tt = 0; tt < 4; ++tt)
#pragma unroll
            for (int j = 0; j < 4; ++j) w[tt][j] = *(const u32x4*)(VSp + (size_t)(tok0 + t0 + tt) * DM + j * 512 + lane * 8);
#pragma unroll
        for (int tt = 0; tt < 4; ++tt) { float s = 0.f, ss = 0.f;
#pragma unroll
            for (int j = 0; j < 4; ++j)
#pragma unroll
                for (int e = 0; e < 4; ++e) { const float x0 = bflo(w[tt][j][e]), x1 = bfhi(w[tt][j][e]); s += x0 + x1; ss += x0 * x0 + x1 * x1; }
            s = wave_sum(s); ss = wave_sum(ss);
            const float mean = s * (1.0f / DM); float var = ss * (1.0f / DM) - mean * mean; var = var > 0.f ? var : 0.f;
            if (lane == 0) stats[t0 + tt] = (f32x2){mean, 1.0f / sqrtf(var + EPS)}; }
    }
    __syncthreads();
    const int r = lane & 31, h = lane >> 5, ib = wid & 3, dbh = wid >> 2;
    const int tq = (lane & 15) >> 2, tp = lane & 3, g16 = (lane >> 4) & 1;
    for (int gi = 0; gi < 4; ++gi) {
        const int g = ghalf * 4 + gi;
        { const int lc = tid & 31, ch = g * 256 + lc * 8, row0 = tid >> 5;
          u32x4 w[8];
#pragma unroll
          for (int it = 0; it < 8; ++it) w[it] = *(const u32x4*)(VSp + (size_t)(tok0 + row0 + it * 16) * DM + ch);
          const f32x4 g0 = *(const f32x4*)(a.sg_ln_g + ch), g1 = *(const f32x4*)(a.sg_ln_g + ch + 4), b0 = *(const f32x4*)(a.sg_ln_b + ch), b1 = *(const f32x4*)(a.sg_ln_b + ch + 4);
#pragma unroll
          for (int it = 0; it < 8; ++it) { const int row = row0 + it * 16; const f32x2 st = stats[row];
            u32x4 o;
            o.x = cvtpk((bflo(w[it].x) - st.x) * st.y * g0[0] + b0[0], (bfhi(w[it].x) - st.x) * st.y * g0[1] + b0[1]);
            o.y = cvtpk((bflo(w[it].y) - st.x) * st.y * g0[2] + b0[2], (bfhi(w[it].y) - st.x) * st.y * g0[3] + b0[3]);
            o.z = cvtpk((bflo(w[it].z) - st.x) * st.y * g1[0] + b1[0], (bfhi(w[it].z) - st.x) * st.y * g1[1] + b1[1]);
            o.w = cvtpk((bflo(w[it].w) - st.x) * st.y * g1[2] + b1[2], (bfhi(w[it].w) - st.x) * st.y * g1[3] + b1[3]);
            *(LAS u32x4*)(lds + row * 512 + ((lc ^ ((row & 3) << 2)) << 4)) = o; } }
        __syncthreads();
        f32x16 acc[4];
#pragma unroll
        for (int d = 0; d < 4; ++d)
#pragma unroll
            for (int i = 0; i < 16; ++i) acc[d][i] = 0.f;
        const bf16_t* wrow = Wb + (size_t)g * 16384 + (size_t)(ib * 32 + r) * 128 + 8 * h;
        bf16x8 afr[8];
#pragma unroll
        for (int ks = 0; ks < 8; ++ks) afr[ks] = *(const bf16x8*)(wrow + 16 * ks);
#pragma unroll
        for (int ks = 0; ks < 8; ++ks) {
            const bf16x8 af = afr[ks];
            const LAS unsigned char* vb = lds + (16 * ks + 8 * h + tq) * 512 + (2 * g16 + (tp >> 1)) * 16 + (tp & 1) * 8;
#pragma unroll
            for (int d = 0; d < 4; ++d) { const int db = dbh * 4 + d;
                const LAS unsigned char* vp = vb + (((db ^ tq) & 3) << 6) + (db >> 2) * 256;
                const s16x4 lo = vtr(vp), hi = vtr(vp + 4 * 512);
                const bf16x8 bfr = __builtin_shufflevector(lo, hi, 0, 1, 2, 3, 4, 5, 6, 7);
                acc[d] = MFMA32(af, bfr, acc[d]); }
        }
#pragma unroll
        for (int hh2 = 0; hh2 < 2; ++hh2) {
            bf16_t uv[8][4]; float bias[8];
#pragma unroll
            for (int ii = 0; ii < 8; ++ii) { const int i = hh2 * 8 + ii, il = ib * 32 + (i & 3) + 8 * (i >> 2) + 4 * h; bias[ii] = a.sg_b[g * 128 + il];
                const size_t off = (size_t)(tok0 + il) * DM + g * 256 + dbh * 128 + r;
#pragma unroll
                for (int d = 0; d < 4; ++d) uv[ii][d] = Up[off + 32 * d]; }
            asm volatile("" ::: "memory");
#pragma unroll
            for (int ii = 0; ii < 8; ++ii) { const int i = hh2 * 8 + ii, il = ib * 32 + (i & 3) + 8 * (i >> 2) + 4 * h;
                const size_t off = (size_t)(tok0 + il) * DM + g * 256 + dbh * 128 + r;
#pragma unroll
                for (int d = 0; d < 4; ++d) Up[off + 32 * d] = (bf16_t)(cvtpk(bf2f(uv[ii][d]) * (acc[d][i] + bias[ii]), 0.f) & 0xffffu); }
            asm volatile("" ::: "memory");
        }
        __syncthreads();
    }
}

#define XB_TMO      128
#define XB_XCNT(j)  (256  + 64 * (j))
#define XB_XSUB(j)  (1280 + 64 * (j))
#define XB_XGEN(j)  (2304 + 64 * (j))
#define XB_TOP      3328
#define XB_TOPGEN   3392
#define XCD_BAR_WORDS 3456
#define XB_SPIN_CAP (1u << 22)
__device__ __forceinline__ unsigned xb_ld(unsigned* p)              { return __hip_atomic_load(p, __ATOMIC_RELAXED, __HIP_MEMORY_SCOPE_AGENT); }
__device__ __forceinline__ unsigned xb_add(unsigned* p, unsigned v) { return __hip_atomic_fetch_add(p, v, __ATOMIC_RELAXED, __HIP_MEMORY_SCOPE_AGENT); }
__device__ __forceinline__ unsigned xb_xcc_id() { return (unsigned)__builtin_amdgcn_s_getreg((3 << 11) | 20) & 0xFu; }
#define XB_SPIN(cond, bar) do { unsigned _sp = 0; while (cond) { __builtin_amdgcn_s_sleep(1); \
    if ((++_sp & 255u) == 0u) { if (xb_ld(&(bar)[XB_TMO])) break; if (_sp > XB_SPIN_CAP) { atomicAdd(&(bar)[XB_TMO], 1u); break; } } } } while (0)
struct XcdBarrier { unsigned* bar; unsigned x; volatile LAS unsigned* st; };
__device__ __forceinline__ XcdBarrier xcd_barrier_post(unsigned* bar, volatile LAS unsigned* st) {
    XcdBarrier b; b.bar = bar; b.x = xb_xcc_id(); b.st = st;
    if (threadIdx.x == 0) (void)xb_add(&bar[XB_XCNT(b.x)], 1u);
    return b;
}
__device__ __forceinline__ void xcd_barrier_complete(unsigned* bar, unsigned x, unsigned& nloc, unsigned& nx) {
    const unsigned G = gridDim.x * gridDim.y * gridDim.z;
    unsigned sum, cnt, mine, sp = 0u;
    for (;;) {
        sum = 0u; cnt = 0u; mine = 0u;
#pragma unroll
        for (unsigned j = 0; j < 16; ++j) { const unsigned c = xb_ld(&bar[XB_XCNT(j)]); sum += c; cnt += (c > 0u) ? 1u : 0u; mine = (j == x) ? c : mine; }
        if (sum == G) break;
        __builtin_amdgcn_s_sleep(1);
        if ((++sp & 255u) == 0u) { if (xb_ld(&bar[XB_TMO])) break; if (sp > XB_SPIN_CAP) { atomicAdd(&bar[XB_TMO], 1u); break; } }
    }
    nloc = mine > 0u ? mine : 1u; nx = cnt > 0u ? cnt : 1u;
}
__device__ __forceinline__ void xcd_barrier(const XcdBarrier& b) {
    asm volatile("s_waitcnt vmcnt(0)" ::: "memory");
    __syncthreads();
    if (threadIdx.x == 0) {
        unsigned* bar = b.bar;
        __builtin_amdgcn_s_waitcnt(0);
        unsigned nloc = b.st[0], nx = b.st[1];
        if (nloc == 0u) { xcd_barrier_complete(bar, b.x, nloc, nx); b.st[0] = nloc; b.st[1] = nx; }
        const unsigned old = xb_add(&bar[XB_XSUB(b.x)], 1u);
        const unsigned gen = old / nloc;
        if (old + 1u == (gen + 1u) * nloc) {
            __builtin_amdgcn_fence(__ATOMIC_RELEASE, "agent");
            asm volatile("s_waitcnt vmcnt(0)" ::: "memory");
            const unsigned og = xb_add(&bar[XB_TOP], 1u);
            const unsigned tg = og / nx;
            if (og + 1u == (tg + 1u) * nx) xb_add(&bar[XB_TOPGEN], 1u);
            else XB_SPIN(xb_ld(&bar[XB_TOPGEN]) == tg, bar);
            __builtin_amdgcn_fence(__ATOMIC_ACQUIRE, "agent");
            xb_add(&bar[XB_XGEN(b.x)], 1u);
            asm volatile("s_waitcnt vmcnt(0)" ::: "memory");
        } else {
            XB_SPIN(xb_ld(&bar[XB_XGEN(b.x)]) == gen, bar);
            __builtin_amdgcn_fence(__ATOMIC_ACQUIRE, "agent");
            asm volatile("s_waitcnt vmcnt(0)" ::: "memory");
        }
    }
    __syncthreads();
}

__global__ void __launch_bounds__(512, 2) fwd_megakernel(Args a) {
    extern __shared__ __attribute__((aligned(16))) unsigned char lds_raw[];
    LAS unsigned char* lds = (LAS unsigned char*)lds_raw;
    cg::grid_group grid = cg::this_grid();
    const int tid = threadIdx.x, wid = __builtin_amdgcn_readfirstlane(tid >> 6), lane = tid & 63;
    const int G = gridDim.x, bx = blockIdx.x;
    unsigned char* ws = a.ws;
    const float* MOD = (const float*)(ws + WS_MOD);
    const int gw = bx * 8 + wid, NGW = G * 8;

    if (tid < 4) ((LAS unsigned*)(lds + LDS_BARST))[tid] = 0u;
    __syncthreads();
    const XcdBarrier xbar = xcd_barrier_post((unsigned*)(ws + WS_BAR), (volatile LAS unsigned*)(lds + LDS_BARST));
#define GRID_BAR() xcd_barrier(xbar)
    if (a.dec_f[0] < -1e30f) grid.sync();
    p0_prologue(a, lds, tid, wid, lane, G);
    GRID_BAR();
    rows_phase<false>(a.x, a.ctx, MTOK, MTOK + MCTX, a.norm1_g, MOD, 0, DM, (void*)(ws + WS_H), gw, NGW, lane);
    GRID_BAR();
    {
        EpiIn E{(bf16_t*)(ws + WS_Q), (bf16_t*)(ws + WS_K), (bf16_t*)(ws + WS_V), (bf16_t*)(ws + WS_G), (bf16_t*)a.out, (bf16_t*)a.out + (size_t)MTOK * DM,
                (bf16_t*)(ws + WS_KC), (bf16_t*)(ws + WS_VC), (const f32x4*)(ws + WS_ROPE)};
        pg8::Gemm g{(const bf16_t*)(ws + WS_H), (const bf16_t*)(ws + WS_WIN), nullptr, nullptr, DM}; pg8::Order S; S.init(64, 48, 0, 128, G, bx);
        pg8::gemm_phase(lds, g, S, E);
        if (G == 256) { if (bx >= 128) convert_ffn(a, lds, (bx - 128) * 8 + wid, 128 * 8, wid, lane); }
        else convert_ffn(a, lds, gw, NGW, wid, lane);
    }
    GRID_BAR();
    for (int idx = bx; idx < 256; idx += G) { spatial_unit(lds, a, idx >> 5, (idx >> 1) & 15, idx & 1, tid, wid, lane); }
    GRID_BAR();
    for (int idx = bx; idx < 256; idx += G) { state_unit(lds, a, idx >> 5, (idx >> 2) & 7, (idx >> 1) & 1, idx & 1, wid, lane); __syncthreads(); }
    GRID_BAR();
    for (int i = 0; ; ++i) {
        int b, hh, qb;
        if (G == 256) { if (i >= 4) break; const int xcd = bx & 7, j = i * 32 + (bx >> 3); hh = xcd; b = j >> 4; qb = j & 15; }
        else { const int idx = i * G + bx; if (idx >= 1024) break; b = idx >> 7; hh = (idx >> 4) & 7; qb = idx & 15; }
        retention_unit(lds, a, b, hh, qb, wid, lane);
        __syncthreads();
    }
    GRID_BAR();
    {
        EpiIn E{(bf16_t*)(ws + WS_Q), (bf16_t*)(ws + WS_K), (bf16_t*)(ws + WS_V), (bf16_t*)(ws + WS_G), (bf16_t*)a.out, (bf16_t*)a.out + (size_t)MTOK * DM,
                (bf16_t*)(ws + WS_KC), (bf16_t*)(ws + WS_VC), (const f32x4*)(ws + WS_ROPE)};
        pg8::Gemm g{(const bf16_t*)(ws + WS_H), (const bf16_t*)(ws + WS_WIN), nullptr, nullptr, DM}; pg8::Order S; S.init(64, 16, 48, 0, G, bx);
        pg8::gemm_phase(lds, g, S, E);
    }
    GRID_BAR();
    {
        EpiDual E{(const bf16_t*)(ws + WS_K), (const bf16_t*)(ws + WS_V), (bf16_t*)(ws + WS_G)};
        pg8::Gemm g{(const bf16_t*)(ws + WS_Q), (const bf16_t*)(ws + WS_W3), (const bf16_t*)a.out, (const bf16_t*)(ws + WS_W3 + 8 * MiB), DM}; pg8::Order S; S.init(64, 8, 0, 0, G, bx, 1);
        pg8::gemm_phase(lds, g, S, E);
    }
    GRID_BAR();
    {
        EpiRes E{a.x, MOD + 2 * DM, a.out};
        pg8::Gemm g{(const bf16_t*)(ws + WS_G), (const bf16_t*)(ws + WS_W3 + 16 * MiB), nullptr, nullptr, DM}; pg8::Order S; S.init(64, 8, 0, 0, G, bx);
        pg8::gemm_phase(lds, g, S, E);
    }
    GRID_BAR();
    rows_phase<false>(a.out, a.out, MTOK, MTOK, a.norm2_g, MOD, 3 * DM, 4 * DM, (void*)(ws + WS_Q), gw, NGW, lane);
    GRID_BAR();
    {
        EpiSwiglu E{(bf16_t*)(ws + WS_HID)};
        pg8::Gemm g{(const bf16_t*)(ws + WS_Q), (const bf16_t*)(ws + WS_WF1), nullptr, nullptr, DM}; pg8::Order S; S.init(64, 44, 0, 0, G, bx);
        pg8::gemm_phase(lds, g, S, E);
    }
    GRID_BAR();
    {
        EpiRes E{a.out, MOD + 5 * DM, a.out};
        pg8::Gemm g{(const bf16_t*)(ws + WS_HID), (const bf16_t*)(ws + WS_WF2), nullptr, nullptr, FF}; pg8::Order S; S.init(64, 8, 0, 0, G, bx);
        pg8::gemm_phase(lds, g, S, E);
    }
    GRID_BAR();
    rows_phase<true>(a.out, a.out, MTOK, MTOK, a.final_g, MOD, 0, 0, (void*)a.out, gw, NGW, lane);
}

extern "C" void kernel_launch(void* const* d_in, const int* in_sizes, int n_in, void* d_out, int out_size, void* d_ws, size_t ws_size, hipStream_t stream) {
    static int grid_blocks = 0;
    if (grid_blocks == 0) {
        if (n_in != 21 || out_size != MTOK * DM || ws_size < WS_END) { fprintf(stderr, "kernel_launch: unexpected problem (n_in %d, out %d, ws %zu)\n", n_in, out_size, ws_size); grid_blocks = -1; return; }
        int dev = 0, cus = 0, per_cu = 0;
        hipGetDevice(&dev);
        hipDeviceGetAttribute(&cus, hipDeviceAttributeMultiprocessorCount, dev);
        if (hipFuncSetAttribute((const void*)fwd_megakernel, hipFuncAttributeMaxDynamicSharedMemorySize, LDS_BYTES) != hipSuccess) { fprintf(stderr, "kernel_launch: hipFuncSetAttribute failed\n"); grid_blocks = -1; return; }
        if (hipOccupancyMaxActiveBlocksPerMultiprocessor(&per_cu, (const void*)fwd_megakernel, 512, LDS_BYTES) != hipSuccess || per_cu < 1) { fprintf(stderr, "kernel_launch: occupancy query gave %d\n", per_cu); per_cu = 1; }
        (void)hipGetLastError();
        grid_blocks = cus * (per_cu > 1 ? 1 : per_cu);
        if (grid_blocks < 1) grid_blocks = 256;
    }
    if (grid_blocks < 0) return;
    if (hipMemsetAsync((char*)d_ws + WS_BAR, 0, XCD_BAR_WORDS * 4, stream) != hipSuccess) { fprintf(stderr, "kernel_launch: memset of the barrier words failed\n"); return; }
    Args a{};
    const float** pp = (const float**)&a;
    for (int i = 0; i < 21; ++i) pp[i] = (const float*)d_in[i];
    a.out = (float*)d_out; a.ws = (unsigned char*)d_ws;
    void* args[] = {&a};
    hipError_t e = hipLaunchCooperativeKernel((const void*)fwd_megakernel, dim3(grid_blocks), dim3(512), args, LDS_BYTES, stream);
    if (e != hipSuccess) fprintf(stderr, "cooperative launch failed: %s (grid %d)\n", hipGetErrorString(e), grid_blocks);
}
```

```cpp
#include <hip/hip_runtime.h>
#include <hip/hip_cooperative_groups.h>
#include <cstdio>
#include <cstdint>
namespace cg = cooperative_groups;

#define LAS __attribute__((address_space(3)))
typedef unsigned short bf16_t;
typedef short bf16x8 __attribute__((ext_vector_type(8)));
typedef short s16x4 __attribute__((ext_vector_type(4)));
typedef short v4i16_t __attribute__((ext_vector_type(4)));
typedef float f32x2 __attribute__((ext_vector_type(2)));
typedef float f32x4 __attribute__((ext_vector_type(4)));
typedef float f32x16 __attribute__((ext_vector_type(16)));
typedef unsigned u32x2 __attribute__((ext_vector_type(2)));
typedef unsigned u32x4 __attribute__((ext_vector_type(4)));
typedef __bf16 bf16x2_t __attribute__((ext_vector_type(2)));

constexpr int DM = 2048, NB = 8, SEQ = 2048, MTOK = NB * SEQ, LCTX = 256, MCTX = NB * LCTX, NH = 8, DIN = 16384, FF = 5632, NMOD = 12288;
constexpr float EPS = 1e-6f;
constexpr size_t MiB = 1u << 20;
constexpr size_t WS_MOD = 0, WS_ROPE = 512 * 1024, WS_SGW = 576 * 1024;
constexpr size_t WS_WF1 = 1 * MiB, WS_WF2 = 45 * MiB, WS_W3 = 67 * MiB, WS_Q = 91 * MiB, WS_WIN = 155 * MiB, WS_H = 219 * MiB, WS_K = 291 * MiB, WS_V = 355 * MiB,
                 WS_KC = 419 * MiB, WS_VC = 427 * MiB, WS_G = 435 * MiB, WS_END = 499 * MiB;
constexpr int RCH = 512, NRCH = SEQ / RCH;
constexpr size_t WS_T = WS_WIN, WS_HID = WS_WIN;
constexpr int LDS_BYTES = 153600;
constexpr int LDS_XCH = 131072, LDS_XS = 147456, LDS_STATS = 148480, LDS_BARST = 149504;
constexpr size_t WS_BAR = 896 * 1024;

__device__ __forceinline__ unsigned cvtpk(float lo, float hi) { f32x2 v = {lo, hi}; bf16x2_t b = __builtin_convertvector(v, bf16x2_t); return __builtin_bit_cast(unsigned, b); }
__device__ __forceinline__ float bflo(unsigned w) { return __uint_as_float(w << 16); }
__device__ __forceinline__ float bfhi(unsigned w) { return __uint_as_float(w & 0xffff0000u); }
__device__ __forceinline__ float bf2f(bf16_t b) { return __uint_as_float(((unsigned)b) << 16); }
__device__ __forceinline__ float fast_sigmoid(float x) { return __builtin_amdgcn_rcpf(1.0f + __builtin_amdgcn_exp2f(-1.4426950408889634f * x)); }
__device__ __forceinline__ float fast_silu(float x) { return x * fast_sigmoid(x); }
__device__ __forceinline__ float fast_gelu(float x) { const float z = 0.7978845608028654f * (x + 0.044715f * x * x * x); return x * fast_sigmoid(2.0f * z); }
__device__ __forceinline__ float wave_sum(float v) {
#pragma unroll
    for (int o = 1; o < 64; o <<= 1) v += __shfl_xor(v, o);
    return v;
}

namespace pg8 {
constexpr int BM = 256, BK = 64, HALF = 128, HTB = HALF * BK * 2, STAGE_BYTES = 8 * HTB, NXCD = 8, WGM = 4;
__host__ __device__ __forceinline__ int lds_byte(int r, int c) { const int st = (r >> 4) * 2 + (c >> 5), rr = r & 15, cc = c & 31, ob = rr * 64 + cc * 2; return st * 1024 + (ob ^ (((ob >> 9) & 1) << 5)); }
__host__ __device__ __forceinline__ void stage_rc(int b, int& R, int& C) { const int st = b / 1024, sb = b % 1024, swz = sb ^ (((sb >> 9) & 1) << 5); R = (st >> 1) * 16 + swz / 64; C = (st & 1) * 32 + (swz % 64) / 2; }
__host__ __device__ __forceinline__ int perm32(int rho) { const int n = rho >> 4, i = rho & 15; return 8 * (i >> 2) + 4 * n + (i & 3); }

struct Unit { int pm, pn, which; };
struct Gemm { const bf16_t* A; const bf16_t* Bt; const bf16_t* A2; const bf16_t* Bt2; int K; };

struct Order {
    int nM, nN, pn0, nwg, G, c, nextra, dual;
    __device__ void init(int nM_, int nN_, int pn0_, int nextra_, int G_, int c_, int dual_ = 0) { nM = nM_; nN = nN_; pn0 = pn0_; nwg = nM * nN; nextra = nextra_; G = G_; c = c_; dual = dual_; }
    __device__ bool next(int i, Unit& u) const {
        u.which = dual ? (i & 1) : 0; if (dual) i >>= 1;
        long L = (long)i * G + c;
        if (L < nwg) {
            int wgid = (int)L; { const int q = nwg / NXCD, r = nwg % NXCD, xcd = wgid % NXCD, off = wgid / NXCD; wgid = (xcd < r ? xcd * (q + 1) : r * (q + 1) + (xcd - r) * q) + off; }
            const int nig = WGM * nN, gid = wgid / nig, fm = gid * WGM, gsz = (nM - fm) < WGM ? (nM - fm) : WGM;
            u.pm = fm + ((wgid % nig) % gsz); u.pn = pn0 + (wgid % nig) / gsz; return true;
        }
        L -= nwg;
        if (L < nextra) { u.pm = 64 + (int)(L & 7); u.pn = 8 + (int)(L >> 3); return true; }
        return false;
    }
};

template <class Epi>
__device__ __forceinline__ void gemm_phase(LAS unsigned char* lds, const Gemm g, const Order& S, const Epi& E) {
    int tid_ = threadIdx.x; asm volatile("" : "+v"(tid_));
    const int tid = tid_, wid = __builtin_amdgcn_readfirstlane(tid >> 6), lane = tid & 63, wr = wid >> 2, wc = wid & 3, fr = lane & 15, fq = lane >> 4;
    const int K = g.K, nt = K / BK;
    unsigned voffA[2], voffB[2];
#pragma unroll
    for (int i = 0; i < 2; ++i) { int R, C; stage_rc(tid * 16 + i * 8192, R, C); const int Rb = (R & ~31) + perm32(R & 31);
        voffA[i] = (unsigned)(R * K + C) * 2u; voffB[i] = (unsigned)(Rb * K + C) * 2u; }
    const size_t kstep = (size_t)(BK * 2);
    const size_t hstep = (size_t)HALF * K * 2;
    const size_t tstep = 2 * hstep;
    const unsigned ldsw = (unsigned)wid * 1024u;
    const int aoff = lds_byte(wr * 64 + fr, fq * 8), boff = lds_byte(wc * 32 + fr, fq * 8);
#define PG8_SA(b, h) (((b) * 2 + (h)) * HTB)
#define PG8_SB(b, h) ((4 + (b) * 2 + (h)) * HTB)
#define PG8_STAGE(bufoff, gbase, voff) do { _Pragma("unroll") for (int _i = 0; _i < 2; ++_i) \
        __builtin_amdgcn_global_load_lds((const unsigned*)((const char*)(gbase) + (voff)[_i]), (LAS unsigned*)(lds + (bufoff) + ldsw + _i * 8192), 16, 0, 0); } while (0)
#define PG8_LDA(dst, b, h) do { _Pragma("unroll") for (int m = 0; m < 4; ++m) _Pragma("unroll") for (int k = 0; k < 2; ++k) dst[m][k] = *(const LAS bf16x8*)(lds + PG8_SA(b, h) + aoff + m * 2048 + k * 1024); } while (0)
#define PG8_LDB(dst, b, h) do { _Pragma("unroll") for (int n = 0; n < 2; ++n) _Pragma("unroll") for (int k = 0; k < 2; ++k) dst[n][k] = *(const LAS bf16x8*)(lds + PG8_SB(b, h) + boff + n * 2048 + k * 1024); } while (0)
#define PG8_MMA(ai, bj, At, Bt) do { __builtin_amdgcn_s_setprio(1); _Pragma("unroll") for (int m = 0; m < 4; ++m) _Pragma("unroll") for (int n = 0; n < 2; ++n) _Pragma("unroll") for (int k = 0; k < 2; ++k) \
        acc[ai][bj][m][n] = __builtin_amdgcn_mfma_f32_16x16x32_bf16(Bt[n][k], At[m][k], acc[ai][bj][m][n], 0, 0, 0); __builtin_amdgcn_s_setprio(0); } while (0)
#define PG8_WAIT_V(n) asm volatile("s_waitcnt vmcnt(" #n ")" ::: "memory")
#define PG8_WAIT_L(n) asm volatile("s_waitcnt lgkmcnt(" #n ")" ::: "memory")
#define PG8_BAR __builtin_amdgcn_s_barrier()
#define PG8_SCHED __builtin_amdgcn_sched_barrier(0)
    Unit cur, nxt; int ui = 0;
    if (!S.next(0, cur)) return;
    f32x4 acc[2][2][4][2];
#pragma unroll
    for (int a = 0; a < 2; ++a)
#pragma unroll
        for (int b = 0; b < 2; ++b)
#pragma unroll
            for (int m = 0; m < 4; ++m)
#pragma unroll
                for (int n = 0; n < 2; ++n) acc[a][b][m][n] = (f32x4){0.f, 0.f, 0.f, 0.f};
    bf16x8 At[4][2], B0[2][2], B1[2][2];
    const char* cA = (const char*)(cur.which ? g.A2 : g.A) + (size_t)cur.pm * tstep; const char* cB = (const char*)(cur.which ? g.Bt2 : g.Bt) + (size_t)cur.pn * tstep;
    PG8_STAGE(PG8_SB(0, 0), cB, voffB); PG8_STAGE(PG8_SB(0, 1), cB + hstep, voffB); PG8_STAGE(PG8_SA(0, 0), cA, voffA); PG8_STAGE(PG8_SA(0, 1), cA + hstep, voffA);
    if (wr == 1) PG8_BAR;
    PG8_WAIT_V(2); PG8_BAR;
    PG8_STAGE(PG8_SB(1, 0), cB + kstep, voffB); PG8_STAGE(PG8_SA(1, 0), cA + kstep, voffA); PG8_STAGE(PG8_SB(1, 1), cB + hstep + kstep, voffB);
    PG8_WAIT_V(6); PG8_BAR;
    for (;;) {
        const bool has_next = S.next(ui + 1, nxt);
        const char* nA = has_next ? (const char*)(nxt.which ? g.A2 : g.A) + (size_t)nxt.pm * tstep : cA; const char* nB = has_next ? (const char*)(nxt.which ? g.Bt2 : g.Bt) + (size_t)nxt.pn * tstep : cB;
        for (int t = 0; t < nt; t += 2) {
            const bool last = (t == nt - 2);
            const char* a1 = cA + (size_t)(t + 1) * kstep;
            const char* a2 = last ? nA : cA + (size_t)(t + 2) * kstep; const char* b2 = last ? nB : cB + (size_t)(t + 2) * kstep;
            const char* a3 = a2 + kstep; const char* b3 = b2 + kstep;
            PG8_LDB(B0, 0, 0); PG8_LDB(B1, 0, 1); PG8_SCHED; PG8_LDA(At, 0, 0); PG8_STAGE(PG8_SA(1, 1), a1 + hstep, voffA);
            PG8_WAIT_V(8); PG8_WAIT_L(0); PG8_BAR; PG8_MMA(0, 0, At, B0); PG8_MMA(0, 1, At, B1); PG8_BAR; PG8_SCHED;
            PG8_LDA(At, 0, 1); PG8_STAGE(PG8_SB(0, 0), b2, voffB); PG8_STAGE(PG8_SB(0, 1), b2 + hstep, voffB); PG8_STAGE(PG8_SA(0, 0), a2, voffA);
            PG8_WAIT_V(8); PG8_WAIT_L(0); PG8_BAR; PG8_MMA(1, 0, At, B0); PG8_MMA(1, 1, At, B1); PG8_BAR; PG8_SCHED;
            PG8_LDB(B0, 1, 0); PG8_LDB(B1, 1, 1); PG8_SCHED; PG8_LDA(At, 1, 0); PG8_STAGE(PG8_SA(0, 1), a2 + hstep, voffA);
            PG8_WAIT_V(8); PG8_WAIT_L(0); PG8_BAR; PG8_MMA(0, 0, At, B0); PG8_MMA(0, 1, At, B1); PG8_BAR; PG8_SCHED;
            PG8_LDA(At, 1, 1); PG8_STAGE(PG8_SB(1, 0), b3, voffB); PG8_STAGE(PG8_SB(1, 1), b3 + hstep, voffB); PG8_STAGE(PG8_SA(1, 0), a3, voffA);
            PG8_WAIT_V(8); PG8_WAIT_L(0); PG8_BAR; PG8_MMA(1, 0, At, B0); PG8_MMA(1, 1, At, B1); PG8_BAR; PG8_SCHED;
        }
        if (wr == 0) PG8_BAR;
        const bool keep = E(acc, cur, wr, wc, fr, fq);
        if (!has_next) break;
        if (!keep)
#pragma unroll
        for (int a = 0; a < 2; ++a)
#pragma unroll
            for (int b = 0; b < 2; ++b)
#pragma unroll
                for (int m = 0; m < 4; ++m)
#pragma unroll
                    for (int n = 0; n < 2; ++n) acc[a][b][m][n] = (f32x4){0.f, 0.f, 0.f, 0.f};
        cur = nxt; cA = nA; cB = nB; ++ui;
        if (wr == 1) PG8_BAR;
    }
    PG8_WAIT_V(0);
    PG8_BAR;
#undef PG8_SA
#undef PG8_SB
#undef PG8_STAGE
#undef PG8_LDA
#undef PG8_LDB
#undef PG8_MMA
#undef PG8_WAIT_V
#undef PG8_WAIT_L
#undef PG8_BAR
#undef PG8_SCHED
}
}
using pg8::Unit;

#define EPI_ARGS f32x4 (&acc)[2][2][4][2], const Unit& u, int wr, int wc, int fr, int fq
#define EPI_FOR_ROWS _Pragma("unroll") for (int ai = 0; ai < 2; ++ai) _Pragma("unroll") for (int m = 0; m < 4; ++m)
#define EPI_FOR_BJ _Pragma("unroll") for (int bj = 0; bj < 2; ++bj)

struct EpiIn {
    bf16_t *Q, *K, *V, *G, *U, *VS, *KC, *VC; const f32x4* rope;
    __device__ __forceinline__ bool operator()(EPI_ARGS) const {
        const int region = u.pn >> 3, hcol = (u.pn & 7) * 256;
        const bool isctx = u.pm >= 64;
        bf16_t* base; int mode; float sc = 1.0f;
        switch (region) {
            case 0: base = Q; mode = 0; break;
            case 1: base = isctx ? KC : K; mode = isctx ? 1 : 0; sc = 0.0625f; break;
            case 2: base = isctx ? VC : V; mode = 1; break;
            case 3: base = G; mode = 2; break;
            case 4: base = U; mode = 3; break;
            case 5: base = VS; mode = 3; break;
            case 6: base = K; mode = 4; break;
            default: base = V; mode = 4; break;
        }
        const int prow = isctx ? (u.pm - 64) * 256 : u.pm * 256;
        const int col0 = hcol + wc * 32 + fq * 8;
        if (mode == 0) {
            const int lbase = (u.pm & 7) * 256, tcol = wc * 8 + fq * 2;
            f32x4 tr[2][2], tc[4][2];
#pragma unroll
            for (int ai = 0; ai < 2; ++ai) { const int pos = (lbase + ai * 128 + wr * 64) >> 6; tr[ai][0] = rope[pos * 32 + tcol]; tr[ai][1] = rope[pos * 32 + tcol + 1]; }
#pragma unroll
            for (int m = 0; m < 4; ++m) { const int pos = m * 16 + fr; tc[m][0] = rope[pos * 32 + tcol]; tc[m][1] = rope[pos * 32 + tcol + 1]; }
            EPI_FOR_ROWS {
                const int rl = ai * 128 + wr * 64 + m * 16 + fr;
                bf16_t* rowp = base + (size_t)(prow + rl) * DM + col0;
                EPI_FOR_BJ {
                    const f32x4 t0 = bj == 0 ? tr[ai][0] : tc[m][0], t1 = bj == 0 ? tr[ai][1] : tc[m][1];
                    const f32x4 v0 = acc[ai][bj][m][0] * sc, v1 = acc[ai][bj][m][1] * sc;
                    u32x4 w;
                    w.x = cvtpk(v0[0] * t0[0] - v0[1] * t0[1], v0[1] * t0[0] + v0[0] * t0[1]);
                    w.y = cvtpk(v0[2] * t0[2] - v0[3] * t0[3], v0[3] * t0[2] + v0[2] * t0[3]);
                    w.z = cvtpk(v1[0] * t1[0] - v1[1] * t1[1], v1[1] * t1[0] + v1[0] * t1[1]);
                    w.w = cvtpk(v1[2] * t1[2] - v1[3] * t1[3], v1[3] * t1[2] + v1[2] * t1[3]);
                    *(u32x4*)(rowp + bj * 128) = w;
                }
            }
        } else {
            EPI_FOR_ROWS {
                const int rl = ai * 128 + wr * 64 + m * 16 + fr;
                bf16_t* rowp = base + (size_t)(prow + rl) * DM + col0;
                EPI_FOR_BJ {
                    f32x4 v0 = acc[ai][bj][m][0], v1 = acc[ai][bj][m][1];
                    if (mode == 1) { v0 = v0 * sc; v1 = v1 * sc; }
                    else if (mode == 2) {
#pragma unroll
                        for (int e = 0; e < 4; ++e) { v0[e] = fast_silu(v0[e]); v1[e] = fast_silu(v1[e]); } }
                    else if (mode == 3) {
#pragma unroll
                        for (int e = 0; e < 4; ++e) { v0[e] = fast_gelu(v0[e]); v1[e] = fast_gelu(v1[e]); } }
                    else {
#pragma unroll
                        for (int e = 0; e < 4; ++e) { v0[e] = fast_sigmoid(v0[e]); v1[e] = fast_sigmoid(v1[e]); } }
                    u32x4 w; w.x = cvtpk(v0[0], v0[1]); w.y = cvtpk(v0[2], v0[3]); w.z = cvtpk(v1[0], v1[1]); w.w = cvtpk(v1[2], v1[3]);
                    *(u32x4*)(rowp + bj * 128) = w;
                }
            }
        }
        return false;
    }
};
struct EpiDual {
    const bf16_t* GR; const bf16_t* GS; bf16_t* MG;
    __device__ __forceinline__ bool operator()(EPI_ARGS) const {
        const int col0 = u.pn * 256 + wc * 32 + fq * 8;
        const size_t off0 = (size_t)(u.pm * 256 + wr * 64 + fr) * DM + col0;
        if (u.which == 0) {
#pragma unroll
            for (int ai = 0; ai < 2; ++ai) {
                u32x4 rw[4][2], sw[4][2];
#pragma unroll
                for (int m = 0; m < 4; ++m)
#pragma unroll
                    for (int bj = 0; bj < 2; ++bj) { const size_t off = off0 + (size_t)(ai * 128 + m * 16) * DM + bj * 128; rw[m][bj] = *(const u32x4*)(GR + off); sw[m][bj] = *(const u32x4*)(GS + off); }
                asm volatile("" ::: "memory");
#pragma unroll
                for (int m = 0; m < 4; ++m)
#pragma unroll
                    for (int bj = 0; bj < 2; ++bj)
#pragma unroll
                        for (int e = 0; e < 4; ++e) {
                            const float r0 = bflo(rw[m][bj][e]) * __builtin_amdgcn_rcpf(fmaxf(bflo(sw[m][bj][e]), 1e-30f)), r1 = bfhi(rw[m][bj][e]) * __builtin_amdgcn_rcpf(fmaxf(bfhi(sw[m][bj][e]), 1e-30f));
                            acc[ai][bj][m][e >> 1][(e & 1) * 2] *= r0; acc[ai][bj][m][e >> 1][(e & 1) * 2 + 1] *= r1; }
            }
            return true;
        }
#pragma unroll
        for (int ai = 0; ai < 2; ++ai) {
            u32x4 gw[4][2];
#pragma unroll
            for (int m = 0; m < 4; ++m)
#pragma unroll
                for (int bj = 0; bj < 2; ++bj) gw[m][bj] = *(const u32x4*)(GS + off0 + (size_t)(ai * 128 + m * 16) * DM + bj * 128);
            asm volatile("" ::: "memory");
#pragma unroll
            for (int m = 0; m < 4; ++m)
#pragma unroll
                for (int bj = 0; bj < 2; ++bj) {
                    const f32x4 v0 = acc[ai][bj][m][0], v1 = acc[ai][bj][m][1]; const u32x4 g = gw[m][bj];
                    u32x4 w; w.x = cvtpk(v0[0] * bflo(g.x), v0[1] * bfhi(g.x)); w.y = cvtpk(v0[2] * bflo(g.y), v0[3] * bfhi(g.y));
                    w.z = cvtpk(v1[0] * bflo(g.z), v1[1] * bfhi(g.z)); w.w = cvtpk(v1[2] * bflo(g.w), v1[3] * bfhi(g.w));
                    *(u32x4*)(MG + off0 + (size_t)(ai * 128 + m * 16) * DM + bj * 128) = w;
                }
            asm volatile("" ::: "memory");
        }
        return false;
    }
};
struct EpiRes {
    const float* res; const float* gate; float* out;
    __device__ __forceinline__ bool operator()(EPI_ARGS) const {
        const int col0 = u.pn * 256 + wc * 32 + fq * 8;
        const float* gp = gate + (size_t)(u.pm >> 3) * NMOD + col0;
        const size_t off0 = (size_t)(u.pm * 256 + wr * 64 + fr) * DM + col0;
        f32x4 g0[2], g1[2];
        EPI_FOR_BJ { g0[bj] = *(const f32x4*)(gp + bj * 128); g1[bj] = *(const f32x4*)(gp + bj * 128 + 4); }
#pragma unroll
        for (int ai = 0; ai < 2; ++ai) {
            f32x4 r0[4][2], r1[4][2];
#pragma unroll
            for (int m = 0; m < 4; ++m)
#pragma unroll
                for (int bj = 0; bj < 2; ++bj) { const float* p = res + off0 + (size_t)(ai * 128 + m * 16) * DM + bj * 128; r0[m][bj] = *(const f32x4*)p; r1[m][bj] = *(const f32x4*)(p + 4); }
            asm volatile("" ::: "memory");
#pragma unroll
            for (int m = 0; m < 4; ++m)
#pragma unroll
                for (int bj = 0; bj < 2; ++bj) { float* p = out + off0 + (size_t)(ai * 128 + m * 16) * DM + bj * 128;
                    *(f32x4*)p = r0[m][bj] + g0[bj] * acc[ai][bj][m][0]; *(f32x4*)(p + 4) = r1[m][bj] + g1[bj] * acc[ai][bj][m][1]; }
            asm volatile("" ::: "memory");
        }
        return false;
    }
};
struct EpiSwiglu {
    bf16_t* HID;
    __device__ __forceinline__ bool operator()(EPI_ARGS) const {
        const int col0 = u.pn * 128 + wc * 32 + fq * 8;
        EPI_FOR_ROWS {
            const f32x4 a0 = acc[ai][0][m][0], a1 = acc[ai][0][m][1], b0 = acc[ai][1][m][0], b1 = acc[ai][1][m][1];
            u32x4 w; w.x = cvtpk(fast_silu(a0[0]) * b0[0], fast_silu(a0[1]) * b0[1]); w.y = cvtpk(fast_silu(a0[2]) * b0[2], fast_silu(a0[3]) * b0[3]);
            w.z = cvtpk(fast_silu(a1[0]) * b1[0], fast_silu(a1[1]) * b1[1]); w.w = cvtpk(fast_silu(a1[2]) * b1[2], fast_silu(a1[3]) * b1[3]);
            *(u32x4*)(HID + (size_t)(u.pm * 256 + ai * 128 + wr * 64 + m * 16 + fr) * FF + col0) = w;
        }
        return false;
    }
};

struct Args {
    const float *x, *c, *ctx, *c_ctx, *w_mod, *b_mod, *norm1_g, *w_in, *dec_f, *dec_b, *sg_ln_g, *sg_ln_b, *sg_w, *sg_b, *w_ret_o, *w_sg_o, *w_out, *norm2_g, *w_ffn_in, *w_ffn_out, *final_g;
    float* out; unsigned char* ws;
};

__device__ __forceinline__ int src_col(int kind, int n) {
    if (kind == 1) { if (n >= 4096) return n; const int cp = n & 255, half = cp >> 7, within = cp & 127; return (n & ~255) + half * 128 + (within & 1) * 64 + (within >> 1); }
    if (kind == 2) { const int j = (n >> 8) * 128 + (n & 127); return (n & 128) ? FF + j : j; }
    return n;
}
__device__ __forceinline__ void transpose_item(const float* W, int K, int N, bf16_t* WT, int kind, LAS float* scr, int item, int lane) {
    const int nblk = N >> 6, kb = item / nblk, nb = item - kb * nblk, k0 = kb * 64, n0 = nb * 64;
    const float* src = W + (size_t)k0 * N + src_col(kind, n0 + lane);
#pragma unroll 8
    for (int i = 0; i < 64; ++i) scr[i * 65 + lane] = src[(size_t)i * N];
    asm volatile("s_waitcnt lgkmcnt(0)" ::: "memory");
    const int c = lane & 7;
#pragma unroll
    for (int j = 0; j < 8; ++j) { const int n = (lane >> 3) + 8 * j; const LAS float* s = scr + (8 * c) * 65 + n;
        u32x4 o; o.x = cvtpk(s[0 * 65], s[1 * 65]); o.y = cvtpk(s[2 * 65], s[3 * 65]); o.z = cvtpk(s[4 * 65], s[5 * 65]); o.w = cvtpk(s[6 * 65], s[7 * 65]);
        *(u32x4*)(WT + (size_t)(n0 + n) * K + k0 + 8 * c) = o; }
    asm volatile("s_waitcnt lgkmcnt(0)" ::: "memory");
}

__device__ __forceinline__ void p0_prologue(const Args& a, LAS unsigned char* lds, int tid, int wid, int lane, int G) {
    unsigned char* ws = a.ws;
    if ((int)blockIdx.x < 192) {
        LAS float* sl = (LAS float*)lds;
        LAS float* part = (LAS float*)(lds + 73728);
        for (int i = tid; i < 9 * DM; i += 512) { const float v = i < 8 * DM ? a.c[i] : a.c_ctx[i - 8 * DM]; sl[i] = fast_silu(v); }
        __syncthreads();
        const int n = blockIdx.x * 64 + lane;
        float accv[9];
#pragma unroll
        for (int r = 0; r < 9; ++r) accv[r] = 0.f;
        const float* wp = a.w_mod + (size_t)(wid * 256) * NMOD + n;
#pragma unroll 16
        for (int k = 0; k < 256; ++k) { const float wv = wp[(size_t)k * NMOD];
#pragma unroll
            for (int r = 0; r < 9; ++r) accv[r] += sl[r * DM + wid * 256 + k] * wv; }
#pragma unroll
        for (int r = 0; r < 9; ++r) part[(wid * 9 + r) * 64 + lane] = accv[r];
        __syncthreads();
        for (int i = tid; i < 9 * 64; i += 512) { const int r = i >> 6, cc = i & 63; float s = 0.f;
#pragma unroll
            for (int w = 0; w < 8; ++w) s += part[(w * 9 + r) * 64 + cc];
            ((float*)(ws + WS_MOD))[(size_t)r * NMOD + blockIdx.x * 64 + cc] = s + a.b_mod[blockIdx.x * 64 + cc]; }
        __syncthreads();
    } else if ((int)blockIdx.x == G - 1) {
        f32x2* tab = (f32x2*)(ws + WS_ROPE);
        for (int i = tid; i < 64 * 64; i += 512) { const int pos = i >> 6, f = i & 63; const float freq = exp2f(-(float)f * (13.287712379549449f / 64.0f)); const float ang = (float)pos * freq;
            tab[i] = (f32x2){cosf(ang), sinf(ang)}; }
    } else if ((int)blockIdx.x == G - 2) {
        bf16_t* sw = (bf16_t*)(ws + WS_SGW);
        for (int i = tid; i < 8 * 128 * 128 / 2; i += 512) ((unsigned*)sw)[i] = cvtpk(a.sg_w[2 * i], a.sg_w[2 * i + 1]);
    }
    LAS float* scr = (LAS float*)(lds + wid * 16640);
    const int gw = blockIdx.x * 8 + wid, NGW = G * 8;
    constexpr int I_IN = 32 * 256, I_SQ = 32 * 32, NITEMS = I_IN + 3 * I_SQ;
    const int nfree = G > 192 ? G - 192 : 0, E = nfree * 8 * 4 < NITEMS ? nfree * 8 * 4 : NITEMS;
    const bool isfree = (int)blockIdx.x >= 192;
    for (int it = isfree ? ((int)blockIdx.x - 192) * 8 + wid : E + gw; it < NITEMS; ) {
        int r = it;
        it = (it < E) ? ((it + nfree * 8 < E) ? it + nfree * 8 : E + gw) : it + NGW;
        if (r < I_IN) { transpose_item(a.w_in, DM, DIN, (bf16_t*)(ws + WS_WIN), 1, scr, r, lane); continue; } r -= I_IN;
        if (r < I_SQ) { transpose_item(a.w_ret_o, DM, DM, (bf16_t*)(ws + WS_W3), 0, scr, r, lane); continue; } r -= I_SQ;
        if (r < I_SQ) { transpose_item(a.w_sg_o, DM, DM, (bf16_t*)(ws + WS_W3 + 8 * MiB), 0, scr, r, lane); continue; } r -= I_SQ;
        transpose_item(a.w_out, DM, DM, (bf16_t*)(ws + WS_W3 + 16 * MiB), 0, scr, r, lane);
    }
}
__device__ __forceinline__ void convert_ffn(const Args& a, LAS unsigned char* lds, int cw, int ncw, int wid, int lane) {
    LAS float* scr = (LAS float*)(lds + wid * 16640);
    constexpr int I_F1 = 32 * 176, I_F2 = 88 * 32;
    for (int it = cw; it < I_F1 + I_F2; it += ncw) {
        if (it < I_F1) transpose_item(a.w_ffn_in, DM, 2 * FF, (bf16_t*)(a.ws + WS_WF1), 2, scr, it, lane);
        else transpose_item(a.w_ffn_out, FF, DM, (bf16_t*)(a.ws + WS_WF2), 0, scr, it - I_F1, lane);
    }
}

template <bool FINAL>
__device__ __forceinline__ void rows_phase(const float* srcL, const float* srcC, int nL, int nTot, const float* g, const float* mod, int sh_off, int sc_off, void* dst, int gw, int NGW, int lane) {
    asm volatile("" : "+v"(lane));
    const int per = (nTot + NGW - 1) / NGW; const int r0 = gw * per; int r1 = r0 + per; if (r1 > nTot) r1 = nTot;
    if (r0 >= r1) return;
    f32x4 v[8], A[8], B[8]; int cur = -1;
    { const float* p = (r0 < nL ? srcL + (size_t)r0 * DM : srcC + (size_t)(r0 - nL) * DM) + lane * 4;
#pragma unroll
      for (int j = 0; j < 8; ++j) v[j] = *(const f32x4*)(p + j * 256); }
#pragma unroll 1
    for (int row = r0; row < r1; ++row) {
        f32x4 vn[8];
        const bool more = row + 1 < r1;
        if (more) { const int rn = row + 1; const float* p = (rn < nL ? srcL + (size_t)rn * DM : srcC + (size_t)(rn - nL) * DM) + lane * 4;
#pragma unroll
            for (int j = 0; j < 8; ++j) vn[j] = *(const f32x4*)(p + j * 256); }
        const int mr = FINAL ? 0 : (row < nL ? (row >> 11) : 8);
        if (mr != cur) { cur = mr;
#pragma unroll
            for (int j = 0; j < 8; ++j) { const int o = j * 256 + lane * 4; const f32x4 gg = *(const f32x4*)(g + o);
                if (FINAL) { A[j] = gg; B[j] = (f32x4){0.f, 0.f, 0.f, 0.f}; }
                else { const float* mp = mod + (size_t)mr * NMOD + o; A[j] = gg * (*(const f32x4*)(mp + sc_off) + 1.0f); B[j] = *(const f32x4*)(mp + sh_off); } } }
        float ss = 0.f;
#pragma unroll
        for (int j = 0; j < 8; ++j) ss += (v[j][0] * v[j][0] + v[j][1] * v[j][1]) + (v[j][2] * v[j][2] + v[j][3] * v[j][3]);
        const float rstd = 1.0f / sqrtf(wave_sum(ss) * (1.0f / DM) + EPS);
#pragma unroll
        for (int j = 0; j < 8; ++j) { const int o = j * 256 + lane * 4;
            if (FINAL) *(f32x4*)((float*)dst + (size_t)row * DM + o) = v[j] * rstd * A[j];
            else { const f32x4 y = v[j] * rstd * A[j] + B[j]; u32x2 w; w.x = cvtpk(y[0], y[1]); w.y = cvtpk(y[2], y[3]); *(u32x2*)((bf16_t*)dst + (size_t)row * DM + o) = w; } }
        if (more) {
#pragma unroll
            for (int j = 0; j < 8; ++j) v[j] = vn[j]; }
    }
}

__device__ __forceinline__ s16x4 vtr(const LAS unsigned char* p) { return __builtin_bit_cast(s16x4, __builtin_amdgcn_ds_read_tr16_b64_v4i16((LAS v4i16_t*)p)); }
#define MFMA32(a, b, c) __builtin_amdgcn_mfma_f32_32x32x16_bf16((a), (b), (c), 0, 0, 0)

__device__ __forceinline__ void glds16(const void* gsrc, unsigned lds_dst) { unsigned keep;
    asm volatile("s_mov_b32 %0, m0\n\ts_mov_b32 m0, %2\n\ts_nop 0\n\tglobal_load_lds_dwordx4 %1, off\n\ts_mov_b32 m0, %0" : "=&s"(keep) : "v"(gsrc), "s"(lds_dst) : "memory"); }
template <bool ISV>
__device__ __forceinline__ void ret_issue(LAS unsigned char* dst, const bf16_t* T, int wid, int lane) {
    const int rsub = lane >> 5, pc = lane & 31;
    const unsigned d0 = (unsigned)(__UINTPTR_TYPE__)dst;
#pragma unroll
    for (int cc = 0; cc < 4; ++cc) {
        const int c = wid * 4 + cc, row = 2 * c + rsub;
        const int lc = ISV ? (pc ^ ((row & 3) << 2)) : (pc ^ (row & 15));
        glds16(T + (size_t)row * DM + lc * 8, (unsigned)__builtin_amdgcn_readfirstlane(d0 + c * 1024));
    }
}
struct RetC { const bf16_t *Kl0, *Vl0; float lf2, lb2, gi, gi8, gb, gb8; int iabs, qr0, r, h, hf, tq, vlane, myx, pbx, kend; };
template <bool PV, bool CTX>
__device__ __forceinline__ void ret_iter(LAS unsigned char* lds, const RetC& c, int kt, f32x16 (&O)[4], const bf16x8 (&qf)[16], int wid, int lane) {
    LAS unsigned char* xch = lds + LDS_XCH;
    asm volatile("s_waitcnt vmcnt(0) lgkmcnt(0)" ::: "memory");
    __builtin_amdgcn_s_barrier();
    asm volatile("" ::: "memory");
    if (kt + 1 < c.kend) { const int k1 = kt + 1; ret_issue<false>(lds + (k1 & 1) * 65536, c.Kl0 + (size_t)(k1 * 64) * DM, wid, lane); }
    if (kt < c.kend) ret_issue<true>(lds + 32768 + (kt & 1) * 65536, c.Vl0 + (size_t)(kt * 64) * DM, wid, lane);
    const LAS unsigned char* Kl = lds + (kt & 1) * 65536;
    int krow = 32 * c.hf + c.r; asm volatile("" : "+v"(krow));
    const LAS unsigned char* kb = Kl + krow * 512; const int cx = ((krow & 15) ^ c.h) << 4;
    f32x16 st;
#pragma unroll
    for (int i = 0; i < 16; ++i) st[i] = 0.f;
    bf16x8 kf[2][4];
#define RET_PIN asm volatile("" ::: "memory")
#define RET_SB __builtin_amdgcn_sched_barrier(0)
#define RET_KREAD(g) do { _Pragma("unroll") for (int j = 0; j < 4; ++j) kf[(g) & 1][j] = *(const LAS bf16x8*)(kb + ((32 * (4 * (g) + j)) ^ cx)); RET_PIN; } while (0)
#define RET_KMMA(g) do { _Pragma("unroll") for (int j = 0; j < 4; ++j) st = MFMA32(kf[(g) & 1][j], qf[4 * (g) + j], st); } while (0)
    RET_KREAD(0); RET_SB;
    RET_KREAD(1); RET_KMMA(0); RET_SB;
    RET_KREAD(2); RET_KMMA(1); RET_SB;
    RET_KREAD(3); RET_KMMA(2); RET_SB;
    if (PV) {
        const LAS unsigned char* Vl = lds + 32768 + ((kt + 1) & 1) * 65536;
        int vb = c.vlane; asm volatile("" : "+v"(vb));
        const LAS unsigned char* vbase = Vl + vb;
        const LAS unsigned char* pbase = xch + c.pbx;
        const int vo0 = ((0 ^ c.tq) & 3) << 6, vo1 = ((1 ^ c.tq) & 3) << 6, vo2 = ((2 ^ c.tq) & 3) << 6, vo3 = ((3 ^ c.tq) & 3) << 6;
        s16x4 vlo[2][4], vhi[2][4]; bf16x8 pf[2];
#define RET_VREAD(g) do { const LAS unsigned char* _p = vbase + ((g) * 16) * 512; pf[(g) & 1] = *(const LAS bf16x8*)(pbase + (g) * 1024); \
            vlo[(g) & 1][0] = vtr(_p + vo0); vhi[(g) & 1][0] = vtr(_p + vo0 + 4096); vlo[(g) & 1][1] = vtr(_p + vo1); vhi[(g) & 1][1] = vtr(_p + vo1 + 4096); \
            vlo[(g) & 1][2] = vtr(_p + vo2); vhi[(g) & 1][2] = vtr(_p + vo2 + 4096); vlo[(g) & 1][3] = vtr(_p + vo3); vhi[(g) & 1][3] = vtr(_p + vo3 + 4096); RET_PIN; } while (0)
#define RET_VMMA(g) do { _Pragma("unroll") for (int d = 0; d < 4; ++d) O[d] = MFMA32(pf[(g) & 1], __builtin_shufflevector(vlo[(g) & 1][d], vhi[(g) & 1][d], 0, 1, 2, 3, 4, 5, 6, 7), O[d]); } while (0)
        RET_VREAD(0); RET_KMMA(3); RET_SB;
        RET_VREAD(1); RET_VMMA(0); RET_SB;
        RET_VREAD(2); RET_VMMA(1); RET_SB;
        RET_VREAD(3); RET_VMMA(2); RET_SB;
        RET_VMMA(3); RET_SB;
#undef RET_VREAD
#undef RET_VMMA
    } else {
        RET_KMMA(3); RET_SB;
    }
#undef RET_KREAD
#undef RET_KMMA
#undef RET_SB
#undef RET_PIN
    {
        const int k0 = kt * 64 + 32 * c.hf;
        if (!CTX) {
            const int d0 = c.iabs - (k0 + 4 * c.h);
            if (k0 != c.qr0) {
                const bool fwd = c.qr0 > k0;
                const float m = fwd ? c.gi : c.gb, m8 = fwd ? c.gi8 : c.gb8;
                float w[4]; w[0] = __builtin_amdgcn_exp2f((float)d0 * (fwd ? c.lf2 : -c.lb2)); w[1] = w[0] * m; w[2] = w[1] * m; w[3] = w[2] * m;
#pragma unroll
                for (int q4 = 0; q4 < 4; ++q4) {
#pragma unroll
                    for (int e = 0; e < 4; ++e) { st[4 * q4 + e] *= w[e]; w[e] *= m8; } }
            } else {
#pragma unroll
                for (int i = 0; i < 16; ++i) { const int dist = d0 - ((i & 3) + 8 * (i >> 2)); const float fd = (float)dist; st[i] *= __builtin_amdgcn_exp2f(fd * (dist >= 0 ? c.lf2 : -c.lb2)); }
            }
        } else {
            const int l0 = (kt - 32) * 64 + 32 * c.hf + 4 * c.h;
            float wf[4], wb[4];
            wf[0] = __builtin_amdgcn_exp2f(c.lf2 * (float)(c.iabs + LCTX - l0)); wf[1] = wf[0] * c.gi; wf[2] = wf[1] * c.gi; wf[3] = wf[2] * c.gi;
            wb[0] = __builtin_amdgcn_exp2f(c.lb2 * (float)(SEQ + l0 - c.iabs)); wb[1] = wb[0] * c.gb; wb[2] = wb[1] * c.gb; wb[3] = wb[2] * c.gb;
#pragma unroll
            for (int q4 = 0; q4 < 4; ++q4) {
#pragma unroll
                for (int e = 0; e < 4; ++e) { st[4 * q4 + e] *= wf[e] + wb[e]; wf[e] *= c.gi8; wb[e] *= c.gb8; } }
        }
    }
    u32x4 p0, p1;
    p0.x = cvtpk(st[0], st[1]); p0.y = cvtpk(st[2], st[3]); p0.z = cvtpk(st[4], st[5]); p0.w = cvtpk(st[6], st[7]);
    p1.x = cvtpk(st[8], st[9]); p1.y = cvtpk(st[10], st[11]); p1.z = cvtpk(st[12], st[13]); p1.w = cvtpk(st[14], st[15]);
    asm volatile("s_waitcnt lgkmcnt(0)" ::: "memory");
    __builtin_amdgcn_s_barrier();
    asm volatile("" ::: "memory");
    *(LAS u32x4*)(xch + c.myx) = p0; *(LAS u32x4*)(xch + c.myx + 1024) = p1;
}

__device__ __forceinline__ void retention_unit(LAS unsigned char* lds, const Args& a, int b, int hh, int qb, int wid, int lane) {
    unsigned char* ws = a.ws;
    bf16_t* Qp = (bf16_t*)(ws + WS_Q); const bf16_t* Kp = (const bf16_t*)(ws + WS_K); const bf16_t* Vp = (const bf16_t*)(ws + WS_V);
    const bf16_t* Gp = (const bf16_t*)(ws + WS_G);
    asm volatile("" : "+v"(lane));
    const int r = lane & 31, h = lane >> 5, rg = wid >> 1, hf = wid & 1;
    const int ch = qb / (RCH / 128), kbeg = (RCH / 64) * ch;
    RetC c; c.kend = kbeg + RCH / 64;
    c.lf2 = -log1pf(expf(-a.dec_f[hh])) * 1.4426950408889634f; c.lb2 = -log1pf(expf(-a.dec_b[hh])) * 1.4426950408889634f;
    c.iabs = qb * 128 + rg * 32 + r; c.qr0 = qb * 128 + rg * 32; c.r = r; c.h = h; c.hf = hf;
    c.gi = exp2f(-c.lf2); { const float t2 = c.gi * c.gi, t4 = t2 * t2; c.gi8 = t4 * t4; } c.gb = exp2f(c.lb2); { const float t2 = c.gb * c.gb, t4 = t2 * t2; c.gb8 = t4 * t4; }
#define RET_UNI(x) x = __uint_as_float(__builtin_amdgcn_readfirstlane(__float_as_uint(x)))
    RET_UNI(c.lf2); RET_UNI(c.lb2); RET_UNI(c.gi); RET_UNI(c.gi8); RET_UNI(c.gb); RET_UNI(c.gb8);
#undef RET_UNI
    bf16x8 qf[16];
    { const bf16_t* qp = Qp + (size_t)(b * SEQ + c.iabs) * DM + hh * 256 + 8 * h;
#pragma unroll
      for (int s = 0; s < 16; ++s) qf[s] = *(const bf16x8*)(qp + 16 * s); }
    f32x16 O[4];
#pragma unroll
    for (int d = 0; d < 4; ++d)
#pragma unroll
        for (int i = 0; i < 16; ++i) O[d][i] = 0.f;
    c.Kl0 = Kp + (size_t)(b * SEQ) * DM + hh * 256; c.Vl0 = Vp + (size_t)(b * SEQ) * DM + hh * 256;
    const int tq = (lane & 15) >> 2, tp = lane & 3, g16 = (lane >> 4) & 1;
    c.tq = tq; c.vlane = (4 * h + tq) * 512 + (2 * g16 + (tp >> 1)) * 16 + (tp & 1) * 8 + hf * 256;
    c.myx = ((wid * 2) * 64 + lane) * 16; c.pbx = (((wid & ~1) * 2) * 64 + lane) * 16;
    ret_issue<false>(lds, c.Kl0 + (size_t)(kbeg * 64) * DM, wid, lane);
    ret_iter<false, false>(lds, c, kbeg, O, qf, wid, lane);
#pragma unroll 1
    for (int kt = kbeg + 1; kt <= kbeg + RCH / 64; ++kt) ret_iter<true, false>(lds, c, kt, O, qf, wid, lane);
    {
        const bf16_t* ST = (const bf16_t*)a.out + (size_t)MTOK * DM + (size_t)((b * 8 + hh) * 2 * NRCH) * 65536;
        const int g16 = (lane >> 4) & 1, tp = lane & 3, tq = c.tq;
        const unsigned l0 = (unsigned)(__UINTPTR_TYPE__)lds;
        const bf16_t* SF = ST + (size_t)ch * 65536; const bf16_t* SB = ST + (size_t)(NRCH + ch) * 65536;
        const float aqf = __builtin_amdgcn_exp2f(c.lf2 * (float)(c.iabs - RCH * ch + 1)), aqb = __builtin_amdgcn_exp2f(c.lb2 * (float)(RCH * (ch + 1) - c.iabs));
#define ST_ISSUE(S, half) do { const int row0 = 128 * (half) + 16 * wid + (lane >> 5), pc = lane & 31; const bf16_t* sp = (S) + (size_t)row0 * 256; unsigned ld = l0 + (half) * 65536 + wid * 8192; \
            _Pragma("unroll 1") for (int cc = 0; cc < 8; ++cc) { const int lc = pc ^ (((2 * cc + (lane >> 5)) & 3) << 2); glds16(sp + lc * 8, (unsigned)__builtin_amdgcn_readfirstlane(ld)); sp += 512; ld += 1024; } } while (0)
#define ST_WAIT(n) do { asm volatile("s_waitcnt vmcnt(" #n ")" ::: "memory"); __syncthreads(); } while (0)
#define ST_COMPUTE(aq, half) do { _Pragma("unroll") for (int s = 8 * (half); s < 8 * (half) + 8; ++s) { \
            const u32x4 qw = __builtin_bit_cast(u32x4, qf[s]); u32x4 pw; \
            pw.x = cvtpk(bflo(qw.x) * (aq), bfhi(qw.x) * (aq)); pw.y = cvtpk(bflo(qw.y) * (aq), bfhi(qw.y) * (aq)); \
            pw.z = cvtpk(bflo(qw.z) * (aq), bfhi(qw.z) * (aq)); pw.w = cvtpk(bflo(qw.w) * (aq), bfhi(qw.w) * (aq)); \
            const bf16x8 af = __builtin_bit_cast(bf16x8, pw); \
            const LAS unsigned char* vb = lds + (16 * s + 8 * h + tq) * 512 + (2 * g16 + (tp >> 1)) * 16 + (tp & 1) * 8; \
            _Pragma("unroll") for (int d = 0; d < 4; ++d) { const int blk = 4 * hf + d; \
                const LAS unsigned char* vp = vb + (((blk ^ tq) & 3) << 6) + (blk >> 2) * 256; \
                const s16x4 lo = vtr(vp), hi = vtr(vp + 4 * 512); \
                O[d] = MFMA32(af, __builtin_shufflevector(lo, hi, 0, 1, 2, 3, 4, 5, 6, 7), O[d]); } } } while (0)
        __syncthreads();
        ST_ISSUE(SF, 0); ST_ISSUE(SF, 1);
#pragma unroll 1
        for (int dir = 0; dir < 2; ++dir) {
            const float aq = dir ? aqb : aqf;
            ST_WAIT(8); ST_COMPUTE(aq, 0);
            __syncthreads(); if (dir == 0) ST_ISSUE(SB, 0);
            if (dir == 0) ST_WAIT(8); else ST_WAIT(0);
            ST_COMPUTE(aq, 1);
            __syncthreads(); if (dir == 0) ST_ISSUE(SB, 1);
        }
#undef ST_ISSUE
#undef ST_WAIT
#undef ST_COMPUTE
    }
    LAS float* xs = (LAS float*)(lds + LDS_XS);
    float rs[16];
#pragma unroll
    for (int i = 0; i < 16; ++i) { float s = 0.f;
#pragma unroll
        for (int d = 0; d < 4; ++d) s += O[d][i] * O[d][i];
        s += __shfl_xor(s, 1); s += __shfl_xor(s, 2); s += __shfl_xor(s, 4); s += __shfl_xor(s, 8); s += __shfl_xor(s, 16);
        rs[i] = s; if (r == 0) xs[wid * 32 + (i & 3) + 8 * (i >> 2) + 4 * h] = s; }
    __syncthreads();
#pragma unroll
    for (int i = 0; i < 16; ++i) { const float s = rs[i] + xs[(wid ^ 1) * 32 + (i & 3) + 8 * (i >> 2) + 4 * h]; rs[i] = 1.0f / sqrtf(s * (1.0f / 256.0f) + EPS); }
    const size_t obase = (size_t)(b * SEQ + qb * 128 + rg * 32 + 4 * h) * DM + hh * 256 + hf * 128 + r;
#pragma unroll
    for (int hh2 = 0; hh2 < 2; ++hh2) {
        bf16_t gv[8][4];
#pragma unroll
        for (int ii = 0; ii < 8; ++ii) { const int i = hh2 * 8 + ii; const size_t off = obase + (size_t)((i & 3) + 8 * (i >> 2)) * DM;
#pragma unroll
            for (int d = 0; d < 4; ++d) gv[ii][d] = Gp[off + 32 * d]; }
        asm volatile("" ::: "memory");
#pragma unroll
        for (int ii = 0; ii < 8; ++ii) { const int i = hh2 * 8 + ii; const size_t off = obase + (size_t)((i & 3) + 8 * (i >> 2)) * DM;
#pragma unroll
            for (int d = 0; d < 4; ++d) Qp[off + 32 * d] = (bf16_t)(cvtpk(O[d][i] * rs[i] * bf2f(gv[ii][d]), 0.f) & 0xffffu); }
        asm volatile("" ::: "memory");
    }
}

__device__ __forceinline__ void state_unit(LAS unsigned char* lds, const Args& a, int b, int hh, int dir, int eh, int wid, int lane) {
    unsigned char* ws = a.ws;
    asm volatile("" : "+v"(lane));
    const int r = lane & 31, h = lane >> 5, tq = (lane & 15) >> 2, tp = lane & 3, g16 = (lane >> 4) & 1;
    float lg2 = -log1pf(expf(-(dir ? a.dec_b[hh] : a.dec_f[hh]))) * 1.4426950408889634f;
    lg2 = __uint_as_float(__builtin_amdgcn_readfirstlane(__float_as_uint(lg2)));
    const float m = exp2f(dir ? lg2 : -lg2);
    const float gch = exp2f((float)RCH * lg2);
    const bf16_t* Kc = (const bf16_t*)(ws + WS_KC) + (size_t)(b * LCTX) * DM + hh * 256; const bf16_t* Vc = (const bf16_t*)(ws + WS_VC) + (size_t)(b * LCTX) * DM + hh * 256;
    const bf16_t* Kl = (const bf16_t*)(ws + WS_K) + (size_t)(b * SEQ) * DM + hh * 256; const bf16_t* Vl = (const bf16_t*)(ws + WS_V) + (size_t)(b * SEQ) * DM + hh * 256;
    bf16_t* ST = (bf16_t*)a.out + (size_t)MTOK * DM + (size_t)((b * 8 + hh) * 2 * NRCH) * 65536;
    constexpr int TPC = RCH / 64, NT = 4 + (NRCH - 1) * TPC;
#define ST_ROW(t_) ((t_) < 4 ? 0 : (dir ? (NRCH - 1 - ((t_) - 4) / TPC) : ((t_) - 4) / TPC) * RCH + (((t_) - 4) % TPC) * 64)
    f32x16 acc[4];
#pragma unroll
    for (int d = 0; d < 4; ++d)
#pragma unroll
        for (int i = 0; i < 16; ++i) acc[d][i] = 0.f;
    const int lanec = (2 * g16 + (tp >> 1)) * 16 + (tp & 1) * 8;
    ret_issue<true>(lds, Kc, wid, lane); ret_issue<true>(lds + 32768, Vc, wid, lane);
#pragma unroll 1
    for (int t = 0; t < NT; ++t) {
        asm volatile("s_waitcnt vmcnt(0) lgkmcnt(0)" ::: "memory");
        __builtin_amdgcn_s_barrier();
        asm volatile("" ::: "memory");
        if (t + 1 < NT) { const int t1 = t + 1; const bf16_t* kp = t1 < 4 ? Kc + (size_t)(t1 * 64) * DM : Kl + (size_t)ST_ROW(t1) * DM; const bf16_t* vp = t1 < 4 ? Vc + (size_t)(t1 * 64) * DM : Vl + (size_t)ST_ROW(t1) * DM;
            ret_issue<true>(lds + (t1 & 1) * 65536, kp, wid, lane); ret_issue<true>(lds + (t1 & 1) * 65536 + 32768, vp, wid, lane); }
        if (t >= 4 && (t - 4) % TPC == 0) {
            const int wi = (t - 4) / TPC; bf16_t* S = ST + (size_t)(dir ? NRCH + (NRCH - 1 - wi) : wi) * 65536;
#pragma unroll
            for (int d = 0; d < 4; ++d)
#pragma unroll
                for (int i = 0; i < 16; ++i) { S[(size_t)(32 * wid + (i & 3) + 8 * (i >> 2) + 4 * h) * 256 + 128 * eh + 32 * d + r] = (bf16_t)(cvtpk(acc[d][i], 0.f) & 0xffffu); acc[d][i] *= gch; }
        }
        const LAS unsigned char* Kt = lds + (t & 1) * 65536; const LAS unsigned char* Vt = Kt + 32768;
        const int p0 = (t < 4 ? 64 * t : 64 * ((t - 4) % TPC)) + 8 * h, last = t < 4 ? 255 : RCH - 1;
#pragma unroll
        for (int s = 0; s < 4; ++s) {
            const LAS unsigned char* kb = Kt + (16 * s + 8 * h + tq) * 512 + lanec + (((wid ^ tq) & 3) << 6) + (wid >> 2) * 256;
            const s16x4 klo = vtr(kb), khi = vtr(kb + 4 * 512);
            const int p = p0 + 16 * s;
            float w = __builtin_amdgcn_exp2f(lg2 * (float)(dir ? p : last - p));
            const u32x2 lw = __builtin_bit_cast(u32x2, klo), hw = __builtin_bit_cast(u32x2, khi);
            float kv[8] = {bflo(lw.x), bfhi(lw.x), bflo(lw.y), bfhi(lw.y), bflo(hw.x), bfhi(hw.x), bflo(hw.y), bfhi(hw.y)};
#pragma unroll
            for (int j = 0; j < 8; ++j) { kv[j] *= w; w *= m; }
            u32x4 pw; pw.x = cvtpk(kv[0], kv[1]); pw.y = cvtpk(kv[2], kv[3]); pw.z = cvtpk(kv[4], kv[5]); pw.w = cvtpk(kv[6], kv[7]);
            const bf16x8 af = __builtin_bit_cast(bf16x8, pw);
            const LAS unsigned char* vb = Vt + (16 * s + 8 * h + tq) * 512 + lanec;
#pragma unroll
            for (int d = 0; d < 4; ++d) { const int blk = 4 * eh + d;
                const LAS unsigned char* vp = vb + (((blk ^ tq) & 3) << 6) + (blk >> 2) * 256;
                const s16x4 lo = vtr(vp), hi = vtr(vp + 4 * 512);
                acc[d] = MFMA32(af, __builtin_shufflevector(lo, hi, 0, 1, 2, 3, 4, 5, 6, 7), acc[d]); }
        }
    }
    { bf16_t* S = ST + (size_t)(dir ? NRCH : NRCH - 1) * 65536;
#pragma unroll
      for (int d = 0; d < 4; ++d)
#pragma unroll
          for (int i = 0; i < 16; ++i) S[(size_t)(32 * wid + (i & 3) + 8 * (i >> 2) + 4 * h) * 256 + 128 * eh + 32 * d + r] = (bf16_t)(cvtpk(acc[d][i], 0.f) & 0xffffu); }
#undef ST_ROW
}

__device__ __forceinline__ void spatial_unit(LAS unsigned char* lds, const Args& a, int b, int n, int ghalf, int tid, int wid, int lane) {
    bf16_t* Up = (bf16_t*)a.out; const bf16_t* VSp = (const bf16_t*)a.out + (size_t)MTOK * DM;
    const bf16_t* Wb = (const bf16_t*)(a.ws + WS_SGW);
    asm volatile("" : "+v"(lane)); asm volatile("" : "+v"(tid));
    LAS f32x2* stats = (LAS f32x2*)(lds + LDS_STATS);
    const int tok0 = b * SEQ + n * 128;
#pragma unroll 1
    for (int t0 = wid * 16; t0 < wid * 16 + 16; t0 += 4) {
        u32x4 w[4][4];
#pragma unroll
        for (int tt = 0; tt < 4; ++tt)
#pragma unroll
            for (int j = 0; j < 4; ++j) w[tt][j] = *(const u32x4*)(VSp + (size_t)(tok0 + t0 + tt) * DM + j * 512 + lane * 8);
#pragma unroll
        for (int tt = 0; tt < 4; ++tt) { float s = 0.f, ss = 0.f;
#pragma unroll
            for (int j = 0; j < 4; ++j)
#pragma unroll
                for (int e = 0; e < 4; ++e) { const float x0 = bflo(w[tt][j][e]), x1 = bfhi(w[tt][j][e]); s += x0 + x1; ss += x0 * x0 + x1 * x1; }
            s = wave_sum(s); ss = wave_sum(ss);
            const float mean = s * (1.0f / DM); float var = ss * (1.0f / DM) - mean * mean; var = var > 0.f ? var : 0.f;
            if (lane == 0) stats[t0 + tt] = (f32x2){mean, 1.0f / sqrtf(var + EPS)}; }
    }
    __syncthreads();
    const int r = lane & 31, h = lane >> 5, ib = wid & 3, dbh = wid >> 2;
    const int tq = (lane & 15) >> 2, tp = lane & 3, g16 = (lane >> 4) & 1;
    for (int gi = 0; gi < 4; ++gi) {
        const int g = ghalf * 4 + gi;
        { const int lc = tid & 31, ch = g * 256 + lc * 8, row0 = tid >> 5;
          u32x4 w[8];
#pragma unroll
          for (int it = 0; it < 8; ++it) w[it] = *(const u32x4*)(VSp + (size_t)(tok0 + row0 + it * 16) * DM + ch);
          const f32x4 g0 = *(const f32x4*)(a.sg_ln_g + ch), g1 = *(const f32x4*)(a.sg_ln_g + ch + 4), b0 = *(const f32x4*)(a.sg_ln_b + ch), b1 = *(const f32x4*)(a.sg_ln_b + ch + 4);
#pragma unroll
          for (int it = 0; it < 8; ++it) { const int row = row0 + it * 16; const f32x2 st = stats[row];
            u32x4 o;
            o.x = cvtpk((bflo(w[it].x) - st.x) * st.y * g0[0] + b0[0], (bfhi(w[it].x) - st.x) * st.y * g0[1] + b0[1]);
            o.y = cvtpk((bflo(w[it].y) - st.x) * st.y * g0[2] + b0[2], (bfhi(w[it].y) - st.x) * st.y * g0[3] + b0[3]);
            o.z = cvtpk((bflo(w[it].z) - st.x) * st.y * g1[0] + b1[0], (bfhi(w[it].z) - st.x) * st.y * g1[1] + b1[1]);
            o.w = cvtpk((bflo(w[it].w) - st.x) * st.y * g1[2] + b1[2], (bfhi(w[it].w) - st.x) * st.y * g1[3] + b1[3]);
            *(LAS u32x4*)(lds + row * 512 + ((lc ^ ((row & 3) << 2)) << 4)) = o; } }
        __syncthreads();
        f32x16 acc[4];
#pragma unroll
        for (int d = 0; d < 4; ++d)
#pragma unroll
            for (int i = 0; i < 16; ++i) acc[d][i] = 0.f;
        const bf16_t* wrow = Wb + (size_t)g * 16384 + (size_t)(ib * 32 + r) * 128 + 8 * h;
        bf16x8 afr[8];
#pragma unroll
        for (int ks = 0; ks < 8; ++ks) afr[ks] = *(const bf16x8*)(wrow + 16 * ks);
#pragma unroll
        for (int ks = 0; ks < 8; ++ks) {
            const bf16x8 af = afr[ks];
            const LAS unsigned char* vb = lds + (16 * ks + 8 * h + tq) * 512 + (2 * g16 + (tp >> 1)) * 16 + (tp & 1) * 8;
#pragma unroll
            for (int d = 0; d < 4; ++d) { const int db = dbh * 4 + d;
                const LAS unsigned char* vp = vb + (((db ^ tq) & 3) << 6) + (db >> 2) * 256;
                const s16x4 lo = vtr(vp), hi = vtr(vp + 4 * 512);
                const bf16x8 bfr = __builtin_shufflevector(lo, hi, 0, 1, 2, 3, 4, 5, 6, 7);
                acc[d] = MFMA32(af, bfr, acc[d]); }
        }
#pragma unroll
        for (int hh2 = 0; hh2 < 2; ++hh2) {
            bf16_t uv[8][4]; float bias[8];
#pragma unroll
            for (int ii = 0; ii < 8; ++ii) { const int i = hh2 * 8 + ii, il = ib * 32 + (i & 3) + 8 * (i >> 2) + 4 * h; bias[ii] = a.sg_b[g * 128 + il];
                const size_t off = (size_t)(tok0 + il) * DM + g * 256 + dbh * 128 + r;
#pragma unroll
                for (int d = 0; d < 4; ++d) uv[ii][d] = Up[off + 32 * d]; }
            asm volatile("" ::: "memory");
#pragma unroll
            for (int ii = 0; ii < 8; ++ii) { const int i = hh2 * 8 + ii, il = ib * 32 + (i & 3) + 8 * (i >> 2) + 4 * h;
                const size_t off = (size_t)(tok0 + il) * DM + g * 256 + dbh * 128 + r;
#pragma unroll
                for (int d = 0; d < 4; ++d) Up[off + 32 * d] = (bf16_t)(cvtpk(bf2f(uv[ii][d]) * (acc[d][i] + bias[ii]), 0.f) & 0xffffu); }
            asm volatile("" ::: "memory");
        }
        __syncthreads();
    }
}

#define XB_TMO      128
#define XB_XCNT(j)  (256  + 64 * (j))
#define XB_XSUB(j)  (1280 + 64 * (j))
#define XB_XGEN(j)  (2304 + 64 * (j))
#define XB_TOP      3328
#define XB_TOPGEN   3392
#define XCD_BAR_WORDS 3456
#define XB_SPIN_CAP (1u << 22)
__device__ __forceinline__ unsigned xb_ld(unsigned* p)              { return __hip_atomic_load(p, __ATOMIC_RELAXED, __HIP_MEMORY_SCOPE_AGENT); }
__device__ __forceinline__ unsigned xb_add(unsigned* p, unsigned v) { return __hip_atomic_fetch_add(p, v, __ATOMIC_RELAXED, __HIP_MEMORY_SCOPE_AGENT); }
__device__ __forceinline__ unsigned xb_xcc_id() { return (unsigned)__builtin_amdgcn_s_getreg((3 << 11) | 20) & 0xFu; }
#define XB_SPIN(cond, bar) do { unsigned _sp = 0; while (cond) { __builtin_amdgcn_s_sleep(1); \
    if ((++_sp & 255u) == 0u) { if (xb_ld(&(bar)[XB_TMO])) break; if (_sp > XB_SPIN_CAP) { atomicAdd(&(bar)[XB_TMO], 1u); break; } } } } while (0)
struct XcdBarrier { unsigned* bar; unsigned x; volatile LAS unsigned* st; };
__device__ __forceinline__ XcdBarrier xcd_barrier_post(unsigned* bar, volatile LAS unsigned* st) {
    XcdBarrier b; b.bar = bar; b.x = xb_xcc_id(); b.st = st;
    if (threadIdx.x == 0) (void)xb_add(&bar[XB_XCNT(b.x)], 1u);
    return b;
}
__device__ __forceinline__ void xcd_barrier_complete(unsigned* bar, unsigned x, unsigned& nloc, unsigned& nx) {
    const unsigned G = gridDim.x * gridDim.y * gridDim.z;
    unsigned sum, cnt, mine, sp = 0u;
    for (;;) {
        sum = 0u; cnt = 0u; mine = 0u;
#pragma unroll
        for (unsigned j = 0; j < 16; ++j) { const unsigned c = xb_ld(&bar[XB_XCNT(j)]); sum += c; cnt += (c > 0u) ? 1u : 0u; mine = (j == x) ? c : mine; }
        if (sum == G) break;
        __builtin_amdgcn_s_sleep(1);
        if ((++sp & 255u) == 0u) { if (xb_ld(&bar[XB_TMO])) break; if (sp > XB_SPIN_CAP) { atomicAdd(&bar[XB_TMO], 1u); break; } }
    }
    nloc = mine > 0u ? mine : 1u; nx = cnt > 0u ? cnt : 1u;
}
__device__ __forceinline__ void xcd_barrier(const XcdBarrier& b) {
    asm volatile("s_waitcnt vmcnt(0)" ::: "memory");
    __syncthreads();
    if (threadIdx.x == 0) {
        unsigned* bar = b.bar;
        __builtin_amdgcn_s_waitcnt(0);
        unsigned nloc = b.st[0], nx = b.st[1];
        if (nloc == 0u) { xcd_barrier_complete(bar, b.x, nloc, nx); b.st[0] = nloc; b.st[1] = nx; }
        const unsigned old = xb_add(&bar[XB_XSUB(b.x)], 1u);
        const unsigned gen = old / nloc;
        if (old + 1u == (gen + 1u) * nloc) {
            __builtin_amdgcn_fence(__ATOMIC_RELEASE, "agent");
            asm volatile("s_waitcnt vmcnt(0)" ::: "memory");
            const unsigned og = xb_add(&bar[XB_TOP], 1u);
            const unsigned tg = og / nx;
            if (og + 1u == (tg + 1u) * nx) xb_add(&bar[XB_TOPGEN], 1u);
            else XB_SPIN(xb_ld(&bar[XB_TOPGEN]) == tg, bar);
            __builtin_amdgcn_fence(__ATOMIC_ACQUIRE, "agent");
            xb_add(&bar[XB_XGEN(b.x)], 1u);
            asm volatile("s_waitcnt vmcnt(0)" ::: "memory");
        } else {
            XB_SPIN(xb_ld(&bar[XB_XGEN(b.x)]) == gen, bar);
            __builtin_amdgcn_fence(__ATOMIC_ACQUIRE, "agent");
            asm volatile("s_waitcnt vmcnt(0)" ::: "memory");
        }
    }
    __syncthreads();
}

__global__ void __launch_bounds__(512, 2) fwd_megakernel(Args a) {
    extern __shared__ __attribute__((aligned(16))) unsigned char lds_raw[];
    LAS unsigned char* lds = (LAS unsigned char*)lds_raw;
    cg::grid_group grid = cg::this_grid();
    const int tid = threadIdx.x, wid = __builtin_amdgcn_readfirstlane(tid >> 6), lane = tid & 63;
    const int G = gridDim.x, bx = blockIdx.x;
    unsigned char* ws = a.ws;
    const float* MOD = (const float*)(ws + WS_MOD);
    const int gw = bx * 8 + wid, NGW = G * 8;

    if (tid < 4) ((LAS unsigned*)(lds + LDS_BARST))[tid] = 0u;
    __syncthreads();
    const XcdBarrier xbar = xcd_barrier_post((unsigned*)(ws + WS_BAR), (volatile LAS unsigned*)(lds + LDS_BARST));
#define GRID_BAR() xcd_barrier(xbar)
    if (a.dec_f[0] < -1e30f) grid.sync();
    p0_prologue(a, lds, tid, wid, lane, G);
    GRID_BAR();
    rows_phase<false>(a.x, a.ctx, MTOK, MTOK + MCTX, a.norm1_g, MOD, 0, DM, (void*)(ws + WS_H), gw, NGW, lane);
    GRID_BAR();
    {
        EpiIn E{(bf16_t*)(ws + WS_Q), (bf16_t*)(ws + WS_K), (bf16_t*)(ws + WS_V), (bf16_t*)(ws + WS_G), (bf16_t*)a.out, (bf16_t*)a.out + (size_t)MTOK * DM,
                (bf16_t*)(ws + WS_KC), (bf16_t*)(ws + WS_VC), (const f32x4*)(ws + WS_ROPE)};
        pg8::Gemm g{(const bf16_t*)(ws + WS_H), (const bf16_t*)(ws + WS_WIN), nullptr, nullptr, DM}; pg8::Order S; S.init(64, 48, 0, 128, G, bx);
        pg8::gemm_phase(lds, g, S, E);
        if (G == 256) { if (bx >= 128) convert_ffn(a, lds, (bx - 128) * 8 + wid, 128 * 8, wid, lane); }
        else convert_ffn(a, lds, gw, NGW, wid, lane);
    }
    GRID_BAR();
    for (int idx = bx; idx < 256; idx += G) { spatial_unit(lds, a, idx >> 5, (idx >> 1) & 15, idx & 1, tid, wid, lane); }
    GRID_BAR();
    for (int idx = bx; idx < 256; idx += G) { state_unit(lds, a, idx >> 5, (idx >> 2) & 7, (idx >> 1) & 1, idx & 1, wid, lane); __syncthreads(); }
    GRID_BAR();
    for (int i = 0; ; ++i) {
        int b, hh, qb;
        if (G == 256) { if (i >= 4) break; const int xcd = bx & 7, j = i * 32 + (bx >> 3); hh = xcd; b = j >> 4; qb = j & 15; }
        else { const int idx = i * G + bx; if (idx >= 1024) break; b = idx >> 7; hh = (idx >> 4) & 7; qb = idx & 15; }
        retention_unit(lds, a, b, hh, qb, wid, lane);
        __syncthreads();
    }
    GRID_BAR();
    {
        EpiIn E{(bf16_t*)(ws + WS_Q), (bf16_t*)(ws + WS_K), (bf16_t*)(ws + WS_V), (bf16_t*)(ws + WS_G), (bf16_t*)a.out, (bf16_t*)a.out + (size_t)MTOK * DM,
                (bf16_t*)(ws + WS_KC), (bf16_t*)(ws + WS_VC), (const f32x4*)(ws + WS_ROPE)};
        pg8::Gemm g{(const bf16_t*)(ws + WS_H), (const bf16_t*)(ws + WS_WIN), nullptr, nullptr, DM}; pg8::Order S; S.init(64, 16, 48, 0, G, bx);
        pg8::gemm_phase(lds, g, S, E);
    }
    GRID_BAR();
    {
        EpiDual E{(const bf16_t*)(ws + WS_K), (const bf16_t*)(ws + WS_V), (bf16_t*)(ws + WS_G)};
        pg8::Gemm g{(const bf16_t*)(ws + WS_Q), (const bf16_t*)(ws + WS_W3), (const bf16_t*)a.out, (const bf16_t*)(ws + WS_W3 + 8 * MiB), DM}; pg8::Order S; S.init(64, 8, 0, 0, G, bx, 1);
        pg8::gemm_phase(lds, g, S, E);
    }
    GRID_BAR();
    {
        EpiRes E{a.x, MOD + 2 * DM, a.out};
        pg8::Gemm g{(const bf16_t*)(ws + WS_G), (const bf16_t*)(ws + WS_W3 + 16 * MiB), nullptr, nullptr, DM}; pg8::Order S; S.init(64, 8, 0, 0, G, bx);
        pg8::gemm_phase(lds, g, S, E);
    }
    GRID_BAR();
    rows_phase<false>(a.out, a.out, MTOK, MTOK, a.norm2_g, MOD, 3 * DM, 4 * DM, (void*)(ws + WS_Q), gw, NGW, lane);
    GRID_BAR();
    {
        EpiSwiglu E{(bf16_t*)(ws + WS_HID)};
        pg8::Gemm g{(const bf16_t*)(ws + WS_Q), (const bf16_t*)(ws + WS_WF1), nullptr, nullptr, DM}; pg8::Order S; S.init(64, 44, 0, 0, G, bx);
        pg8::gemm_phase(lds, g, S, E);
    }
    GRID_BAR();
    {
        EpiRes E{a.out, MOD + 5 * DM, a.out};
        pg8::Gemm g{(const bf16_t*)(ws + WS_HID), (const bf16_t*)(ws + WS_WF2), nullptr, nullptr, FF}; pg8::Order S; S.init(64, 8, 0, 0, G, bx);
        pg8::gemm_phase(lds, g, S, E);
    }
    GRID_BAR();
    rows_phase<true>(a.out, a.out, MTOK, MTOK, a.final_g, MOD, 0, 0, (void*)a.out, gw, NGW, lane);
}

extern "C" void kernel_launch(void* const* d_in, const int* in_sizes, int n_in, void* d_out, int out_size, void* d_ws, size_t ws_size, hipStream_t stream) {
    static int grid_blocks = 0;
    if (grid_blocks == 0) {
        if (n_in != 21 || out_size != MTOK * DM || ws_size < WS_END) { fprintf(stderr, "kernel_launch: unexpected problem (n_in %d, out %d, ws %zu)\n", n_in, out_size, ws_size); grid_blocks = -1; return; }
        int dev = 0, cus = 0, per_cu = 0;
        hipGetDevice(&dev);
        hipDeviceGetAttribute(&cus, hipDeviceAttributeMultiprocessorCount, dev);
        if (hipFuncSetAttribute((const void*)fwd_megakernel, hipFuncAttributeMaxDynamicSharedMemorySize, LDS_BYTES) != hipSuccess) { fprintf(stderr, "kernel_launch: hipFuncSetAttribute failed\n"); grid_blocks = -1; return; }
        if (hipOccupancyMaxActiveBlocksPerMultiprocessor(&per_cu, (const void*)fwd_megakernel, 512, LDS_BYTES) != hipSuccess || per_cu < 1) { fprintf(stderr, "kernel_launch: occupancy query gave %d\n", per_cu); per_cu = 1; }
        (void)hipGetLastError();
        grid_blocks = cus * (per_cu > 1 ? 1 : per_cu);
        if (grid_blocks < 1) grid_blocks = 256;
    }
    if (grid_blocks < 0) return;
    if (hipMemsetAsync((char*)d_ws + WS_BAR, 0, XCD_BAR_WORDS * 4, stream) != hipSuccess) { fprintf(stderr, "kernel_launch: memset of the barrier words failed\n"); return; }
    Args a{};
    const float** pp = (const float**)&a;
    for (int i = 0; i < 21; ++i) pp[i] = (const float*)d_in[i];
    a.out = (float*)d_out; a.ws = (unsigned char*)d_ws;
    void* args[] = {&a};
    hipError_t e = hipLaunchCooperativeKernel((const void*)fwd_megakernel, dim3(grid_blocks), dim3(512), args, LDS_BYTES, stream);
    if (e != hipSuccess) fprintf(stderr, "cooperative launch failed: %s (grid %d)\n", hipGetErrorString(e), grid_blocks);
}
```
